# Optimizing an MI355X kernel written in HIP

```python
import jax, jax.numpy as jnp
from jax import lax
import numpy as np

D_MODEL = 1024
BATCH = 8
SEQ = 8192
DEPTH = 1
DEC_BATCH = 8
DEC_SEQ = 16
PAST_LEN = 1024

CHUNK = 64
SGU_LEN = 128
SGU_GROUPS = 8
SGU_WIDTH = 512
SGU_GDIM = SGU_WIDTH // SGU_GROUPS
N_HEADS = 8
N_KV_HEADS = 4
HEAD_DIM = 64
GROUP = N_HEADS // N_KV_HEADS
ATT_WIDTH = N_HEADS * HEAD_DIM
KV_WIDTH = N_KV_HEADS * HEAD_DIM
N_IDX_HEADS = 8
IDX_DIM = 64
TOPK_MAX = 256
Q_BLOCK = 128
RMS_EPS = 1e-6
LN_EPS = 1e-5
SPLIT_SIZES = (SGU_WIDTH, SGU_WIDTH, SGU_WIDTH,
               ATT_WIDTH, KV_WIDTH, KV_WIDTH, ATT_WIDTH,
               N_IDX_HEADS * IDX_DIM, IDX_DIM, N_IDX_HEADS,
               D_MODEL, D_MODEL)
IN_WIDTH = (3 * SGU_WIDTH + 2 * ATT_WIDTH + 2 * KV_WIDTH
            + N_IDX_HEADS * IDX_DIM + IDX_DIM + N_IDX_HEADS + 2 * D_MODEL)

kernel_name = "chunk_causal_gmlp_dsa_hybrid_step"


def _rmsnorm(x, g):
    xf = x.astype(jnp.float32)
    y = xf * lax.rsqrt(jnp.mean(xf * xf, axis=-1, keepdims=True) + RMS_EPS)
    return (y * g.astype(jnp.float32)).astype(x.dtype)


def _chunk_mask(q_pos, k_pos):
    return (k_pos[None, :] // CHUNK) <= (q_pos[:, None] // CHUNK)


def _project(x, norm_g, w_in):
    h = _rmsnorm(x, norm_g)
    points = np.cumsum(SPLIT_SIZES)[:-1].tolist()
    return jnp.split(h @ w_in, points, axis=-1)


def _sgu(u_pre, v_pre, ln_g, ln_b, w_s, b_s):
    b, L, _ = u_pre.shape
    n = min(L, SGU_LEN)
    u = jax.nn.gelu(u_pre)
    v = jax.nn.gelu(v_pre)
    vf = v.astype(jnp.float32)
    mu = jnp.mean(vf, axis=-1, keepdims=True)
    var = jnp.mean(jnp.square(vf - mu), axis=-1, keepdims=True)
    vn = ((vf - mu) * lax.rsqrt(var + LN_EPS) * ln_g.astype(jnp.float32)
          + ln_b.astype(jnp.float32)).astype(v.dtype)
    pos = jnp.arange(n)
    ws = jnp.where(_chunk_mask(pos, pos)[None], w_s[:, :n, :n], 0)
    vc = vn.reshape(b, L // n, n, SGU_GROUPS, SGU_GDIM)
    mixed = jnp.einsum('gij,bcjgd->bcigd', ws, vc) + b_s[:, :n].T[None, None, :, :, None]
    return u * mixed.reshape(b, L, SGU_WIDTH), vn


def _sparse_attend(q, qi, wi, q_pos, k, v, kidx, k_pos, topk):
    b, nq = q.shape[0], q.shape[1]
    rel = jax.nn.relu(jnp.einsum('bqhd,bld->bqhl', qi, kidx) * (IDX_DIM ** -0.5))
    score = jnp.einsum('bqhl,bqh->bql', rel, wi).astype(jnp.float32) * (N_IDX_HEADS ** -0.5)
    score = jnp.where(_chunk_mask(q_pos, k_pos)[None], score, -jnp.inf)
    top_val, top_idx = lax.top_k(score, topk)
    valid = top_val > -jnp.inf
    gather = jax.vmap(lambda rows, idx: rows[idx])
    k_sel = gather(k, top_idx)
    v_sel = gather(v, top_idx)
    qg = q.reshape(b, nq, N_KV_HEADS, GROUP, HEAD_DIM)
    logits = jnp.einsum('bqhgd,bqnhd->bqhgn', qg, k_sel).astype(jnp.float32) * (HEAD_DIM ** -0.5)
    logits = jnp.where(valid[:, :, None, None, :], logits, -jnp.inf)
    p = jax.nn.softmax(logits, axis=-1).astype(v.dtype)
    out = jnp.einsum('bqhgn,bqnhd->bqhgd', p, v_sel)
    return out.reshape(b, nq, ATT_WIDTH)


def _prompt_attention(q, qi, wi, k, v, kidx):
    bsz, seq = q.shape[0], q.shape[1]
    topk = min(TOPK_MAX, seq // 4)
    k_pos = jnp.arange(seq)

    def block(i):
        start = i * Q_BLOCK
        sl = lambda a: lax.dynamic_slice_in_dim(a, start, Q_BLOCK, axis=1)
        return _sparse_attend(sl(q), sl(qi), sl(wi), start + jnp.arange(Q_BLOCK),
                              k, v, kidx, k_pos, topk)

    out = lax.map(block, jnp.arange(seq // Q_BLOCK))
    return jnp.swapaxes(out, 0, 1).reshape(bsz, seq, ATT_WIDTH)


def _merge(x, a_out, b_out, g_a, g_b, w_pa, w_pb, w_out):
    m = jax.nn.sigmoid(g_a) * (a_out @ w_pa) + jax.nn.sigmoid(g_b) * (b_out @ w_pb)
    return x + m @ w_out


def _heads(q, k, v, qi, ki, wi):
    b, L = q.shape[0], q.shape[1]
    return (q.reshape(b, L, N_HEADS, HEAD_DIM), k.reshape(b, L, N_KV_HEADS, HEAD_DIM),
            v.reshape(b, L, N_KV_HEADS, HEAD_DIM), qi.reshape(b, L, N_IDX_HEADS, IDX_DIM), ki, wi)


def setup_inputs(seed: int = 0) -> dict:
    key = jax.random.key(seed)
    ks = jax.random.split(key, 18)
    f32 = jnp.float32
    nrm = lambda k, s: jax.random.normal(k, s, f32)
    return {
        "x_prompt": nrm(ks[0], (BATCH, SEQ, D_MODEL)),
        "x_sample": nrm(ks[1], (DEC_BATCH, DEC_SEQ, D_MODEL)),
        "cache_k": nrm(ks[2], (DEPTH, DEC_BATCH, PAST_LEN, N_KV_HEADS, HEAD_DIM)),
        "cache_v": nrm(ks[3], (DEPTH, DEC_BATCH, PAST_LEN, N_KV_HEADS, HEAD_DIM)),
        "cache_kidx": nrm(ks[4], (DEPTH, DEC_BATCH, PAST_LEN, IDX_DIM)),
        "norm_g": 1.0 + 0.02 * nrm(ks[5], (DEPTH, D_MODEL)),
        "w_in": nrm(ks[6], (DEPTH, D_MODEL, IN_WIDTH)) * D_MODEL ** -0.5,
        "sgu_ln_g": 1.0 + 0.02 * nrm(ks[7], (DEPTH, SGU_WIDTH)),
        "sgu_ln_b": 0.02 * nrm(ks[8], (DEPTH, SGU_WIDTH)),
        "sgu_w": nrm(ks[9], (DEPTH, SGU_GROUPS, SGU_LEN, SGU_LEN)) * SGU_LEN ** -0.5,
        "sgu_b": 1.0 + 0.02 * nrm(ks[10], (DEPTH, SGU_GROUPS, SGU_LEN)),
        "w_pa": nrm(ks[11], (DEPTH, SGU_WIDTH, D_MODEL)) * SGU_WIDTH ** -0.5,
        "w_pb": nrm(ks[12], (DEPTH, ATT_WIDTH, D_MODEL)) * ATT_WIDTH ** -0.5,
        "w_out": nrm(ks[13], (DEPTH, D_MODEL, D_MODEL)) * D_MODEL ** -0.5,
        "final_g": 1.0 + 0.02 * nrm(ks[14], (D_MODEL,)),
    }


def reference(x_prompt, x_sample, cache_k, cache_v, cache_kidx, norm_g, w_in, sgu_ln_g, sgu_ln_b,
              sgu_w, sgu_b, w_pa, w_pb, w_out, final_g):
    xp, xs = x_prompt, x_sample
    pk, pv, pki, sk, sv, ski, svn = [], [], [], [], [], [], []
    topk_s = min(TOPK_MAX, (PAST_LEN + DEC_SEQ) // 4)
    k_pos_s = jnp.arange(PAST_LEN + DEC_SEQ)
    q_pos_s = PAST_LEN + jnp.arange(DEC_SEQ)
    for l in range(DEPTH):
        u, v, za, q, k, vv, zb, qi, ki, wi, ga, gb = _project(xp, norm_g[l], w_in[l])
        a_out, _ = _sgu(u, v, sgu_ln_g[l], sgu_ln_b[l], sgu_w[l], sgu_b[l])
        a_out = a_out * jax.nn.silu(za)
        q4, k4, v4, qi4, ki4, wi4 = _heads(q, k, vv, qi, ki, wi)
        b_out = _prompt_attention(q4, qi4, wi4, k4, v4, ki4) * jax.nn.silu(zb)
        xp = _merge(xp, a_out, b_out, ga, gb, w_pa[l], w_pb[l], w_out[l])
        pk.append(k4); pv.append(v4); pki.append(ki4)
        u, v, za, q, k, vv, zb, qi, ki, wi, ga, gb = _project(xs, norm_g[l], w_in[l])
        a_out, vn_s = _sgu(u, v, sgu_ln_g[l], sgu_ln_b[l], sgu_w[l], sgu_b[l])
        a_out = a_out * jax.nn.silu(za)
        q4, k4, v4, qi4, ki4, wi4 = _heads(q, k, vv, qi, ki, wi)
        k_all = jnp.concatenate([cache_k[l], k4], axis=1)
        v_all = jnp.concatenate([cache_v[l], v4], axis=1)
        ki_all = jnp.concatenate([cache_kidx[l], ki4], axis=1)
        b_out = _sparse_attend(q4, qi4, wi4, q_pos_s, k_all, v_all, ki_all, k_pos_s, topk_s)
        b_out = b_out * jax.nn.silu(zb)
        xs = _merge(xs, a_out, b_out, ga, gb, w_pa[l], w_pb[l], w_out[l])
        sk.append(k4); sv.append(v4); ski.append(ki4); svn.append(vn_s)
    y_prompt = _rmsnorm(xp, final_g)
    y_sample = _rmsnorm(xs, final_g)
    prompt_k = jnp.stack(pk)
    prompt_v = jnp.stack(pv)
    prompt_kidx = jnp.stack(pki)
    sample_k = jnp.stack(sk)
    sample_v = jnp.stack(sv)
    sample_kidx = jnp.stack(ski)
    sample_sgu_v = jnp.stack(svn)
    return (y_prompt, y_sample, prompt_k, prompt_v, prompt_kidx, sample_k, sample_v, sample_kidx, sample_sgu_v)
```

```cpp
#include <hip/hip_runtime.h>
#include <hip/hip_cooperative_groups.h>
#include <cstdio>
#include <cstdint>
namespace cg = cooperative_groups;

#define LAS __attribute__((address_space(3)))
typedef _Float16 h16;
typedef _Float16 h16x8 __attribute__((ext_vector_type(8)));
typedef _Float16 h16x4 __attribute__((ext_vector_type(4)));
typedef _Float16 h16x2 __attribute__((ext_vector_type(2)));
typedef float f32x2 __attribute__((ext_vector_type(2)));
typedef float f32x4 __attribute__((ext_vector_type(4)));
typedef float f32x16 __attribute__((ext_vector_type(16)));
typedef unsigned u32x4 __attribute__((ext_vector_type(4)));
typedef unsigned u32x2 __attribute__((ext_vector_type(2)));
typedef unsigned long long u64;

constexpr int DM = 1024, SEQ = 8192, NB = 8, MP = NB * SEQ;
constexpr int DSQ = 16, MS = NB * DSQ, PAST = 1024, NKS = PAST + DSQ, NKSP = 1056;
constexpr int MROWS = MP + MS;
constexpr int MT = MP + 256;
constexpr int INW = 5704, NPJ = 5888;
constexpr int C_U = 0, C_V = 512, C_ZA = 1024, C_Q = 1536, C_K = 2048, C_VV = 2304, C_ZB = 2560, C_QI = 3072, C_KI = 3584, C_WI = 3648, C_GA = 3840, C_GB = 4864;
constexpr size_t O_YP = 0, O_YS = 67108864, O_PK = 67239936, O_PV = 84017152, O_PKI = 100794368, O_SK = 104988672, O_SV = 105021440, O_SKI = 105054208, O_SSV = 105062400;
constexpr size_t WS_XH = 0;
constexpr size_t WS_PROJ = WS_XH + (size_t)MT * DM * 2;
constexpr size_t WS_WIN = WS_PROJ + (size_t)MT * NPJ * 2;
constexpr size_t WS_WPA = WS_WIN + (size_t)NPJ * DM * 2;
constexpr size_t WS_WPB = WS_WPA + (size_t)1024 * 512 * 2;
constexpr size_t WS_WOUT = WS_WPB + (size_t)1024 * 512 * 2;
constexpr size_t WS_WSM = WS_WOUT + (size_t)1024 * 1024 * 2;
constexpr size_t WS_KVS = WS_WSM + (size_t)8 * 128 * 128 * 2;
constexpr size_t WS_KIS = WS_KVS + (size_t)NB * NKSP * 512 * 2;
constexpr size_t WS_RSTD = WS_KIS + (size_t)NB * NKSP * 64 * 2;
constexpr size_t WS_ROWSS = WS_RSTD + (size_t)MT * 4;
constexpr size_t WS_END = WS_ROWSS + (size_t)MT * 4;
constexpr int LDS_BYTES = 147456;

__device__ __forceinline__ float sigmoidf_(float x) { return 1.f / (1.f + __expf(-x)); }
__device__ __forceinline__ float siluf_(float x) { return x / (1.f + __expf(-x)); }
__device__ __forceinline__ float geluf_(float x) { const float t = 1.5957691216057308f * (x + 0.044715f * x * x * x); return x / (1.f + __expf(-t)); }
__device__ __forceinline__ float wave_sum(float v) {
#pragma unroll
    for (int o = 1; o < 64; o <<= 1) v += __shfl_xor(v, o);
    return v;
}

namespace pg8 {
constexpr int BM = 256, BK = 64, HALF = 128, HTB = HALF * BK * 2, STAGE_BYTES = 8 * HTB, NXCD = 8, WGM = 8;
__host__ __device__ __forceinline__ int lds_byte(int r, int c) { const int st = (r >> 4) * 2 + (c >> 5), rr = r & 15, cc = c & 31, ob = rr * 64 + cc * 2; return st * 1024 + (ob ^ (((ob >> 9) & 1) << 5)); }
__host__ __device__ __forceinline__ void stage_rc(int b, int& R, int& C) { const int st = b / 1024, sb = b % 1024, swz = sb ^ (((sb >> 9) & 1) << 5); R = (st >> 1) * 16 + swz / 64; C = (st & 1) * 32 + (swz % 64) / 2; }
__host__ __device__ __forceinline__ int perm32(int rho) { const int n = rho >> 4, i = rho & 15; return 8 * (i >> 2) + 4 * n + (i & 3); }
struct Unit { int pm, pn; };
struct Gemm { const h16* A; const h16* Bt; int M, N, K, lda; };
struct StaticOrder {
    int nM, nN, nwg, G, c;
    __device__ void init(int M, int N, int G_, int c_) { nM = M / BM; nN = N / BM; nwg = nM * nN; G = G_; c = c_; }
    __device__ bool next(int i, Unit& u) const {
        const long L = (long)i * G + c; if (L >= nwg) return false;
        int wgid = (int)L; { const int q = nwg / NXCD, r = nwg % NXCD, xcd = wgid % NXCD, off = wgid / NXCD; wgid = (xcd < r ? xcd * (q + 1) : r * (q + 1) + (xcd - r) * q) + off; }
        const int nig = WGM * nN, gid = wgid / nig, fm = gid * WGM, gsz = (nM - fm) < WGM ? (nM - fm) : WGM;
        u.pm = fm + ((wgid % nig) % gsz); u.pn = (wgid % nig) / gsz; return true;
    }
};
template <class Epi>
__device__ __forceinline__ void gemm_phase(LAS unsigned char* lds, const Gemm g, const StaticOrder& S, const Epi& E) {
    const int tid = threadIdx.x, wid = __builtin_amdgcn_readfirstlane(tid >> 6), lane = tid & 63, wr = wid >> 2, wc = wid & 3, fr = lane & 15, fq = lane >> 4;
    const int K = g.K, nt = K / BK, lda = g.lda;
    unsigned voffA[2], voffB[2];
#pragma unroll
    for (int i = 0; i < 2; ++i) { int R, C; stage_rc(tid * 16 + i * 8192, R, C); const int Rb = (R & ~31) + perm32(R & 31);
        voffA[i] = (unsigned)(R * lda + C) * 2u; voffB[i] = (unsigned)(Rb * K + C) * 2u; }
    const size_t kstep = (size_t)(BK * 2);
    const size_t hstepA = (size_t)HALF * lda * 2, hstepB = (size_t)HALF * K * 2;
    const size_t tstepA = 2 * hstepA, tstepB = 2 * hstepB;
    const unsigned ldsw = (unsigned)wid * 1024u;
    const int aoff = lds_byte(wr * 64 + fr, fq * 8), boff = lds_byte(wc * 32 + fr, fq * 8);
#define PG8_SA(b, h) (((b) * 2 + (h)) * HTB)
#define PG8_SB(b, h) ((4 + (b) * 2 + (h)) * HTB)
#define PG8_STAGE(bufoff, gbase, voff) do { _Pragma("unroll") for (int _i = 0; _i < 2; ++_i) \
        __builtin_amdgcn_global_load_lds((const unsigned*)((const char*)(gbase) + (voff)[_i]), (LAS unsigned*)(lds + (bufoff) + ldsw + _i * 8192), 16, 0, 0); } while (0)
#define PG8_LDA(dst, b, h) do { _Pragma("unroll") for (int m = 0; m < 4; ++m) _Pragma("unroll") for (int k = 0; k < 2; ++k) dst[m][k] = *(const LAS h16x8*)(lds + PG8_SA(b, h) + aoff + m * 2048 + k * 1024); } while (0)
#define PG8_LDB(dst, b, h) do { _Pragma("unroll") for (int n = 0; n < 2; ++n) _Pragma("unroll") for (int k = 0; k < 2; ++k) dst[n][k] = *(const LAS h16x8*)(lds + PG8_SB(b, h) + boff + n * 2048 + k * 1024); } while (0)
#define PG8_MMA(ai, bj, At, Bt) do { __builtin_amdgcn_s_setprio(1); _Pragma("unroll") for (int m = 0; m < 4; ++m) _Pragma("unroll") for (int n = 0; n < 2; ++n) _Pragma("unroll") for (int k = 0; k < 2; ++k) \
        acc[ai][bj][m][n] = __builtin_amdgcn_mfma_f32_16x16x32_f16(Bt[n][k], At[m][k], acc[ai][bj][m][n], 0, 0, 0); __builtin_amdgcn_s_setprio(0); } while (0)
#define PG8_WAIT_V(n) asm volatile("s_waitcnt vmcnt(" #n ")" ::: "memory")
#define PG8_WAIT_L(n) asm volatile("s_waitcnt lgkmcnt(" #n ")" ::: "memory")
#define PG8_BAR __builtin_amdgcn_s_barrier()
#define PG8_SCHED __builtin_amdgcn_sched_barrier(0)
    Unit cur, nxt; int ui = 0;
    if (!S.next(0, cur)) return;
    f32x4 acc[2][2][4][2];
#pragma unroll
    for (int a = 0; a < 2; ++a)
#pragma unroll
        for (int b = 0; b < 2; ++b)
#pragma unroll
            for (int m = 0; m < 4; ++m)
#pragma unroll
                for (int n = 0; n < 2; ++n) acc[a][b][m][n] = (f32x4){0.f, 0.f, 0.f, 0.f};
    h16x8 At[4][2], B0[2][2], B1[2][2];
    const char* cA = (const char*)g.A + (size_t)cur.pm * tstepA; const char* cB = (const char*)g.Bt + (size_t)cur.pn * tstepB;
    PG8_STAGE(PG8_SB(0, 0), cB, voffB); PG8_STAGE(PG8_SB(0, 1), cB + hstepB, voffB); PG8_STAGE(PG8_SA(0, 0), cA, voffA); PG8_STAGE(PG8_SA(0, 1), cA + hstepA, voffA);
    if (wr == 1) PG8_BAR;
    PG8_WAIT_V(2); PG8_BAR;
    PG8_STAGE(PG8_SB(1, 0), cB + kstep, voffB); PG8_STAGE(PG8_SA(1, 0), cA + kstep, voffA); PG8_STAGE(PG8_SB(1, 1), cB + hstepB + kstep, voffB);
    PG8_WAIT_V(6); PG8_BAR;
    for (;;) {
        const bool has_next = S.next(ui + 1, nxt);
        const char* nA = has_next ? (const char*)g.A + (size_t)nxt.pm * tstepA : cA; const char* nB = has_next ? (const char*)g.Bt + (size_t)nxt.pn * tstepB : cB;
        for (int t = 0; t < nt; t += 2) {
            const bool last = (t == nt - 2);
            const char* a1 = cA + (size_t)(t + 1) * kstep;
            const char* a2 = last ? nA : cA + (size_t)(t + 2) * kstep; const char* b2 = last ? nB : cB + (size_t)(t + 2) * kstep;
            const char* a3 = a2 + kstep; const char* b3 = b2 + kstep;
            PG8_LDB(B0, 0, 0); PG8_LDB(B1, 0, 1); PG8_SCHED; PG8_LDA(At, 0, 0); PG8_STAGE(PG8_SA(1, 1), a1 + hstepA, voffA);
            PG8_WAIT_V(8); PG8_WAIT_L(0); PG8_BAR; PG8_MMA(0, 0, At, B0); PG8_MMA(0, 1, At, B1); PG8_BAR; PG8_SCHED;
            PG8_LDA(At, 0, 1); PG8_STAGE(PG8_SB(0, 0), b2, voffB); PG8_STAGE(PG8_SB(0, 1), b2 + hstepB, voffB); PG8_STAGE(PG8_SA(0, 0), a2, voffA);
            PG8_WAIT_V(8); PG8_WAIT_L(0); PG8_BAR; PG8_MMA(1, 0, At, B0); PG8_MMA(1, 1, At, B1); PG8_BAR; PG8_SCHED;
            PG8_LDB(B0, 1, 0); PG8_LDB(B1, 1, 1); PG8_SCHED; PG8_LDA(At, 1, 0); PG8_STAGE(PG8_SA(0, 1), a2 + hstepA, voffA);
            PG8_WAIT_V(8); PG8_WAIT_L(0); PG8_BAR; PG8_MMA(0, 0, At, B0); PG8_MMA(0, 1, At, B1); PG8_BAR; PG8_SCHED;
            PG8_LDA(At, 1, 1); PG8_STAGE(PG8_SB(1, 0), b3, voffB); PG8_STAGE(PG8_SB(1, 1), b3 + hstepB, voffB); PG8_STAGE(PG8_SA(1, 0), a3, voffA);
            PG8_WAIT_V(8); PG8_WAIT_L(0); PG8_BAR; PG8_MMA(1, 0, At, B0); PG8_MMA(1, 1, At, B1); PG8_BAR; PG8_SCHED;
        }
        if (wr == 0) PG8_BAR;
        E(acc, cur, wr, wc, fr, fq);
        if (!has_next) break;
#pragma unroll
        for (int a = 0; a < 2; ++a)
#pragma unroll
            for (int b = 0; b < 2; ++b)
#pragma unroll
                for (int m = 0; m < 4; ++m)
#pragma unroll
                    for (int n = 0; n < 2; ++n) acc[a][b][m][n] = (f32x4){0.f, 0.f, 0.f, 0.f};
        cur = nxt; cA = nA; cB = nB; ++ui;
        if (wr == 1) PG8_BAR;
    }
    PG8_WAIT_V(0);
    PG8_BAR;
#undef PG8_SA
#undef PG8_SB
#undef PG8_STAGE
#undef PG8_LDA
#undef PG8_LDB
#undef PG8_MMA
#undef PG8_WAIT_V
#undef PG8_WAIT_L
#undef PG8_BAR
#undef PG8_SCHED
}
}

__device__ __forceinline__ u32x4 pack8(const f32x4 a, const f32x4 b) {
    h16x8 h; h[0] = (h16)a[0]; h[1] = (h16)a[1]; h[2] = (h16)a[2]; h[3] = (h16)a[3]; h[4] = (h16)b[0]; h[5] = (h16)b[1]; h[6] = (h16)b[2]; h[7] = (h16)b[3];
    return __builtin_bit_cast(u32x4, h);
}

struct EpiProj {
    h16* PROJ; const float* rstd; float* dout; h16* KVS; h16* KIS;
    __device__ __forceinline__ void operator()(const f32x4 (&acc)[2][2][4][2], const pg8::Unit& u, int wr, int wc, int fr, int fq) const {
        const int row0 = u.pm * 256 + wr * 64 + fr, col0 = u.pn * 256 + wc * 32 + 8 * fq;
        const int pn = u.pn;
#pragma unroll
        for (int ai = 0; ai < 2; ++ai)
#pragma unroll
            for (int m = 0; m < 4; ++m) {
                const int row = row0 + ai * 128 + m * 16; const float rs = rstd[row];
#pragma unroll
                for (int bj = 0; bj < 2; ++bj) {
                    const int c = col0 + bj * 128;
                    const f32x4 v0 = acc[ai][bj][m][0] * rs, v1 = acc[ai][bj][m][1] * rs;
                    *(u32x4*)(PROJ + (size_t)row * NPJ + c) = pack8(v0, v1);
                    if (pn == 8 || pn == 9 || (pn == 14 && c < C_KI + 64)) {
                        if (row < MP) {
                            float* o = (pn == 8) ? dout + O_PK + (size_t)row * 256 + (c - C_K) : (pn == 9) ? dout + O_PV + (size_t)row * 256 + (c - C_VV) : dout + O_PKI + (size_t)row * 64 + (c - C_KI);
                            *(f32x4*)o = v0; *(f32x4*)(o + 4) = v1;
                        } else if (row < MROWS) {
                            const int t = row - MP, b = t >> 4, s = t & 15; const size_t kr = (size_t)b * NKSP + PAST + s;
                            float* o = (pn == 8) ? dout + O_SK + (size_t)t * 256 + (c - C_K) : (pn == 9) ? dout + O_SV + (size_t)t * 256 + (c - C_VV) : dout + O_SKI + (size_t)t * 64 + (c - C_KI);
                            *(f32x4*)o = v0; *(f32x4*)(o + 4) = v1;
                            h16* ho = (pn == 14) ? KIS + kr * 64 + (c - C_KI) : KVS + kr * 512 + (c - C_K);
                            *(u32x4*)ho = pack8(v0, v1);
                        }
                    }
                }
            }
    }
};
template <int FIRST> struct EpiGate {
    h16* PROJ;
    __device__ __forceinline__ void operator()(const f32x4 (&acc)[2][2][4][2], const pg8::Unit& u, int wr, int wc, int fr, int fq) const {
        const int row0 = u.pm * 256 + wr * 64 + fr, col0 = u.pn * 256 + wc * 32 + 8 * fq;
#pragma unroll
        for (int ai = 0; ai < 2; ++ai)
#pragma unroll
            for (int m = 0; m < 4; ++m) {
                const int row = row0 + ai * 128 + m * 16;
#pragma unroll
                for (int bj = 0; bj < 2; ++bj) {
                    const int c = col0 + bj * 128;
                    h16* pm_ = PROJ + (size_t)row * NPJ + C_GA + c;
                    const h16x8 gt = *(const h16x8*)(PROJ + (size_t)row * NPJ + (FIRST ? C_GA : C_GB) + c);
                    f32x4 v0, v1;
#pragma unroll
                    for (int j = 0; j < 4; ++j) { v0[j] = sigmoidf_((float)gt[j]) * acc[ai][bj][m][0][j]; v1[j] = sigmoidf_((float)gt[4 + j]) * acc[ai][bj][m][1][j]; }
                    if (!FIRST) { const h16x8 tp = *(const h16x8*)pm_;
#pragma unroll
                        for (int j = 0; j < 4; ++j) { v0[j] += (float)tp[j]; v1[j] += (float)tp[4 + j]; } }
                    *(u32x4*)pm_ = pack8(v0, v1);
                }
            }
    }
};
struct EpiOut {
    const float* xp; const float* xs; float* dout; float* rowss;
    __device__ __forceinline__ void operator()(const f32x4 (&acc)[2][2][4][2], const pg8::Unit& u, int wr, int wc, int fr, int fq) const {
        const int row0 = u.pm * 256 + wr * 64 + fr, col0 = u.pn * 256 + wc * 32 + 8 * fq;
#pragma unroll
        for (int ai = 0; ai < 2; ++ai)
#pragma unroll
            for (int m = 0; m < 4; ++m) {
                const int row = row0 + ai * 128 + m * 16;
                const bool ok = row < MROWS;
                const float* xr = (row < MP) ? xp + (size_t)row * DM : xs + (size_t)(row - MP) * DM;
                float* yr = (row < MP) ? dout + O_YP + (size_t)row * DM : dout + O_YS + (size_t)(row - MP) * DM;
                float ss = 0.f;
                if (ok) {
#pragma unroll
                    for (int bj = 0; bj < 2; ++bj) {
                        const int c = col0 + bj * 128;
                        const f32x4 x0 = *(const f32x4*)(xr + c), x1 = *(const f32x4*)(xr + c + 4);
                        const f32x4 v0 = x0 + acc[ai][bj][m][0], v1 = x1 + acc[ai][bj][m][1];
                        *(f32x4*)(yr + c) = v0; *(f32x4*)(yr + c + 4) = v1;
                        ss += v0[0] * v0[0] + v0[1] * v0[1] + v0[2] * v0[2] + v0[3] * v0[3] + v1[0] * v1[0] + v1[1] * v1[1] + v1[2] * v1[2] + v1[3] * v1[3];
                    }
                }
                ss += __shfl_xor(ss, 16); ss += __shfl_xor(ss, 32);
                if (ok && fq == 0) atomicAdd(rowss + row, ss);
            }
    }
};

struct Params {
    const float *xp, *xs, *ck, *cv, *cki, *norm_g, *w_in, *ln_g, *ln_b, *sgu_w, *sgu_b, *w_pa, *w_pb, *w_out, *final_g;
    float* out; unsigned char* ws; int ph_lo, ph_hi;
};

__device__ __forceinline__ void p0_tr_item(const float* W, int K, int Nsrc, h16* WT, const float* gs, int mode, float* scr, int item, int nblk, int lane) {
    const int kb = item / nblk, nb = item % nblk, k0 = 64 * kb, n0 = 32 * nb;
    const int nn = n0 + (lane & 31);
    int src = nn; bool valid = true;
    if (mode == 1) { if (nn >= C_WI + 8 && nn < C_GA) valid = false; else if (nn >= C_GA) src = nn - (C_GA - (C_WI + 8)); }
#pragma unroll 8
    for (int i = 0; i < 32; ++i) { const int kk = 2 * i + (lane >> 5);
        float v = 0.f; if (valid) { v = W[(size_t)(k0 + kk) * Nsrc + src]; if (gs) v *= gs[k0 + kk]; }
        scr[kk * 33 + (lane & 31)] = v; }
    __builtin_amdgcn_s_waitcnt(0); asm volatile("" ::: "memory");
    const int c = lane & 7;
#pragma unroll
    for (int j = 0; j < 4; ++j) { const int n = (lane >> 3) + 8 * j; const float* s = scr + (8 * c) * 33 + n;
        h16x8 h;
#pragma unroll
        for (int q = 0; q < 8; ++q) h[q] = (h16)s[q * 33];
        *(h16x8*)(WT + (size_t)(n0 + n) * K + k0 + 8 * c) = h; }
    __builtin_amdgcn_s_waitcnt(0); asm volatile("" ::: "memory");
}

constexpr int VNT_LD = 136;
__device__ __forceinline__ void sgu_chunk(const Params& p, unsigned char* lds, int chunk, int wave, int lane) {
    h16* PROJ = (h16*)(p.ws + WS_PROJ);
    h16* vnT = (h16*)lds;
    const h16* WSM = (const h16*)(p.ws + WS_WSM);
    {
        float lg[8], lb[8];
#pragma unroll
        for (int j = 0; j < 8; ++j) { lg[j] = p.ln_g[lane * 8 + j]; lb[j] = p.ln_b[lane * 8 + j]; }
        for (int tt = 0; tt < 16; ++tt) {
            const int tok = wave * 16 + tt; const size_t row = (size_t)chunk * 128 + tok;
            const h16x8 vv = *(const h16x8*)(PROJ + row * NPJ + C_V + lane * 8);
            float g[8]; float s = 0.f;
#pragma unroll
            for (int j = 0; j < 8; ++j) { g[j] = geluf_((float)vv[j]); s += g[j]; }
            const float mean = wave_sum(s) * (1.f / 512.f); float q = 0.f;
#pragma unroll
            for (int j = 0; j < 8; ++j) { g[j] -= mean; q += g[j] * g[j]; }
            const float rstd = rsqrtf(wave_sum(q) * (1.f / 512.f) + 1e-5f);
#pragma unroll
            for (int j = 0; j < 8; ++j) vnT[(lane * 8 + j) * VNT_LD + tok] = (h16)(g[j] * rstd * lg[j] + lb[j]);
        }
    }
    __syncthreads();
    {
        const int g = wave, fr = lane & 15, fq = lane >> 4;
        for (int it = 0; it < 8; ++it) {
            f32x4 acc[4];
#pragma unroll
            for (int dt = 0; dt < 4; ++dt) acc[dt] = (f32x4){0.f, 0.f, 0.f, 0.f};
            const int nks = (it < 4) ? 2 : 4;
            for (int ks = 0; ks < nks; ++ks) {
                const h16x8 b = *(const h16x8*)(WSM + ((size_t)g * 128 + it * 16 + fr) * 128 + ks * 32 + fq * 8);
#pragma unroll
                for (int dt = 0; dt < 4; ++dt) {
                    const h16x8 a = *(const h16x8*)(vnT + (g * 64 + dt * 16 + fr) * VNT_LD + ks * 32 + fq * 8);
                    acc[dt] = __builtin_amdgcn_mfma_f32_16x16x32_f16(a, b, acc[dt], 0, 0, 0);
                }
            }
            const int i = it * 16 + fr; const size_t row = (size_t)chunk * 128 + i;
            const float bias = p.sgu_b[g * 128 + i];
#pragma unroll
            for (int dt = 0; dt < 4; ++dt) {
                const int c = g * 64 + dt * 16 + fq * 4;
                h16* pu = PROJ + row * NPJ + C_U + c;
                const h16x4 uu = *(const h16x4*)pu; const h16x4 zz = *(const h16x4*)(PROJ + row * NPJ + C_ZA + c);
                h16x4 o;
#pragma unroll
                for (int r = 0; r < 4; ++r) o[r] = (h16)(geluf_((float)uu[r]) * (acc[dt][r] + bias) * siluf_((float)zz[r]));
                *(h16x4*)pu = o;
            }
        }
    }
    __syncthreads();
}
__device__ __forceinline__ void sgu_sample(const Params& p, unsigned char* lds, int b, int wave, int lane) {
    h16* PROJ = (h16*)(p.ws + WS_PROJ);
    float* vnS = (float*)lds;
    for (int tt = 0; tt < 2; ++tt) {
        const int t = wave * 2 + tt; const size_t row = (size_t)MP + b * 16 + t;
        const h16x8 vv = *(const h16x8*)(PROJ + row * NPJ + C_V + lane * 8);
        float g[8]; float s = 0.f;
#pragma unroll
        for (int j = 0; j < 8; ++j) { g[j] = geluf_((float)vv[j]); s += g[j]; }
        const float mean = wave_sum(s) * (1.f / 512.f); float q = 0.f;
#pragma unroll
        for (int j = 0; j < 8; ++j) { g[j] -= mean; q += g[j] * g[j]; }
        const float rstd = rsqrtf(wave_sum(q) * (1.f / 512.f) + 1e-5f);
#pragma unroll
        for (int j = 0; j < 8; ++j) { const int c = lane * 8 + j; const float v = g[j] * rstd * p.ln_g[c] + p.ln_b[c];
            vnS[t * 512 + c] = v; p.out[O_SSV + (size_t)(b * 16 + t) * 512 + c] = v; }
    }
    __syncthreads();
    {
        const int c = threadIdx.x, g = c >> 6;
        float vn[16];
#pragma unroll
        for (int j = 0; j < 16; ++j) vn[j] = vnS[j * 512 + c];
        for (int i = 0; i < 16; ++i) {
            float mixed = p.sgu_b[g * 128 + i];
#pragma unroll
            for (int j = 0; j < 16; ++j) mixed += p.sgu_w[((size_t)g * 128 + i) * 128 + j] * vn[j];
            const size_t row = (size_t)MP + b * 16 + i;
            const float u = (float)PROJ[row * NPJ + C_U + c], za = (float)PROJ[row * NPJ + C_ZA + c];
            PROJ[row * NPJ + C_U + c] = (h16)(geluf_(u) * mixed * siluf_(za));
        }
    }
    __syncthreads();
}

constexpr int TK_C = 2048, TK_TRIG = TK_C - 512;
constexpr int L3_HIST = 131072, L3_CNT = L3_HIST + 8192, L3_THR = L3_CNT + 32, L3_SUM = L3_THR + 32;
__device__ __forceinline__ unsigned fkey(float f) { const unsigned u = __float_as_uint(f); return (u & 0x80000000u) ? ~u : (u | 0x80000000u); }
__device__ __forceinline__ float fkey_inv(unsigned k) { return __uint_as_float((k & 0x80000000u) ? (k ^ 0x80000000u) : ~k); }

template <bool ON_LO>
__device__ __forceinline__ unsigned radix_select(const u64* buf, unsigned* hist, int n, int lane, unsigned fhi, int k, int& ceq_out, int& krem_out) {
    unsigned prefix = 0, pmask = 0; int krem = k; int ceq = 0;
    for (int shift = 24; shift >= 0; shift -= 8) {
        *(u32x4*)(hist + 4 * lane) = (u32x4){0u, 0u, 0u, 0u};
        __builtin_amdgcn_s_waitcnt(0); asm volatile("" ::: "memory");
        for (int i = lane; i < n; i += 64) {
            const u64 e = buf[i]; const unsigned hi = (unsigned)(e >> 32), lo = (unsigned)e;
            const unsigned key = ON_LO ? lo : hi;
            const bool ok = (ON_LO ? (hi == fhi) : true) && ((key & pmask) == prefix);
            if (ok) atomicAdd(hist + ((key >> shift) & 255u), 1u);
        }
        __builtin_amdgcn_s_waitcnt(0); asm volatile("" ::: "memory");
        const u32x4 hv = *(const u32x4*)(hist + 4 * lane);
        const unsigned s = hv.x + hv.y + hv.z + hv.w;
        unsigned S = s;
#pragma unroll
        for (int o = 1; o < 64; o <<= 1) { const unsigned t = __shfl_down(S, o); if (lane + o < 64) S += t; }
        const bool is = (S >= (unsigned)krem) && (S - s < (unsigned)krem);
        const u64 bm = __ballot(is);
        const int L = bm ? (__ffsll((long long)bm) - 1) : 0;
        unsigned d = 0, cab = S - s, ce = 0;
        { unsigned c = S - s;
          if (c + hv.w >= (unsigned)krem) { d = 3; cab = c; ce = hv.w; }
          else { c += hv.w; if (c + hv.z >= (unsigned)krem) { d = 2; cab = c; ce = hv.z; }
          else { c += hv.z; if (c + hv.y >= (unsigned)krem) { d = 1; cab = c; ce = hv.y; }
          else { c += hv.y; d = 0; cab = c; ce = hv.x; } } } }
        d = __shfl(d, L); cab = __shfl(cab, L); ce = __shfl(ce, L);
        const unsigned digit = 4u * (unsigned)L + d;
        krem -= (int)cab; ceq = (int)ce; prefix |= digit << shift; pmask |= 255u << shift;
    }
    ceq_out = ceq; krem_out = krem;
    return prefix;
}
__device__ __forceinline__ int tk_compact(u64* buf, unsigned* hist, int n, int lane, float& thr) {
    int ceq, krem;
    const unsigned thi = radix_select<false>(buf, hist, n, lane, 0u, 256, ceq, krem);
    unsigned tlo = 0u;
    if (ceq != krem) { int c2, k2; tlo = radix_select<true>(buf, hist, n, lane, thi, krem, c2, k2); }
    int outn = 0;
    for (int base = 0; base < n; base += 64) {
        const int i = base + lane; bool keep = false; u64 e = 0;
        if (i < n) { e = buf[i]; const unsigned hi = (unsigned)(e >> 32), lo = (unsigned)e; keep = (hi > thi) || (hi == thi && lo >= tlo); }
        const u64 bm = __ballot(keep);
        const int off = __builtin_amdgcn_mbcnt_hi((unsigned)(bm >> 32), __builtin_amdgcn_mbcnt_lo((unsigned)bm, 0u));
        __builtin_amdgcn_s_waitcnt(0); asm volatile("" ::: "memory");
        if (keep) buf[outn + off] = e;
        outn += __popcll(bm);
    }
    __builtin_amdgcn_s_waitcnt(0); asm volatile("" ::: "memory");
    thr = fkey_inv(thi);
    return outn;
}

struct AUnit { int qrow0, krow0, nk; const h16* kib; int kis; const h16* kvb; int kvs; };

__device__ __forceinline__ void attn_unit(const Params& p, unsigned char* lds, const AUnit U, int wave, int lane) {
    h16* PROJ = (h16*)(p.ws + WS_PROJ);
    u64* bufall = (u64*)lds;
    unsigned* hist = (unsigned*)(lds + L3_HIST) + wave * 256;
    unsigned* cnt = (unsigned*)(lds + L3_CNT);
    float* thrs = (float*)(lds + L3_THR);
    float* sums = (float*)(lds + L3_SUM) + wave * 8;
    const int half = lane >> 5, l31 = lane & 31;
    if (threadIdx.x < 8) { cnt[threadIdx.x] = 0u; thrs[threadIdx.x] = -__builtin_inff(); }
    h16x8 qa[2][4]; float wq[2][2][8];
    {
        const int ql = 2 * ((l31 >> 2) & 1) + (l31 >> 4), hh = ((l31 >> 3) & 1) * 4 + (l31 & 3);
#pragma unroll
        for (int mt = 0; mt < 2; ++mt) {
            const h16* qp = PROJ + (size_t)(U.qrow0 + mt * 4 + ql) * NPJ + C_QI + hh * 64 + half * 8;
#pragma unroll
            for (int ks = 0; ks < 4; ++ks) qa[mt][ks] = *(const h16x8*)(qp + ks * 16);
#pragma unroll
            for (int e = 0; e < 2; ++e) {
                const h16x8 w8 = *(const h16x8*)(PROJ + (size_t)(U.qrow0 + mt * 4 + 2 * half + e) * NPJ + C_WI);
#pragma unroll
                for (int h = 0; h < 8; ++h) wq[mt][e][h] = (float)w8[h];
            }
        }
    }
    float th[2][2];
#pragma unroll
    for (int mt = 0; mt < 2; ++mt)
#pragma unroll
        for (int e = 0; e < 2; ++e) th[mt][e] = -__builtin_inff();
    __syncthreads();
    const int nkt = (U.nk + 31) >> 5, rounds = (nkt + 15) >> 4;
    for (int rd = 0; rd < rounds; ++rd) {
        h16x8 bf[2][4];
#pragma unroll
        for (int rr = 0; rr < 2; ++rr) {
            const int kt = rd * 16 + rr * 8 + wave;
            if (kt < nkt) {
                const h16* kp = U.kib + (size_t)(U.krow0 + kt * 32 + l31) * U.kis + half * 8;
#pragma unroll
                for (int ks = 0; ks < 4; ++ks) bf[rr][ks] = *(const h16x8*)(kp + ks * 16);
            }
        }
#pragma unroll
        for (int rr = 0; rr < 2; ++rr) {
            const int kt = rd * 16 + rr * 8 + wave;
            if (kt < nkt) {
                f32x16 c0, c1;
#pragma unroll
                for (int r = 0; r < 16; ++r) { c0[r] = 0.f; c1[r] = 0.f; }
#pragma unroll
                for (int ks = 0; ks < 4; ++ks) { c0 = __builtin_amdgcn_mfma_f32_32x32x16_f16(qa[0][ks], bf[rr][ks], c0, 0, 0, 0); c1 = __builtin_amdgcn_mfma_f32_32x32x16_f16(qa[1][ks], bf[rr][ks], c1, 0, 0, 0); }
                const int key = kt * 32 + l31; const bool kvalid = key < U.nk;
#pragma unroll
                for (int mt = 0; mt < 2; ++mt)
#pragma unroll
                    for (int e = 0; e < 2; ++e) {
                        float s = 0.f;
#pragma unroll
                        for (int h = 0; h < 8; ++h) s += wq[mt][e][h] * fmaxf(mt ? c1[e * 8 + h] : c0[e * 8 + h], 0.f);
                        const bool pass = kvalid && (s > th[mt][e]);
                        const u64 bm = __ballot(pass);
                        if (bm) {
                            const unsigned blo = (unsigned)bm, bhi = (unsigned)(bm >> 32);
                            const int q0 = mt * 4 + e, q1 = mt * 4 + 2 + e;
                            unsigned base = 0u;
                            if (lane == 0 && blo) base = atomicAdd(cnt + q0, (unsigned)__popc(blo));
                            if (lane == 32 && bhi) base = atomicAdd(cnt + q1, (unsigned)__popc(bhi));
                            base = __shfl(base, half * 32);
                            if (pass) {
                                const unsigned hm = half ? bhi : blo;
                                const unsigned pos = base + (unsigned)__popc(hm & ((1u << l31) - 1u));
                                const int q = half ? q1 : q0;
                                bufall[(size_t)q * TK_C + pos] = ((u64)fkey(s) << 32) | (u64)(~(unsigned)key);
                            }
                        }
                    }
            }
        }
        __syncthreads();
        bool need = false;
#pragma unroll
        for (int q = 0; q < 8; ++q) need = need || (cnt[q] > (unsigned)TK_TRIG);
        __syncthreads();
        if (need && rd + 1 < rounds) {
            const int n = (int)cnt[wave];
            if (n > 256) { float t; const int nn = tk_compact(bufall + (size_t)wave * TK_C, hist, n, lane, t); if (lane == 0) { cnt[wave] = (unsigned)nn; thrs[wave] = t; } }
            __syncthreads();
#pragma unroll
            for (int mt = 0; mt < 2; ++mt)
#pragma unroll
                for (int e = 0; e < 2; ++e) th[mt][e] = thrs[mt * 4 + 2 * half + e];
        }
    }
    u64* buf = bufall + (size_t)wave * TK_C;
    int n = (int)cnt[wave];
    if (n > 256) { float t; n = tk_compact(buf, hist, n, lane, t); }
    const int qrow = U.qrow0 + wave;
    float* P = (float*)((unsigned char*)buf + 4096);
    {
        const int fr = lane & 15, fq = lane >> 4;
        h16x8 qf[2];
#pragma unroll
        for (int ks = 0; ks < 2; ++ks) {
            if (fr < 8) qf[ks] = *(const h16x8*)(PROJ + (size_t)qrow * NPJ + C_Q + fr * 64 + ks * 32 + fq * 8);
            else {
#pragma unroll
                for (int j = 0; j < 8; ++j) qf[ks][j] = (h16)0.f; }
        }
        h16x8 zero8;
#pragma unroll
        for (int j = 0; j < 8; ++j) zero8[j] = (h16)0.f;
        f32x4 acc[16];
#pragma unroll
        for (int t = 0; t < 16; ++t) {
            acc[t] = (f32x4){0.f, 0.f, 0.f, 0.f};
            if (t * 16 < n) {
                const int s = t * 16 + fr; const unsigned idx = (s < n) ? ~(unsigned)buf[s] : 0u;
                const h16* kr = U.kvb + (size_t)(U.krow0 + (int)idx) * U.kvs + fq * 8;
#pragma unroll
                for (int j = 0; j < 4; ++j)
#pragma unroll
                    for (int ks = 0; ks < 2; ++ks) {
                        const h16x8 b = *(const h16x8*)(kr + j * 64 + ks * 32);
                        const h16x8 a = ((fr >> 1) == j) ? qf[ks] : zero8;
                        acc[t] = __builtin_amdgcn_mfma_f32_16x16x32_f16(a, b, acc[t], 0, 0, 0);
                    }
            }
        }
        float mx[4] = {-1e30f, -1e30f, -1e30f, -1e30f};
#pragma unroll
        for (int t = 0; t < 16; ++t) { const bool v = (t * 16 + fr) < n;
#pragma unroll
            for (int r = 0; r < 4; ++r) { acc[t][r] = v ? acc[t][r] * 0.125f : -1e30f; mx[r] = fmaxf(mx[r], acc[t][r]); } }
#pragma unroll
        for (int r = 0; r < 4; ++r) {
#pragma unroll
            for (int o = 1; o < 16; o <<= 1) mx[r] = fmaxf(mx[r], __shfl_xor(mx[r], o)); }
        float sm[4] = {0.f, 0.f, 0.f, 0.f};
#pragma unroll
        for (int t = 0; t < 16; ++t) { const bool v = (t * 16 + fr) < n;
#pragma unroll
            for (int r = 0; r < 4; ++r) { const float e = v ? __expf(acc[t][r] - mx[r]) : 0.f; acc[t][r] = e; sm[r] += e; } }
#pragma unroll
        for (int r = 0; r < 4; ++r) {
#pragma unroll
            for (int o = 1; o < 16; o <<= 1) sm[r] += __shfl_xor(sm[r], o); }
        __builtin_amdgcn_s_waitcnt(0); asm volatile("" ::: "memory");
        if (fq < 2) {
#pragma unroll
            for (int t = 0; t < 16; ++t) *(f32x4*)(P + (t * 16 + fr) * 8 + fq * 4) = acc[t];
            if (fr == 0) {
#pragma unroll
                for (int r = 0; r < 4; ++r) sums[fq * 4 + r] = sm[r]; }
        }
        __builtin_amdgcn_s_waitcnt(0); asm volatile("" ::: "memory");
    }
    {
        const int sp = lane >> 5, part = lane & 31, kv = part >> 3, d0 = (part & 7) * 8;
        float o0[8], o1[8];
#pragma unroll
        for (int j = 0; j < 8; ++j) { o0[j] = 0.f; o1[j] = 0.f; }
        for (int i = 0; 2 * i < n; ++i) {
            const int s = 2 * i + sp; const bool v = s < n; const unsigned idx = v ? ~(unsigned)buf[s] : 0u;
            const h16x8 vv = *(const h16x8*)(U.kvb + (size_t)(U.krow0 + (int)idx) * U.kvs + 256 + kv * 64 + d0);
            f32x2 pp = (f32x2){0.f, 0.f}; if (v) pp = *(const f32x2*)(P + s * 8 + 2 * kv);
#pragma unroll
            for (int j = 0; j < 8; ++j) { const float x = (float)vv[j]; o0[j] += pp.x * x; o1[j] += pp.y * x; }
        }
#pragma unroll
        for (int j = 0; j < 8; ++j) { o0[j] += __shfl_xor(o0[j], 32); o1[j] += __shfl_xor(o1[j], 32); }
        if (sp == 0) {
            const float i0 = 1.f / sums[2 * kv], i1 = 1.f / sums[2 * kv + 1];
            h16* pz = PROJ + (size_t)qrow * NPJ + C_ZB + (2 * kv) * 64 + d0;
            h16* po = PROJ + (size_t)qrow * NPJ + C_Q + (2 * kv) * 64 + d0;
            const h16x8 z0 = *(const h16x8*)pz, z1 = *(const h16x8*)(pz + 64);
            h16x8 r0, r1;
#pragma unroll
            for (int j = 0; j < 8; ++j) { r0[j] = (h16)(o0[j] * i0 * siluf_((float)z0[j])); r1[j] = (h16)(o1[j] * i1 * siluf_((float)z1[j])); }
            *(h16x8*)po = r0; *(h16x8*)(po + 64) = r1;
        }
    }
    __syncthreads();
}

__global__ void __launch_bounds__(512, 2) mk_fwd(Params p) {
    extern __shared__ __attribute__((aligned(16))) unsigned char lds[];
    cg::grid_group grid = cg::this_grid();
    const int tid = threadIdx.x, lane = tid & 63, wave = __builtin_amdgcn_readfirstlane(tid >> 6);
    const int G = gridDim.x, bx = blockIdx.x;
    const int gw = bx * 8 + wave, NGW = G * 8;
    const int lo = p.ph_lo, hi = p.ph_hi;
#define IN(k) (lo <= (k) && (k) < hi)
#define SEAM(k) do { if (IN(k) && IN((k) + 1)) grid.sync(); } while (0)
    h16* XH = (h16*)(p.ws + WS_XH); h16* PROJ = (h16*)(p.ws + WS_PROJ);
    h16* WIN = (h16*)(p.ws + WS_WIN); h16* WPA = (h16*)(p.ws + WS_WPA); h16* WPB = (h16*)(p.ws + WS_WPB); h16* WOUT = (h16*)(p.ws + WS_WOUT);
    h16* WSM = (h16*)(p.ws + WS_WSM); h16* KVS = (h16*)(p.ws + WS_KVS); h16* KIS = (h16*)(p.ws + WS_KIS);
    float* RSTD = (float*)(p.ws + WS_RSTD); float* ROWSS = (float*)(p.ws + WS_ROWSS);

    if (IN(0)) {
        float* scr = (float*)(lds + wave * 16384);
        constexpr int I_IN = 16 * (NPJ / 32), I_PA = 8 * 32, I_PB = 8 * 32, I_OUT = 16 * 32;
        for (int it = gw; it < I_IN + I_PA + I_PB + I_OUT; it += NGW) {
            int r = it;
            if (r < I_IN) { p0_tr_item(p.w_in, 1024, INW, WIN, p.norm_g, 1, scr, r, NPJ / 32, lane); continue; } r -= I_IN;
            if (r < I_PA) { p0_tr_item(p.w_pa, 512, 1024, WPA, nullptr, 0, scr, r, 32, lane); continue; } r -= I_PA;
            if (r < I_PB) { p0_tr_item(p.w_pb, 512, 1024, WPB, nullptr, 0, scr, r, 32, lane); continue; } r -= I_PB;
            p0_tr_item(p.w_out, 1024, 1024, WOUT, nullptr, 0, scr, r, 32, lane);
        }
        for (int m = gw; m < MT; m += NGW) {
            u64* o8 = (u64*)(XH + (size_t)m * DM) + lane;
            if (m < MROWS) {
                const float* xr = (m < MP) ? p.xp + (size_t)m * DM : p.xs + (size_t)(m - MP) * DM;
                const f32x4* x4 = (const f32x4*)xr + lane;
                f32x4 v[4]; float s = 0.f;
#pragma unroll
                for (int j = 0; j < 4; ++j) { v[j] = x4[64 * j]; s += (v[j].x * v[j].x + v[j].y * v[j].y) + (v[j].z * v[j].z + v[j].w * v[j].w); }
                s = wave_sum(s);
                if (lane == 0) { RSTD[m] = rsqrtf(s * (1.f / 1024.f) + 1e-6f); ROWSS[m] = 0.f; }
#pragma unroll
                for (int j = 0; j < 4; ++j) { h16x4 h; h[0] = (h16)v[j].x; h[1] = (h16)v[j].y; h[2] = (h16)v[j].z; h[3] = (h16)v[j].w; o8[64 * j] = __builtin_bit_cast(u64, h); }
            } else {
                if (lane == 0) { RSTD[m] = 0.f; ROWSS[m] = 0.f; }
#pragma unroll
                for (int j = 0; j < 4; ++j) o8[64 * j] = 0ull;
            }
        }
        const int gt = bx * 512 + tid, NGT = G * 512;
        for (int i = gt; i < NB * NKSP * 64; i += NGT) {
            const int c8 = (i & 63) * 8, r = (i >> 6) % NKSP, b = (i >> 6) / NKSP;
            if (r >= PAST && r < NKS) continue;
            h16x8 h;
            if (r < PAST) { const float* src = (c8 < 256) ? p.ck + ((size_t)b * PAST + r) * 256 + c8 : p.cv + ((size_t)b * PAST + r) * 256 + (c8 - 256);
#pragma unroll
                for (int j = 0; j < 8; ++j) h[j] = (h16)src[j]; }
            else {
#pragma unroll
                for (int j = 0; j < 8; ++j) h[j] = (h16)0.f; }
            *(h16x8*)(KVS + ((size_t)b * NKSP + r) * 512 + c8) = h;
        }
        for (int i = gt; i < NB * NKSP * 8; i += NGT) {
            const int c8 = (i & 7) * 8, r = (i >> 3) % NKSP, b = (i >> 3) / NKSP;
            if (r >= PAST && r < NKS) continue;
            h16x8 h;
            if (r < PAST) { const float* src = p.cki + ((size_t)b * PAST + r) * 64 + c8;
#pragma unroll
                for (int j = 0; j < 8; ++j) h[j] = (h16)src[j]; }
            else {
#pragma unroll
                for (int j = 0; j < 8; ++j) h[j] = (h16)0.f; }
            *(h16x8*)(KIS + ((size_t)b * NKSP + r) * 64 + c8) = h;
        }
        for (int i = gt; i < 8 * 128 * 128; i += NGT) { const int j = i & 127, ii = (i >> 7) & 127; WSM[i] = ((j >> 6) <= (ii >> 6)) ? (h16)p.sgu_w[i] : (h16)0.f; }
    }
    SEAM(0);
    if (IN(1)) {
        pg8::Gemm g{XH, WIN, MT, NPJ, 1024, 1024}; pg8::StaticOrder S; S.init(MT, NPJ, G, bx);
        EpiProj E{PROJ, RSTD, p.out, KVS, KIS};
        pg8::gemm_phase<EpiProj>((LAS unsigned char*)lds, g, S, E);
    }
    SEAM(1);
    if (IN(2)) {
        for (int u = bx; u < 512 + NB; u += G) { if (u < 512) sgu_chunk(p, lds, u, wave, lane); else sgu_sample(p, lds, u - 512, wave, lane); }
    }
    if (IN(3)) {
        for (int u = bx; u < 8192 + 16; u += G) {
            AUnit U;
            if (u < 8192) { const int i = u >> 8, gp = u & 255, b = gp & 7, s = gp >> 3; const int jt = (i & 1) ? (31 - s) + 32 * i : s + 32 * i;
                U.qrow0 = b * SEQ + jt * 8; U.krow0 = b * SEQ; U.nk = ((jt * 8) / 64 + 1) * 64; U.kib = PROJ + C_KI; U.kis = NPJ; U.kvb = PROJ + C_K; U.kvs = NPJ; }
            else { const int v = u - 8192, b = v >> 1, hf = v & 1;
                U.qrow0 = MP + b * 16 + hf * 8; U.krow0 = b * NKSP; U.nk = NKS; U.kib = KIS; U.kis = 64; U.kvb = KVS; U.kvs = 512; }
            attn_unit(p, lds, U, wave, lane);
        }
    }
    SEAM(3);
    if (IN(4)) {
        { pg8::Gemm g{PROJ + C_U, WPA, MT, 1024, 512, NPJ}; pg8::StaticOrder S; S.init(MT, 1024, G, bx); EpiGate<1> E{PROJ}; pg8::gemm_phase<EpiGate<1>>((LAS unsigned char*)lds, g, S, E); }
        { pg8::Gemm g{PROJ + C_Q, WPB, MT, 1024, 512, NPJ}; pg8::StaticOrder S; S.init(MT, 1024, G, bx); EpiGate<0> E{PROJ}; pg8::gemm_phase<EpiGate<0>>((LAS unsigned char*)lds, g, S, E); }
    }
    SEAM(4);
    if (IN(5)) {
        pg8::Gemm g{PROJ + C_GA, WOUT, MT, 1024, 1024, NPJ}; pg8::StaticOrder S; S.init(MT, 1024, G, bx);
        EpiOut E{p.xp, p.xs, p.out, ROWSS};
        pg8::gemm_phase<EpiOut>((LAS unsigned char*)lds, g, S, E);
    }
    SEAM(5);
    if (IN(6)) {
        for (int m = gw; m < MROWS; m += NGW) {
            float* yr = (m < MP) ? p.out + O_YP + (size_t)m * DM : p.out + O_YS + (size_t)(m - MP) * DM;
            const float r = rsqrtf(ROWSS[m] * (1.f / 1024.f) + 1e-6f);
            f32x4* y4 = (f32x4*)yr + lane; const f32x4* g4 = (const f32x4*)p.final_g + lane;
#pragma unroll
            for (int j = 0; j < 4; ++j) { f32x4 v = y4[64 * j]; const f32x4 gg = g4[64 * j]; v = v * r * gg; y4[64 * j] = v; }
        }
    }
#undef IN
#undef SEAM
}

extern "C" void kernel_launch(void* const* d_in, const int* in_sizes, int n_in, void* d_out, int out_size, void* d_ws, size_t ws_size, hipStream_t stream) {
    static int grid_blocks = 0;
    if (grid_blocks == 0) {
        if (ws_size < WS_END) { fprintf(stderr, "kernel_launch: workspace too small: %zu < %zu\n", ws_size, (size_t)WS_END); grid_blocks = -1; return; }
        int dev = 0, cus = 0, per_cu = 0;
        hipGetDevice(&dev);
        hipDeviceGetAttribute(&cus, hipDeviceAttributeMultiprocessorCount, dev);
        hipFuncSetAttribute((const void*)mk_fwd, hipFuncAttributeMaxDynamicSharedMemorySize, LDS_BYTES);
        hipOccupancyMaxActiveBlocksPerMultiprocessor(&per_cu, (const void*)mk_fwd, 512, LDS_BYTES);
        if (per_cu < 1) { fprintf(stderr, "kernel_launch: occupancy query says %d blocks per CU\n", per_cu); per_cu = 1; }
        grid_blocks = cus * per_cu;
        (void)hipGetLastError();
    }
    if (grid_blocks < 0) return;
    Params p{};
    p.xp = (const float*)d_in[0]; p.xs = (const float*)d_in[1]; p.ck = (const float*)d_in[2]; p.cv = (const float*)d_in[3]; p.cki = (const float*)d_in[4];
    p.norm_g = (const float*)d_in[5]; p.w_in = (const float*)d_in[6]; p.ln_g = (const float*)d_in[7]; p.ln_b = (const float*)d_in[8];
    p.sgu_w = (const float*)d_in[9]; p.sgu_b = (const float*)d_in[10]; p.w_pa = (const float*)d_in[11]; p.w_pb = (const float*)d_in[12];
    p.w_out = (const float*)d_in[13]; p.final_g = (const float*)d_in[14];
    p.out = (float*)d_out; p.ws = (unsigned char*)d_ws; p.ph_lo = 0; p.ph_hi = 7;
    void* args[] = {&p};
    hipError_t e = hipLaunchCooperativeKernel((const void*)mk_fwd, dim3(grid_blocks), dim3(512), args, LDS_BYTES, stream);
    if (e != hipSuccess) fprintf(stderr, "cooperative launch failed: %s (grid %d)\n", hipGetErrorString(e), grid_blocks);
}
```

```cpp
#include <hip/hip_runtime.h>
#include <hip/hip_cooperative_groups.h>
#include <cstdio>
#include <cstdint>
namespace cg = cooperative_groups;
#define REP_P0 1
#define REP_P1 1
#define REP_P2 1
#define REP_P3 1
#define REP_IDX 1
#define REP_ATT 1
#define TSEL 0
__device__ __forceinline__ unsigned long long rt_() { return __builtin_amdgcn_s_memrealtime(); }
#define TBEG(k) unsigned long long tb_##k = 0; if (TSEL == (k)) tb_##k = rt_();
#define TEND(k) if (TSEL == (k)) tacc += rt_() - tb_##k;
#define REP_P4 1
#define REP_P5 1

#define LAS __attribute__((address_space(3)))
typedef _Float16 h16;
typedef _Float16 h16x8 __attribute__((ext_vector_type(8)));
typedef _Float16 h16x4 __attribute__((ext_vector_type(4)));
typedef _Float16 h16x2 __attribute__((ext_vector_type(2)));
typedef float f32x2 __attribute__((ext_vector_type(2)));
typedef float f32x4 __attribute__((ext_vector_type(4)));
typedef float f32x16 __attribute__((ext_vector_type(16)));
typedef unsigned u32x4 __attribute__((ext_vector_type(4)));
typedef unsigned u32x2 __attribute__((ext_vector_type(2)));
typedef unsigned long long u64;

constexpr int DM = 1024, SEQ = 8192, NB = 8, MP = NB * SEQ;
constexpr int DSQ = 16, MS = NB * DSQ, PAST = 1024, NKS = PAST + DSQ, NKSP = 1056;
constexpr int MROWS = MP + MS;
constexpr int MT = MP + 256;
constexpr int INW = 5704, NPJ = 5888;
constexpr int C_U = 0, C_V = 512, C_ZA = 1024, C_Q = 1536, C_K = 2048, C_VV = 2304, C_ZB = 2560, C_QI = 3072, C_KI = 3584, C_WI = 3648, C_GA = 3840, C_GB = 4864;
constexpr size_t O_YP = 0, O_YS = 67108864, O_PK = 67239936, O_PV = 84017152, O_PKI = 100794368, O_SK = 104988672, O_SV = 105021440, O_SKI = 105054208, O_SSV = 105062400;
constexpr size_t WS_XH = 0;
constexpr size_t WS_PROJ = WS_XH + (size_t)MT * DM * 2;
constexpr size_t WS_WIN = WS_PROJ + (size_t)MT * NPJ * 2;
constexpr size_t WS_WPA = WS_WIN + (size_t)NPJ * DM * 2;
constexpr size_t WS_WPB = WS_WPA + (size_t)1024 * 512 * 2;
constexpr size_t WS_WOUT = WS_WPB + (size_t)1024 * 512 * 2;
constexpr size_t WS_WSM = WS_WOUT + (size_t)1024 * 1024 * 2;
constexpr size_t WS_KVS = WS_WSM + (size_t)8 * 128 * 128 * 2;
constexpr size_t WS_KIS = WS_KVS + (size_t)NB * NKSP * 512 * 2;
constexpr size_t WS_RSTD = WS_KIS + (size_t)NB * NKSP * 64 * 2;
constexpr size_t WS_ROWSS = WS_RSTD + (size_t)MT * 4;
constexpr size_t WS_END = WS_ROWSS + (size_t)MT * 16 * 4;
constexpr size_t WS_AOUT = WS_XH, WS_BOUT = WS_XH + (size_t)MT * 512 * 2;
constexpr int C_T = 0, C_M = 1024;
constexpr int LDS_BYTES = 147456;

__device__ __forceinline__ float sigmoidf_(float x) { return 1.f / (1.f + __expf(-x)); }
__device__ __forceinline__ float siluf_(float x) { return x / (1.f + __expf(-x)); }
__device__ __forceinline__ float geluf_(float x) { const float t = 1.5957691216057308f * (x + 0.044715f * x * x * x); return x / (1.f + __expf(-t)); }
__device__ __forceinline__ float wave_sum(float v) {
#pragma unroll
    for (int o = 1; o < 64; o <<= 1) v += __shfl_xor(v, o);
    return v;
}

namespace pg8 {
constexpr int BM = 256, BK = 64, HALF = 128, HTB = HALF * BK * 2, STAGE_BYTES = 8 * HTB, NXCD = 8, WGM = 8;
__host__ __device__ __forceinline__ int lds_byte(int r, int c) { const int st = (r >> 4) * 2 + (c >> 5), rr = r & 15, cc = c & 31, ob = rr * 64 + cc * 2; return st * 1024 + (ob ^ (((ob >> 9) & 1) << 5)); }
__host__ __device__ __forceinline__ void stage_rc(int b, int& R, int& C) { const int st = b / 1024, sb = b % 1024, swz = sb ^ (((sb >> 9) & 1) << 5); R = (st >> 1) * 16 + swz / 64; C = (st & 1) * 32 + (swz % 64) / 2; }
__host__ __device__ __forceinline__ int perm32(int rho) { const int n = rho >> 4, i = rho & 15; return 8 * (i >> 2) + 4 * n + (i & 3); }
struct Unit { int pm, pn; };
struct Gemm { const h16* A; const h16* Bt; int M, N, K, lda; };
struct StaticOrder {
    int nM, nN, nwg, G, c;
    __device__ void init(int M, int N, int G_, int c_) { nM = M / BM; nN = N / BM; nwg = nM * nN; G = G_; c = c_; }
    __device__ bool next(int i, Unit& u) const {
        const long L = (long)i * G + c; if (L >= nwg) return false;
        int wgid = (int)L; { const int q = nwg / NXCD, r = nwg % NXCD, xcd = wgid % NXCD, off = wgid / NXCD; wgid = (xcd < r ? xcd * (q + 1) : r * (q + 1) + (xcd - r) * q) + off; }
        const int nig = WGM * nN, gid = wgid / nig, fm = gid * WGM, gsz = (nM - fm) < WGM ? (nM - fm) : WGM;
        u.pm = fm + ((wgid % nig) % gsz); u.pn = (wgid % nig) / gsz; return true;
    }
};
template <class Epi>
__device__ __forceinline__ void gemm_phase(LAS unsigned char* lds, const Gemm g, const StaticOrder& S, const Epi& E) {
    const int tid = threadIdx.x, wid = __builtin_amdgcn_readfirstlane(tid >> 6), lane = tid & 63, wr = wid >> 2, wc = wid & 3, fr = lane & 15, fq = lane >> 4;
    const int K = g.K, nt = K / BK, lda = g.lda;
    unsigned voffA[2], voffB[2];
#pragma unroll
    for (int i = 0; i < 2; ++i) { int R, C; stage_rc(tid * 16 + i * 8192, R, C); const int Rb = (R & ~31) + perm32(R & 31);
        voffA[i] = (unsigned)(R * lda + C) * 2u; voffB[i] = (unsigned)(Rb * K + C) * 2u; }
    const size_t kstep = (size_t)(BK * 2);
    const size_t hstepA = (size_t)HALF * lda * 2, hstepB = (size_t)HALF * K * 2;
    const size_t tstepA = 2 * hstepA, tstepB = 2 * hstepB;
    const unsigned ldsw = (unsigned)wid * 1024u;
    const int aoff = lds_byte(wr * 64 + fr, fq * 8), boff = lds_byte(wc * 32 + fr, fq * 8);
#define PG8_SA(b, h) (((b) * 2 + (h)) * HTB)
#define PG8_SB(b, h) ((4 + (b) * 2 + (h)) * HTB)
#define PG8_STAGE(bufoff, gbase, voff) do { _Pragma("unroll") for (int _i = 0; _i < 2; ++_i) \
        __builtin_amdgcn_global_load_lds((const unsigned*)((const char*)(gbase) + (voff)[_i]), (LAS unsigned*)(lds + (bufoff) + ldsw + _i * 8192), 16, 0, 0); } while (0)
#define PG8_LDA(dst, b, h) do { _Pragma("unroll") for (int m = 0; m < 4; ++m) _Pragma("unroll") for (int k = 0; k < 2; ++k) dst[m][k] = *(const LAS h16x8*)(lds + PG8_SA(b, h) + aoff + m * 2048 + k * 1024); } while (0)
#define PG8_LDB(dst, b, h) do { _Pragma("unroll") for (int n = 0; n < 2; ++n) _Pragma("unroll") for (int k = 0; k < 2; ++k) dst[n][k] = *(const LAS h16x8*)(lds + PG8_SB(b, h) + boff + n * 2048 + k * 1024); } while (0)
#define PG8_MMA(ai, bj, At, Bt) do { __builtin_amdgcn_s_setprio(1); _Pragma("unroll") for (int m = 0; m < 4; ++m) _Pragma("unroll") for (int n = 0; n < 2; ++n) _Pragma("unroll") for (int k = 0; k < 2; ++k) \
        acc[ai][bj][m][n] = __builtin_amdgcn_mfma_f32_16x16x32_f16(Bt[n][k], At[m][k], acc[ai][bj][m][n], 0, 0, 0); __builtin_amdgcn_s_setprio(0); } while (0)
#define PG8_WAIT_V(n) asm volatile("s_waitcnt vmcnt(" #n ")" ::: "memory")
#define PG8_WAIT_L(n) asm volatile("s_waitcnt lgkmcnt(" #n ")" ::: "memory")
#define PG8_BAR __builtin_amdgcn_s_barrier()
#define PG8_SCHED __builtin_amdgcn_sched_barrier(0)
    Unit cur, nxt; int ui = 0;
    if (!S.next(0, cur)) return;
    f32x4 acc[2][2][4][2];
#pragma unroll
    for (int a = 0; a < 2; ++a)
#pragma unroll
        for (int b = 0; b < 2; ++b)
#pragma unroll
            for (int m = 0; m < 4; ++m)
#pragma unroll
                for (int n = 0; n < 2; ++n) acc[a][b][m][n] = (f32x4){0.f, 0.f, 0.f, 0.f};
    h16x8 At[4][2], B0[2][2], B1[2][2];
    const char* cA = (const char*)g.A + (size_t)cur.pm * tstepA; const char* cB = (const char*)g.Bt + (size_t)cur.pn * tstepB;
    PG8_STAGE(PG8_SB(0, 0), cB, voffB); PG8_STAGE(PG8_SB(0, 1), cB + hstepB, voffB); PG8_STAGE(PG8_SA(0, 0), cA, voffA); PG8_STAGE(PG8_SA(0, 1), cA + hstepA, voffA);
    if (wr == 1) PG8_BAR;
    PG8_WAIT_V(2); PG8_BAR;
    PG8_STAGE(PG8_SB(1, 0), cB + kstep, voffB); PG8_STAGE(PG8_SA(1, 0), cA + kstep, voffA); PG8_STAGE(PG8_SB(1, 1), cB + hstepB + kstep, voffB);
    PG8_WAIT_V(6); PG8_BAR;
    for (;;) {
        const bool has_next = S.next(ui + 1, nxt);
        const char* nA = has_next ? (const char*)g.A + (size_t)nxt.pm * tstepA : cA; const char* nB = has_next ? (const char*)g.Bt + (size_t)nxt.pn * tstepB : cB;
        for (int t = 0; t < nt; t += 2) {
            const bool last = (t == nt - 2);
            const char* a1 = cA + (size_t)(t + 1) * kstep;
            const char* a2 = last ? nA : cA + (size_t)(t + 2) * kstep; const char* b2 = last ? nB : cB + (size_t)(t + 2) * kstep;
            const char* a3 = a2 + kstep; const char* b3 = b2 + kstep;
            PG8_LDB(B0, 0, 0); PG8_LDB(B1, 0, 1); PG8_SCHED; PG8_LDA(At, 0, 0); PG8_STAGE(PG8_SA(1, 1), a1 + hstepA, voffA);
            PG8_WAIT_V(8); PG8_WAIT_L(0); PG8_BAR; PG8_MMA(0, 0, At, B0); PG8_MMA(0, 1, At, B1); PG8_BAR; PG8_SCHED;
            PG8_LDA(At, 0, 1); PG8_STAGE(PG8_SB(0, 0), b2, voffB); PG8_STAGE(PG8_SB(0, 1), b2 + hstepB, voffB); PG8_STAGE(PG8_SA(0, 0), a2, voffA);
            PG8_WAIT_V(8); PG8_WAIT_L(0); PG8_BAR; PG8_MMA(1, 0, At, B0); PG8_MMA(1, 1, At, B1); PG8_BAR; PG8_SCHED;
            PG8_LDB(B0, 1, 0); PG8_LDB(B1, 1, 1); PG8_SCHED; PG8_LDA(At, 1, 0); PG8_STAGE(PG8_SA(0, 1), a2 + hstepA, voffA);
            PG8_WAIT_V(8); PG8_WAIT_L(0); PG8_BAR; PG8_MMA(0, 0, At, B0); PG8_MMA(0, 1, At, B1); PG8_BAR; PG8_SCHED;
            PG8_LDA(At, 1, 1); PG8_STAGE(PG8_SB(1, 0), b3, voffB); PG8_STAGE(PG8_SB(1, 1), b3 + hstepB, voffB); PG8_STAGE(PG8_SA(1, 0), a3, voffA);
            PG8_WAIT_V(8); PG8_WAIT_L(0); PG8_BAR; PG8_MMA(1, 0, At, B0); PG8_MMA(1, 1, At, B1); PG8_BAR; PG8_SCHED;
        }
        if (wr == 0) PG8_BAR;
        E(acc, cur, wr, wc, fr, fq);
        if (!has_next) break;
#pragma unroll
        for (int a = 0; a < 2; ++a)
#pragma unroll
            for (int b = 0; b < 2; ++b)
#pragma unroll
                for (int m = 0; m < 4; ++m)
#pragma unroll
                    for (int n = 0; n < 2; ++n) acc[a][b][m][n] = (f32x4){0.f, 0.f, 0.f, 0.f};
        cur = nxt; cA = nA; cB = nB; ++ui;
        if (wr == 1) PG8_BAR;
    }
    PG8_WAIT_V(0);
    PG8_BAR;
#undef PG8_SA
#undef PG8_SB
#undef PG8_STAGE
#undef PG8_LDA
#undef PG8_LDB
#undef PG8_MMA
#undef PG8_WAIT_V
#undef PG8_WAIT_L
#undef PG8_BAR
#undef PG8_SCHED
}
}

__device__ __forceinline__ u32x4 pack8(const f32x4 a, const f32x4 b) {
    h16x8 h; h[0] = (h16)a[0]; h[1] = (h16)a[1]; h[2] = (h16)a[2]; h[3] = (h16)a[3]; h[4] = (h16)b[0]; h[5] = (h16)b[1]; h[6] = (h16)b[2]; h[7] = (h16)b[3];
    return __builtin_bit_cast(u32x4, h);
}

struct EpiProj {
    h16* PROJ; const float* rstd; float* dout; h16* KVS; h16* KIS;
    __device__ __forceinline__ void operator()(const f32x4 (&acc)[2][2][4][2], const pg8::Unit& u, int wr, int wc, int fr, int fq) const {
        const int row0 = u.pm * 256 + wr * 64 + fr, col0 = u.pn * 256 + wc * 32 + 8 * fq;
        const int pn = u.pn;
#pragma unroll
        for (int ai = 0; ai < 2; ++ai)
#pragma unroll
            for (int m = 0; m < 4; ++m) {
                const int row = row0 + ai * 128 + m * 16; const float rs = rstd[row];
#pragma unroll
                for (int bj = 0; bj < 2; ++bj) {
                    const int c = col0 + bj * 128;
                    const f32x4 v0 = acc[ai][bj][m][0] * rs, v1 = acc[ai][bj][m][1] * rs;
                    *(u32x4*)(PROJ + (size_t)row * NPJ + c) = pack8(v0, v1);
                    if (pn == 8 || pn == 9 || (pn == 14 && c < C_KI + 64)) {
                        if (row < MP) {
                            float* o = (pn == 8) ? dout + O_PK + (size_t)row * 256 + (c - C_K) : (pn == 9) ? dout + O_PV + (size_t)row * 256 + (c - C_VV) : dout + O_PKI + (size_t)row * 64 + (c - C_KI);
                            *(f32x4*)o = v0; *(f32x4*)(o + 4) = v1;
                        } else if (row < MROWS) {
                            const int t = row - MP, b = t >> 4, s = t & 15; const size_t kr = (size_t)b * NKSP + PAST + s;
                            float* o = (pn == 8) ? dout + O_SK + (size_t)t * 256 + (c - C_K) : (pn == 9) ? dout + O_SV + (size_t)t * 256 + (c - C_VV) : dout + O_SKI + (size_t)t * 64 + (c - C_KI);
                            *(f32x4*)o = v0; *(f32x4*)(o + 4) = v1;
                            h16* ho = (pn == 14) ? KIS + kr * 64 + (c - C_KI) : KVS + kr * 512 + (c - C_K);
                            *(u32x4*)ho = pack8(v0, v1);
                        }
                    }
                }
            }
    }
};
template <int FIRST> struct EpiGate {
    h16* PROJ;
    __device__ __forceinline__ void operator()(const f32x4 (&acc)[2][2][4][2], const pg8::Unit& u, int wr, int wc, int fr, int fq) const {
        const int row0 = u.pm * 256 + wr * 64 + fr, col0 = u.pn * 256 + wc * 32 + 8 * fq;
#pragma unroll
        for (int ai = 0; ai < 2; ++ai)
#pragma unroll
            for (int m = 0; m < 4; ++m) {
                const int row = row0 + ai * 128 + m * 16;
#pragma unroll
                for (int bj = 0; bj < 2; ++bj) {
                    const int c = col0 + bj * 128;
                    h16* pm_ = PROJ + (size_t)row * NPJ + (FIRST ? C_T : C_M) + c;
                    const h16x8 gt = *(const h16x8*)(PROJ + (size_t)row * NPJ + (FIRST ? C_GA : C_GB) + c);
                    f32x4 v0, v1;
#pragma unroll
                    for (int j = 0; j < 4; ++j) { v0[j] = sigmoidf_((float)gt[j]) * acc[ai][bj][m][0][j]; v1[j] = sigmoidf_((float)gt[4 + j]) * acc[ai][bj][m][1][j]; }
                    if (!FIRST) { const h16x8 tp = *(const h16x8*)(PROJ + (size_t)row * NPJ + C_T + c);
#pragma unroll
                        for (int j = 0; j < 4; ++j) { v0[j] += (float)tp[j]; v1[j] += (float)tp[4 + j]; } }
                    *(u32x4*)pm_ = pack8(v0, v1);
                }
            }
    }
};
struct EpiOut {
    const float* xp; const float* xs; float* dout; float* rowss;
    __device__ __forceinline__ void operator()(const f32x4 (&acc)[2][2][4][2], const pg8::Unit& u, int wr, int wc, int fr, int fq) const {
        const int row0 = u.pm * 256 + wr * 64 + fr, col0 = u.pn * 256 + wc * 32 + 8 * fq;
#pragma unroll
        for (int ai = 0; ai < 2; ++ai)
#pragma unroll
            for (int m = 0; m < 4; ++m) {
                const int row = row0 + ai * 128 + m * 16;
                const bool ok = row < MROWS;
                const float* xr = (row < MP) ? xp + (size_t)row * DM : xs + (size_t)(row - MP) * DM;
                float* yr = (row < MP) ? dout + O_YP + (size_t)row * DM : dout + O_YS + (size_t)(row - MP) * DM;
                float ss = 0.f;
                if (ok) {
#pragma unroll
                    for (int bj = 0; bj < 2; ++bj) {
                        const int c = col0 + bj * 128;
                        const f32x4 x0 = *(const f32x4*)(xr + c), x1 = *(const f32x4*)(xr + c + 4);
                        const f32x4 v0 = x0 + acc[ai][bj][m][0], v1 = x1 + acc[ai][bj][m][1];
                        *(f32x4*)(yr + c) = v0; *(f32x4*)(yr + c + 4) = v1;
                        ss += v0[0] * v0[0] + v0[1] * v0[1] + v0[2] * v0[2] + v0[3] * v0[3] + v1[0] * v1[0] + v1[1] * v1[1] + v1[2] * v1[2] + v1[3] * v1[3];
                    }
                }
                ss += __shfl_xor(ss, 16); ss += __shfl_xor(ss, 32);
                if (ok && fq == 0) rowss[(size_t)row * 16 + u.pn * 4 + wc] = ss;
            }
    }
};

struct Params {
    const float *xp, *xs, *ck, *cv, *cki, *norm_g, *w_in, *ln_g, *ln_b, *sgu_w, *sgu_b, *w_pa, *w_pb, *w_out, *final_g;
    float* out; unsigned char* ws; int ph_lo, ph_hi;
};

__device__ __forceinline__ void p0_tr_item(const float* W, int K, int Nsrc, h16* WT, const float* gs, int mode, float* scr, int item, int nblk, int lane) {
    const int kb = item / nblk, nb = item % nblk, k0 = 64 * kb, n0 = 32 * nb;
    const int nn = n0 + (lane & 31);
    int src = nn; bool valid = true;
    if (mode == 1) { if (nn >= C_WI + 8 && nn < C_GA) valid = false; else if (nn >= C_GA) src = nn - (C_GA - (C_WI + 8)); }
#pragma unroll 8
    for (int i = 0; i < 32; ++i) { const int kk = 2 * i + (lane >> 5);
        float v = 0.f; if (valid) { v = W[(size_t)(k0 + kk) * Nsrc + src]; if (gs) v *= gs[k0 + kk]; }
        scr[kk * 33 + (lane & 31)] = v; }
    __builtin_amdgcn_s_waitcnt(0); asm volatile("" ::: "memory");
    const int c = lane & 7;
#pragma unroll
    for (int j = 0; j < 4; ++j) { const int n = (lane >> 3) + 8 * j; const float* s = scr + (8 * c) * 33 + n;
        h16x8 h;
#pragma unroll
        for (int q = 0; q < 8; ++q) h[q] = (h16)s[q * 33];
        *(h16x8*)(WT + (size_t)(n0 + n) * K + k0 + 8 * c) = h; }
    __builtin_amdgcn_s_waitcnt(0); asm volatile("" ::: "memory");
}

constexpr int VNT_LD = 136;
__device__ __forceinline__ void sgu_chunk(const Params& p, unsigned char* lds, int chunk, int wave, int lane) {
    h16* PROJ = (h16*)(p.ws + WS_PROJ);
    h16* vnT = (h16*)lds;
    h16* AOUT = (h16*)(p.ws + WS_AOUT);
    const h16* WSM = (const h16*)(p.ws + WS_WSM);
    {
        float lg[8], lb[8];
#pragma unroll
        for (int j = 0; j < 8; ++j) { lg[j] = p.ln_g[lane * 8 + j]; lb[j] = p.ln_b[lane * 8 + j]; }
        for (int tt = 0; tt < 16; ++tt) {
            const int tok = wave * 16 + tt; const size_t row = (size_t)chunk * 128 + tok;
            const h16x8 vv = *(const h16x8*)(PROJ + row * NPJ + C_V + lane * 8);
            float g[8]; float s = 0.f;
#pragma unroll
            for (int j = 0; j < 8; ++j) { g[j] = geluf_((float)vv[j]); s += g[j]; }
            const float mean = wave_sum(s) * (1.f / 512.f); float q = 0.f;
#pragma unroll
            for (int j = 0; j < 8; ++j) { g[j] -= mean; q += g[j] * g[j]; }
            const float rstd = rsqrtf(wave_sum(q) * (1.f / 512.f) + 1e-5f);
#pragma unroll
            for (int j = 0; j < 8; ++j) vnT[(lane * 8 + j) * VNT_LD + tok] = (h16)(g[j] * rstd * lg[j] + lb[j]);
        }
    }
    __syncthreads();
    {
        const int g = wave, fr = lane & 15, fq = lane >> 4;
        for (int it = 0; it < 8; ++it) {
            f32x4 acc[4];
#pragma unroll
            for (int dt = 0; dt < 4; ++dt) acc[dt] = (f32x4){0.f, 0.f, 0.f, 0.f};
            const int nks = (it < 4) ? 2 : 4;
            for (int ks = 0; ks < nks; ++ks) {
                const h16x8 b = *(const h16x8*)(WSM + ((size_t)g * 128 + it * 16 + fr) * 128 + ks * 32 + fq * 8);
#pragma unroll
                for (int dt = 0; dt < 4; ++dt) {
                    const h16x8 a = *(const h16x8*)(vnT + (g * 64 + dt * 16 + fr) * VNT_LD + ks * 32 + fq * 8);
                    acc[dt] = __builtin_amdgcn_mfma_f32_16x16x32_f16(a, b, acc[dt], 0, 0, 0);
                }
            }
            const int i = it * 16 + fr; const size_t row = (size_t)chunk * 128 + i;
            const float bias = p.sgu_b[g * 128 + i];
#pragma unroll
            for (int dt = 0; dt < 4; ++dt) {
                const int c = g * 64 + dt * 16 + fq * 4;
                const h16x4 uu = *(const h16x4*)(PROJ + row * NPJ + C_U + c); const h16x4 zz = *(const h16x4*)(PROJ + row * NPJ + C_ZA + c);
                h16x4 o;
#pragma unroll
                for (int r = 0; r < 4; ++r) o[r] = (h16)(geluf_((float)uu[r]) * (acc[dt][r] + bias) * siluf_((float)zz[r]));
                *(h16x4*)(AOUT + row * 512 + c) = o;
            }
        }
    }
    __syncthreads();
}
__device__ __forceinline__ void sgu_sample(const Params& p, unsigned char* lds, int b, int wave, int lane) {
    h16* PROJ = (h16*)(p.ws + WS_PROJ);
    float* vnS = (float*)lds;
    for (int tt = 0; tt < 2; ++tt) {
        const int t = wave * 2 + tt; const size_t row = (size_t)MP + b * 16 + t;
        const h16x8 vv = *(const h16x8*)(PROJ + row * NPJ + C_V + lane * 8);
        float g[8]; float s = 0.f;
#pragma unroll
        for (int j = 0; j < 8; ++j) { g[j] = geluf_((float)vv[j]); s += g[j]; }
        const float mean = wave_sum(s) * (1.f / 512.f); float q = 0.f;
#pragma unroll
        for (int j = 0; j < 8; ++j) { g[j] -= mean; q += g[j] * g[j]; }
        const float rstd = rsqrtf(wave_sum(q) * (1.f / 512.f) + 1e-5f);
#pragma unroll
        for (int j = 0; j < 8; ++j) { const int c = lane * 8 + j; const float v = g[j] * rstd * p.ln_g[c] + p.ln_b[c];
            vnS[t * 512 + c] = v; p.out[O_SSV + (size_t)(b * 16 + t) * 512 + c] = v; }
    }
    __syncthreads();
    {
        const int c = threadIdx.x, g = c >> 6;
        float vn[16];
#pragma unroll
        for (int j = 0; j < 16; ++j) vn[j] = vnS[j * 512 + c];
        for (int i = 0; i < 16; ++i) {
            float mixed = p.sgu_b[g * 128 + i];
#pragma unroll
            for (int j = 0; j < 16; ++j) mixed += p.sgu_w[((size_t)g * 128 + i) * 128 + j] * vn[j];
            const size_t row = (size_t)MP + b * 16 + i;
            const float u = (float)PROJ[row * NPJ + C_U + c], za = (float)PROJ[row * NPJ + C_ZA + c];
            ((h16*)(p.ws + WS_AOUT))[row * 512 + c] = (h16)(geluf_(u) * mixed * siluf_(za));
        }
    }
    __syncthreads();
}

constexpr int TK_C = 2048, TK_TRIG = TK_C - 512;
constexpr int L3_HIST = 131072, L3_CNT = L3_HIST + 8192, L3_THR = L3_CNT + 32, L3_SUM = L3_THR + 32;
__device__ __forceinline__ unsigned fkey(float f) { const unsigned u = __float_as_uint(f); return (u & 0x80000000u) ? ~u : (u | 0x80000000u); }
__device__ __forceinline__ float fkey_inv(unsigned k) { return __uint_as_float((k & 0x80000000u) ? (k ^ 0x80000000u) : ~k); }

template <bool ON_LO>
__device__ __forceinline__ unsigned radix_select(const u64* buf, unsigned* hist, int n, int lane, unsigned fhi, int k, int& ceq_out, int& krem_out) {
    unsigned prefix = 0, pmask = 0; int krem = k; int ceq = 0;
    for (int shift = 24; shift >= 0; shift -= 8) {
        *(u32x4*)(hist + 4 * lane) = (u32x4){0u, 0u, 0u, 0u};
        __builtin_amdgcn_s_waitcnt(0); asm volatile("" ::: "memory");
        for (int i = lane; i < n; i += 64) {
            const u64 e = buf[i]; const unsigned hi = (unsigned)(e >> 32), lo = (unsigned)e;
            const unsigned key = ON_LO ? lo : hi;
            const bool ok = (ON_LO ? (hi == fhi) : true) && ((key & pmask) == prefix);
            if (ok) atomicAdd(hist + ((key >> shift) & 255u), 1u);
        }
        __builtin_amdgcn_s_waitcnt(0); asm volatile("" ::: "memory");
        const u32x4 hv = *(const u32x4*)(hist + 4 * lane);
        const unsigned s = hv.x + hv.y + hv.z + hv.w;
        unsigned S = s;
#pragma unroll
        for (int o = 1; o < 64; o <<= 1) { const unsigned t = __shfl_down(S, o); if (lane + o < 64) S += t; }
        const bool is = (S >= (unsigned)krem) && (S - s < (unsigned)krem);
        const u64 bm = __ballot(is);
        const int L = bm ? (__ffsll((long long)bm) - 1) : 0;
        unsigned d = 0, cab = S - s, ce = 0;
        { unsigned c = S - s;
          if (c + hv.w >= (unsigned)krem) { d = 3; cab = c; ce = hv.w; }
          else { c += hv.w; if (c + hv.z >= (unsigned)krem) { d = 2; cab = c; ce = hv.z; }
          else { c += hv.z; if (c + hv.y >= (unsigned)krem) { d = 1; cab = c; ce = hv.y; }
          else { c += hv.y; d = 0; cab = c; ce = hv.x; } } } }
        d = __shfl(d, L); cab = __shfl(cab, L); ce = __shfl(ce, L);
        const unsigned digit = 4u * (unsigned)L + d;
        krem -= (int)cab; ceq = (int)ce; prefix |= digit << shift; pmask |= 255u << shift;
    }
    ceq_out = ceq; krem_out = krem;
    return prefix;
}
__device__ __forceinline__ int tk_compact(u64* buf, unsigned* hist, int n, int lane, float& thr) {
    unsigned ehi[32];
    const unsigned* b32 = (const unsigned*)buf;
#pragma unroll
    for (int j = 0; j < 32; ++j) { ehi[j] = 0u; if (64 * j < n) { const int ic = min(lane + 64 * j, n - 1); ehi[j] = b32[2 * ic + 1]; } }
    unsigned mn = 0xFFFFFFFFu, mx = 0u;
#pragma unroll
    for (int j = 0; j < 32; ++j) { if (64 * j < n) { mn = min(mn, ehi[j]); mx = max(mx, ehi[j]); } }
#pragma unroll
    for (int o = 1; o < 64; o <<= 1) { mn = min(mn, (unsigned)__shfl_xor((int)mn, o)); mx = max(mx, (unsigned)__shfl_xor((int)mx, o)); }
    const unsigned range = mx - mn; const int sh = range ? __clz(range) : 0;
#pragma unroll
    for (int j = 0; j < 32; ++j) { const unsigned nk = (ehi[j] - mn) << sh; ehi[j] = ((lane + 64 * j) < n) ? nk : 0u; }
    const unsigned ninv = (unsigned)(((n + 63) & ~63) - n);
    unsigned prefix = 0, pmask = 0; int krem = 256; bool done = false;
    for (int shift = 24; shift >= 0 && !done; shift -= 8) {
        *(u32x4*)(hist + 4 * lane) = (u32x4){0u, 0u, 0u, 0u};
        __builtin_amdgcn_s_waitcnt(0); asm volatile("" ::: "memory");
#pragma unroll
        for (int j = 0; j < 32; ++j) { if (64 * j < n) { if ((ehi[j] & pmask) == prefix) atomicAdd(hist + ((ehi[j] >> shift) & 255u), 1u); } }
        __builtin_amdgcn_s_waitcnt(0); asm volatile("" ::: "memory");
        u32x4 hv = *(const u32x4*)(hist + 4 * lane);
        if (lane == 0 && prefix == 0u) hv.x -= ninv;
        const unsigned s = hv.x + hv.y + hv.z + hv.w;
        unsigned S = s;
#pragma unroll
        for (int o = 1; o < 64; o <<= 1) { const unsigned t = __shfl_down(S, o); if (lane + o < 64) S += t; }
        const bool is = (S >= (unsigned)krem) && (S - s < (unsigned)krem);
        const u64 bm = __ballot(is);
        const int L = bm ? (__ffsll((long long)bm) - 1) : 0;
        unsigned d = 0, cab = S - s, ce = 0;
        { unsigned c = S - s;
          if (c + hv.w >= (unsigned)krem) { d = 3; cab = c; ce = hv.w; }
          else { c += hv.w; if (c + hv.z >= (unsigned)krem) { d = 2; cab = c; ce = hv.z; }
          else { c += hv.z; if (c + hv.y >= (unsigned)krem) { d = 1; cab = c; ce = hv.y; }
          else { c += hv.y; d = 0; cab = c; ce = hv.x; } } } }
        d = __shfl(d, L); cab = __shfl(cab, L); ce = __shfl(ce, L);
        krem -= (int)cab; prefix |= (4u * (unsigned)L + d) << shift; pmask |= 255u << shift;
        if ((int)ce == krem) done = true;
    }
    unsigned tlo = 0u;
    const unsigned thi_abs = mn + ((prefix + ((1u << sh) - 1u)) >> sh);
    if (!done) { int c2, k2; tlo = radix_select<true>(buf, hist, n, lane, mn + (prefix >> sh), krem, c2, k2); }
    int outn = 0;
#pragma unroll
    for (int j = 0; j < 32; ++j) {
        if (64 * j < n) {
            const int i = lane + 64 * j; const int ic = min(i, n - 1);
            const unsigned elo_ = b32[2 * ic];
            const bool keep = (i < n) && ((ehi[j] > prefix) || ((ehi[j] & pmask) == prefix && (done || elo_ >= tlo)));
            const u64 bm = __ballot(keep);
            const int off = __builtin_amdgcn_mbcnt_hi((unsigned)(bm >> 32), __builtin_amdgcn_mbcnt_lo((unsigned)bm, 0u));
            if (keep) buf[outn + off] = ((u64)(mn + (ehi[j] >> sh)) << 32) | (u64)elo_;
            outn += __popcll(bm);
        }
    }
    __builtin_amdgcn_s_waitcnt(0); asm volatile("" ::: "memory");
    thr = fkey_inv(thi_abs - 1u);
    return outn;
}

struct AUnit { int qrow0, krow0, nk; const h16* kib; int kis; const h16* kvb; int kvs; };

__device__ __forceinline__ void attn_unit(const Params& p, unsigned char* lds, const AUnit U, int wave, int lane, unsigned long long& tacc) {
    h16* PROJ = (h16*)(p.ws + WS_PROJ);
    u64* bufall = (u64*)lds;
    unsigned* hist = (unsigned*)(lds + L3_HIST) + wave * 256;
    unsigned* cnt = (unsigned*)(lds + L3_CNT);
    float* thrs = (float*)(lds + L3_THR);
    float* sums = (float*)(lds + L3_SUM) + wave * 8;
    const int half = lane >> 5, l31 = lane & 31;
    h16x8 qa[2][4]; h16x8 wq[2][2];
#define LOADQ() do     { \
        const int ql = 2 * ((l31 >> 2) & 1) + (l31 >> 4), hh = ((l31 >> 3) & 1) * 4 + (l31 & 3); \
_Pragma("unroll") \
        for (int mt = 0; mt < 2; ++mt) { \
            const h16* qp = PROJ + (size_t)(U.qrow0 + mt * 4 + ql) * NPJ + C_QI + hh * 64 + half * 8; \
_Pragma("unroll") \
            for (int ks = 0; ks < 4; ++ks) qa[mt][ks] = *(const h16x8*)(qp + ks * 16); \
_Pragma("unroll") \
            for (int e = 0; e < 2; ++e) { \
                wq[mt][e] = *(const h16x8*)(PROJ + (size_t)(U.qrow0 + mt * 4 + 2 * half + e) * NPJ + C_WI); \
            } \
        } \
    } while (0)
    LOADQ();
    for (int repi_ = 0; repi_ < REP_IDX; ++repi_) {
    __syncthreads();
    if (threadIdx.x < 8) { cnt[threadIdx.x] = 0u; thrs[threadIdx.x] = -__builtin_inff(); }
    __syncthreads();
    const int nkt = (U.nk + 31) >> 5, rounds = (nkt + 15) >> 4;
    h16x8 bf[2][4], bn[2][4];
#define LOADB(dst, rdx) do { _Pragma("unroll") for (int rr = 0; rr < 2; ++rr) { const int kt_ = (rdx) * 16 + rr * 8 + wave; const int ktc_ = kt_ < nkt ? kt_ : nkt - 1; \
        const h16* kp_ = U.kib + (size_t)(U.krow0 + ktc_ * 32 + l31) * U.kis + half * 8; \
        _Pragma("unroll") for (int ks = 0; ks < 4; ++ks) dst[rr][ks] = *(const h16x8*)(kp_ + ks * 16); } } while (0)
    TBEG(1)
    LOADB(bf, 0);
#pragma unroll 1
    for (int rd = 0; rd < rounds; rd += 2) {
        LOADB(bn, rd + 1);
#pragma unroll
        for (int rr = 0; rr < 2; ++rr) {
            const int kt = (rd) * 16 + rr * 8 + wave;
            if (kt < nkt) {
                const int key = kt * 32 + l31; const bool kvalid = key < U.nk;
#pragma unroll
                for (int mt = 0; mt < 2; ++mt) {
                    f32x16 cc;
#pragma unroll
                    for (int r = 0; r < 16; ++r) cc[r] = 0.f;
#pragma unroll
                    for (int ks = 0; ks < 4; ++ks) cc = __builtin_amdgcn_mfma_f32_32x32x16_f16(qa[mt][ks], bf[rr][ks], cc, 0, 0, 0);
                    float sv[2]; bool ps[2];
                    const f32x2 thp = *(const f32x2*)(thrs + mt * 4 + 2 * half);
#pragma unroll
                    for (int e = 0; e < 2; ++e) {
                        float s = 0.f;
#pragma unroll
                        for (int h = 0; h < 8; ++h) s += (float)wq[mt][e][h] * fmaxf(cc[e * 8 + h], 0.f);
                        sv[e] = s; ps[e] = kvalid && (s > thp[e]);
                    }
                    const u64 bm0 = __ballot(ps[0]), bm1 = __ballot(ps[1]);
                    if (bm0 | bm1) {
                        const int ql = lane - mt * 4;
                        unsigned myc = 0u;
                        myc = (ql == 0) ? (unsigned)__popc((unsigned)bm0) : myc;
                        myc = (ql == 1) ? (unsigned)__popc((unsigned)bm1) : myc;
                        myc = (ql == 2) ? (unsigned)__popc((unsigned)(bm0 >> 32)) : myc;
                        myc = (ql == 3) ? (unsigned)__popc((unsigned)(bm1 >> 32)) : myc;
                        unsigned basev = 0u;
                        if ((unsigned)ql < 4u && myc) basev = atomicAdd(cnt + lane, myc);
                        const unsigned b00 = __builtin_amdgcn_readlane(basev, mt * 4), b01 = __builtin_amdgcn_readlane(basev, mt * 4 + 1);
                        const unsigned b10 = __builtin_amdgcn_readlane(basev, mt * 4 + 2), b11 = __builtin_amdgcn_readlane(basev, mt * 4 + 3);
                        const unsigned ltm = (1u << l31) - 1u;
                        if (ps[0]) { const unsigned hm = half ? (unsigned)(bm0 >> 32) : (unsigned)bm0; const unsigned pos = (half ? b10 : b00) + (unsigned)__popc(hm & ltm);
                            bufall[(size_t)(mt * 4 + 2 * half) * TK_C + pos] = ((u64)fkey(sv[0]) << 32) | (u64)(~(unsigned)key); }
                        if (ps[1]) { const unsigned hm = half ? (unsigned)(bm1 >> 32) : (unsigned)bm1; const unsigned pos = (half ? b11 : b01) + (unsigned)__popc(hm & ltm);
                            bufall[(size_t)(mt * 4 + 2 * half + 1) * TK_C + pos] = ((u64)fkey(sv[1]) << 32) | (u64)(~(unsigned)key); }
                    }
                }
            }
        }
        __syncthreads();
        bool need = false;
#pragma unroll
        for (int q = 0; q < 8; ++q) need = need || (cnt[q] > (unsigned)TK_TRIG);
        __syncthreads();
        if (need && (rd) + 1 < rounds) {
            TBEG(2)
            const int n = (int)cnt[wave];
            if (n > 256) { float t; const int nn = tk_compact(bufall + (size_t)wave * TK_C, hist, n, lane, t); if (lane == 0) { cnt[wave] = (unsigned)nn; thrs[wave] = t; } }
            __builtin_amdgcn_sched_barrier(0);
            LOADQ(); LOADB(bn, rd + 1);
            __syncthreads();
            TEND(2)
        }
        if (rd + 1 < rounds) {
        LOADB(bf, rd + 2);
#pragma unroll
        for (int rr = 0; rr < 2; ++rr) {
            const int kt = (rd + 1) * 16 + rr * 8 + wave;
            if (kt < nkt) {
                const int key = kt * 32 + l31; const bool kvalid = key < U.nk;
#pragma unroll
                for (int mt = 0; mt < 2; ++mt) {
                    f32x16 cc;
#pragma unroll
                    for (int r = 0; r < 16; ++r) cc[r] = 0.f;
#pragma unroll
                    for (int ks = 0; ks < 4; ++ks) cc = __builtin_amdgcn_mfma_f32_32x32x16_f16(qa[mt][ks], bn[rr][ks], cc, 0, 0, 0);
                    float sv[2]; bool ps[2];
                    const f32x2 thp = *(const f32x2*)(thrs + mt * 4 + 2 * half);
#pragma unroll
                    for (int e = 0; e < 2; ++e) {
                        float s = 0.f;
#pragma unroll
                        for (int h = 0; h < 8; ++h) s += (float)wq[mt][e][h] * fmaxf(cc[e * 8 + h], 0.f);
                        sv[e] = s; ps[e] = kvalid && (s > thp[e]);
                    }
                    const u64 bm0 = __ballot(ps[0]), bm1 = __ballot(ps[1]);
                    if (bm0 | bm1) {
                        const int ql = lane - mt * 4;
                        unsigned myc = 0u;
                        myc = (ql == 0) ? (unsigned)__popc((unsigned)bm0) : myc;
                        myc = (ql == 1) ? (unsigned)__popc((unsigned)bm1) : myc;
                        myc = (ql == 2) ? (unsigned)__popc((unsigned)(bm0 >> 32)) : myc;
                        myc = (ql == 3) ? (unsigned)__popc((unsigned)(bm1 >> 32)) : myc;
                        unsigned basev = 0u;
                        if ((unsigned)ql < 4u && myc) basev = atomicAdd(cnt + lane, myc);
                        const unsigned b00 = __builtin_amdgcn_readlane(basev, mt * 4), b01 = __builtin_amdgcn_readlane(basev, mt * 4 + 1);
                        const unsigned b10 = __builtin_amdgcn_readlane(basev, mt * 4 + 2), b11 = __builtin_amdgcn_readlane(basev, mt * 4 + 3);
                        const unsigned ltm = (1u << l31) - 1u;
                        if (ps[0]) { const unsigned hm = half ? (unsigned)(bm0 >> 32) : (unsigned)bm0; const unsigned pos = (half ? b10 : b00) + (unsigned)__popc(hm & ltm);
                            bufall[(size_t)(mt * 4 + 2 * half) * TK_C + pos] = ((u64)fkey(sv[0]) << 32) | (u64)(~(unsigned)key); }
                        if (ps[1]) { const unsigned hm = half ? (unsigned)(bm1 >> 32) : (unsigned)bm1; const unsigned pos = (half ? b11 : b01) + (unsigned)__popc(hm & ltm);
                            bufall[(size_t)(mt * 4 + 2 * half + 1) * TK_C + pos] = ((u64)fkey(sv[1]) << 32) | (u64)(~(unsigned)key); }
                    }
                }
            }
        }
        __syncthreads();
        bool need = false;
#pragma unroll
        for (int q = 0; q < 8; ++q) need = need || (cnt[q] > (unsigned)TK_TRIG);
        __syncthreads();
        if (need && (rd + 1) + 1 < rounds) {
            TBEG(2)
            const int n = (int)cnt[wave];
            if (n > 256) { float t; const int nn = tk_compact(bufall + (size_t)wave * TK_C, hist, n, lane, t); if (lane == 0) { cnt[wave] = (unsigned)nn; thrs[wave] = t; } }
            __builtin_amdgcn_sched_barrier(0);
            LOADQ(); LOADB(bf, rd + 2);
            __syncthreads();
            TEND(2)
        }
        }
    }
#undef LOADB
#undef LOADQ
    TEND(1)
    }
    u64* buf = bufall + (size_t)wave * TK_C;
    TBEG(3)
    int n = (int)cnt[wave];
    if (n > 256) { float t; n = tk_compact(buf, hist, n, lane, t); }
    TEND(3)
    const int qrow = U.qrow0 + wave;
    for (int repa_ = 0; repa_ < REP_ATT; ++repa_) {
    TBEG(4)
    float* P = (float*)((unsigned char*)buf + 4096);
    {
        const int fr = lane & 15, fq = lane >> 4;
        h16x8 qf[2];
#pragma unroll
        for (int ks = 0; ks < 2; ++ks) {
            if (fr < 8) qf[ks] = *(const h16x8*)(PROJ + (size_t)qrow * NPJ + C_Q + fr * 64 + ks * 32 + fq * 8);
            else {
#pragma unroll
                for (int j = 0; j < 8; ++j) qf[ks][j] = (h16)0.f; }
        }
        h16x8 zero8;
#pragma unroll
        for (int j = 0; j < 8; ++j) zero8[j] = (h16)0.f;
        h16x8 ka[16], kb[16];
#define ISSUEK2(dst, g) do { _Pragma("unroll") for (int tt = 0; tt < 2; ++tt) { const int s_ = ((g) * 2 + tt) * 16 + fr; const unsigned idx_ = (s_ < n) ? ~(unsigned)buf[s_] : 0u; \
        const h16* kr_ = U.kvb + (size_t)(U.krow0 + (int)idx_) * U.kvs + fq * 8; \
        _Pragma("unroll") for (int j = 0; j < 4; ++j) _Pragma("unroll") for (int ks = 0; ks < 2; ++ks) dst[tt * 8 + j * 2 + ks] = *(const h16x8*)(kr_ + j * 64 + ks * 32); } } while (0)
#define COMPK2(src, g) do { _Pragma("unroll") for (int tt = 0; tt < 2; ++tt) { f32x4 c_ = (f32x4){0.f, 0.f, 0.f, 0.f}; \
        _Pragma("unroll") for (int j = 0; j < 4; ++j) _Pragma("unroll") for (int ks = 0; ks < 2; ++ks) { const h16x8 a_ = ((fr >> 1) == j) ? qf[ks] : zero8; \
            c_ = __builtin_amdgcn_mfma_f32_16x16x32_f16(a_, src[tt * 8 + j * 2 + ks], c_, 0, 0, 0); } \
        const int s_ = ((g) * 2 + tt) * 16 + fr; const bool v_ = s_ < n; \
        _Pragma("unroll") for (int r = 0; r < 4; ++r) c_[r] = v_ ? c_[r] * 0.125f : -1e30f; \
        if (fq < 2) *(f32x4*)(P + s_ * 8 + fq * 4) = c_; } } while (0)
        ISSUEK2(ka, 0);
#pragma unroll 1
        for (int g = 0; g < 8; g += 2) {
            ISSUEK2(kb, g + 1);
            COMPK2(ka, g);
            ISSUEK2(ka, g + 2);
            COMPK2(kb, g + 1);
        }
#undef ISSUEK2
#undef COMPK2
        __builtin_amdgcn_s_waitcnt(0); asm volatile("" ::: "memory");
        f32x4 acc[16];
#pragma unroll
        for (int t = 0; t < 16; ++t) acc[t] = *(const f32x4*)(P + (t * 16 + fr) * 8 + (fq & 1) * 4);
        float mx[4] = {-1e30f, -1e30f, -1e30f, -1e30f};
#pragma unroll
        for (int t = 0; t < 16; ++t) { const bool v = (t * 16 + fr) < n;
#pragma unroll
            for (int r = 0; r < 4; ++r) { mx[r] = fmaxf(mx[r], acc[t][r]); } }
#pragma unroll
        for (int r = 0; r < 4; ++r) {
#pragma unroll
            for (int o = 1; o < 16; o <<= 1) mx[r] = fmaxf(mx[r], __shfl_xor(mx[r], o)); }
        float sm[4] = {0.f, 0.f, 0.f, 0.f};
#pragma unroll
        for (int t = 0; t < 16; ++t) { const bool v = (t * 16 + fr) < n;
#pragma unroll
            for (int r = 0; r < 4; ++r) { const float e = v ? __expf(acc[t][r] - mx[r]) : 0.f; acc[t][r] = e; sm[r] += e; } }
#pragma unroll
        for (int r = 0; r < 4; ++r) {
#pragma unroll
            for (int o = 1; o < 16; o <<= 1) sm[r] += __shfl_xor(sm[r], o); }
        __builtin_amdgcn_s_waitcnt(0); asm volatile("" ::: "memory");
        if (fq < 2) {
#pragma unroll
            for (int t = 0; t < 16; ++t) *(f32x4*)(P + (t * 16 + fr) * 8 + fq * 4) = acc[t];
            if (fr == 0) {
#pragma unroll
                for (int r = 0; r < 4; ++r) sums[fq * 4 + r] = sm[r]; }
        }
        __builtin_amdgcn_s_waitcnt(0); asm volatile("" ::: "memory");
    }
    TEND(4)
    TBEG(5)
    {
        const int sp = lane >> 5, part = lane & 31, kv = part >> 3, d0 = (part & 7) * 8;
        float o0[8], o1[8];
#pragma unroll
        for (int j = 0; j < 8; ++j) { o0[j] = 0.f; o1[j] = 0.f; }
        h16x8 va[8], vb[8];
        const h16* vbase = U.kvb + 256 + kv * 64 + d0;
#define ISSUEV(dst, gi) do { _Pragma("unroll") for (int ii = 0; ii < 8; ++ii) { const int s_ = 2 * ((gi) * 8 + ii) + sp; const unsigned idx_ = (s_ < n) ? ~(unsigned)buf[s_] : 0u; \
        dst[ii] = *(const h16x8*)(vbase + (size_t)(U.krow0 + (int)idx_) * U.kvs); } } while (0)
#define COMPV(src, gi) do { _Pragma("unroll") for (int ii = 0; ii < 8; ++ii) { const int s_ = 2 * ((gi) * 8 + ii) + sp; const f32x2 pp = *(const f32x2*)(P + s_ * 8 + 2 * kv); \
        _Pragma("unroll") for (int j = 0; j < 8; ++j) { const float x = (float)src[ii][j]; o0[j] += pp.x * x; o1[j] += pp.y * x; } } } while (0)
        ISSUEV(va, 0);
#pragma unroll 1
        for (int gi = 0; gi < 16; gi += 2) {
            ISSUEV(vb, gi + 1);
            COMPV(va, gi);
            ISSUEV(va, gi + 2);
            COMPV(vb, gi + 1);
        }
#undef ISSUEV
#undef COMPV
#pragma unroll
        for (int j = 0; j < 8; ++j) { o0[j] += __shfl_xor(o0[j], 32); o1[j] += __shfl_xor(o1[j], 32); }
        if (sp == 0) {
            const float i0 = 1.f / sums[2 * kv], i1 = 1.f / sums[2 * kv + 1];
            h16* pz = PROJ + (size_t)qrow * NPJ + C_ZB + (2 * kv) * 64 + d0;
            h16* po = (h16*)(p.ws + WS_BOUT) + (size_t)qrow * 512 + (2 * kv) * 64 + d0;
            const h16x8 z0 = *(const h16x8*)pz, z1 = *(const h16x8*)(pz + 64);
            h16x8 r0, r1;
#pragma unroll
            for (int j = 0; j < 8; ++j) { r0[j] = (h16)(o0[j] * i0 * siluf_((float)z0[j])); r1[j] = (h16)(o1[j] * i1 * siluf_((float)z1[j])); }
            *(h16x8*)po = r0; *(h16x8*)(po + 64) = r1;
        }
    }
    TEND(5)
    }
    __syncthreads();
}

__global__ void __launch_bounds__(512, 2) mk_fwd(Params p) {
    __builtin_assume(__builtin_amdgcn_workitem_id_y() == 0); __builtin_assume(__builtin_amdgcn_workitem_id_z() == 0);
    extern __shared__ __attribute__((aligned(16))) unsigned char lds[];
    cg::grid_group grid = cg::this_grid();
    const int tid = threadIdx.x, lane = tid & 63, wave = __builtin_amdgcn_readfirstlane(tid >> 6);
    const int G = gridDim.x, bx = blockIdx.x;
    const int gw = bx * 8 + wave, NGW = G * 8;
    const int lo = p.ph_lo, hi = p.ph_hi;
    unsigned long long tacc = 0;
#define IN(k) (lo <= (k) && (k) < hi)
#define SEAM(k) do { if (IN(k) && IN((k) + 1)) grid.sync(); } while (0)
    h16* XH = (h16*)(p.ws + WS_XH); h16* PROJ = (h16*)(p.ws + WS_PROJ);
    h16* WIN = (h16*)(p.ws + WS_WIN); h16* WPA = (h16*)(p.ws + WS_WPA); h16* WPB = (h16*)(p.ws + WS_WPB); h16* WOUT = (h16*)(p.ws + WS_WOUT);
    h16* WSM = (h16*)(p.ws + WS_WSM); h16* KVS = (h16*)(p.ws + WS_KVS); h16* KIS = (h16*)(p.ws + WS_KIS);
    float* RSTD = (float*)(p.ws + WS_RSTD); float* ROWSS = (float*)(p.ws + WS_ROWSS);

    if (IN(0)) for (int rep_ = 0; rep_ < REP_P0; ++rep_) {
        float* scr = (float*)(lds + wave * 16384);
        constexpr int I_IN = 16 * (NPJ / 32), I_PA = 8 * 32, I_PB = 8 * 32, I_OUT = 16 * 32;
        for (int it = gw; it < I_IN + I_PA + I_PB + I_OUT; it += NGW) {
            int r = it;
            if (r < I_IN) { p0_tr_item(p.w_in, 1024, INW, WIN, p.norm_g, 1, scr, r, NPJ / 32, lane); continue; } r -= I_IN;
            if (r < I_PA) { p0_tr_item(p.w_pa, 512, 1024, WPA, nullptr, 0, scr, r, 32, lane); continue; } r -= I_PA;
            if (r < I_PB) { p0_tr_item(p.w_pb, 512, 1024, WPB, nullptr, 0, scr, r, 32, lane); continue; } r -= I_PB;
            p0_tr_item(p.w_out, 1024, 1024, WOUT, nullptr, 0, scr, r, 32, lane);
        }
        for (int m = gw; m < MT; m += NGW) {
            u64* o8 = (u64*)(XH + (size_t)m * DM) + lane;
            if (m < MROWS) {
                const float* xr = (m < MP) ? p.xp + (size_t)m * DM : p.xs + (size_t)(m - MP) * DM;
                const f32x4* x4 = (const f32x4*)xr + lane;
                f32x4 v[4]; float s = 0.f;
#pragma unroll
                for (int j = 0; j < 4; ++j) { v[j] = x4[64 * j]; s += (v[j].x * v[j].x + v[j].y * v[j].y) + (v[j].z * v[j].z + v[j].w * v[j].w); }
                s = wave_sum(s);
                if (lane == 0) RSTD[m] = rsqrtf(s * (1.f / 1024.f) + 1e-6f);
#pragma unroll
                for (int j = 0; j < 4; ++j) { h16x4 h; h[0] = (h16)v[j].x; h[1] = (h16)v[j].y; h[2] = (h16)v[j].z; h[3] = (h16)v[j].w; o8[64 * j] = __builtin_bit_cast(u64, h); }
            } else {
                if (lane == 0) RSTD[m] = 0.f;
#pragma unroll
                for (int j = 0; j < 4; ++j) o8[64 * j] = 0ull;
            }
        }
        const int gt = bx * 512 + tid, NGT = G * 512;
        for (int i = gt; i < NB * NKSP * 64; i += NGT) {
            const int c8 = (i & 63) * 8, r = (i >> 6) % NKSP, b = (i >> 6) / NKSP;
            if (r >= PAST && r < NKS) continue;
            h16x8 h;
            if (r < PAST) { const float* src = (c8 < 256) ? p.ck + ((size_t)b * PAST + r) * 256 + c8 : p.cv + ((size_t)b * PAST + r) * 256 + (c8 - 256);
#pragma unroll
                for (int j = 0; j < 8; ++j) h[j] = (h16)src[j]; }
            else {
#pragma unroll
                for (int j = 0; j < 8; ++j) h[j] = (h16)0.f; }
            *(h16x8*)(KVS + ((size_t)b * NKSP + r) * 512 + c8) = h;
        }
        for (int i = gt; i < NB * NKSP * 8; i += NGT) {
            const int c8 = (i & 7) * 8, r = (i >> 3) % NKSP, b = (i >> 3) / NKSP;
            if (r >= PAST && r < NKS) continue;
            h16x8 h;
            if (r < PAST) { const float* src = p.cki + ((size_t)b * PAST + r) * 64 + c8;
#pragma unroll
                for (int j = 0; j < 8; ++j) h[j] = (h16)src[j]; }
            else {
#pragma unroll
                for (int j = 0; j < 8; ++j) h[j] = (h16)0.f; }
            *(h16x8*)(KIS + ((size_t)b * NKSP + r) * 64 + c8) = h;
        }
        for (int i = gt; i < 8 * 128 * 128; i += NGT) { const int j = i & 127, ii = (i >> 7) & 127; WSM[i] = ((j >> 6) <= (ii >> 6)) ? (h16)p.sgu_w[i] : (h16)0.f; }
    }
    SEAM(0);
    if (IN(1)) for (int rep_ = 0; rep_ < REP_P1; ++rep_) {
        pg8::Gemm g{XH, WIN, MT, NPJ, 1024, 1024}; pg8::StaticOrder S; S.init(MT, NPJ, G, bx);
        EpiProj E{PROJ, RSTD, p.out, KVS, KIS};
        pg8::gemm_phase<EpiProj>((LAS unsigned char*)lds, g, S, E);
    }
    SEAM(1);
    if (IN(2)) for (int rep_ = 0; rep_ < REP_P2; ++rep_) {
        for (int u = bx; u < 512 + NB; u += G) { if (u < 512) sgu_chunk(p, lds, u, wave, lane); else sgu_sample(p, lds, u - 512, wave, lane); }
    }
    if (IN(3)) for (int rep_ = 0; rep_ < REP_P3; ++rep_) {
        for (int u = bx; u < 8192 + 16; u += G) {
            AUnit U;
            if (u < 8192) { const int i = u >> 8, gp = u & 255, b = gp & 7, s = gp >> 3; const int jt = s + 32 * i;
                U.qrow0 = b * SEQ + jt * 8; U.krow0 = b * SEQ; U.nk = ((jt * 8) / 64 + 1) * 64; U.kib = PROJ + C_KI; U.kis = NPJ; U.kvb = PROJ + C_K; U.kvs = NPJ; }
            else { const int v = u - 8192, b = v >> 1, hf = v & 1;
                U.qrow0 = MP + b * 16 + hf * 8; U.krow0 = b * NKSP; U.nk = NKS; U.kib = KIS; U.kis = 64; U.kvb = KVS; U.kvs = 512; }
            attn_unit(p, lds, U, wave, lane, tacc);
        }
    }
    SEAM(3);
    if (IN(4)) for (int rep_ = 0; rep_ < REP_P4; ++rep_) {
        { pg8::Gemm g{(const h16*)(p.ws + WS_AOUT), WPA, MT, 1024, 512, 512}; pg8::StaticOrder S; S.init(MT, 1024, G, bx); EpiGate<1> E{PROJ}; pg8::gemm_phase<EpiGate<1>>((LAS unsigned char*)lds, g, S, E); }
        { pg8::Gemm g{(const h16*)(p.ws + WS_BOUT), WPB, MT, 1024, 512, 512}; pg8::StaticOrder S; S.init(MT, 1024, G, bx); EpiGate<0> E{PROJ}; pg8::gemm_phase<EpiGate<0>>((LAS unsigned char*)lds, g, S, E); }
    }
    SEAM(4);
    if (IN(5)) for (int rep_ = 0; rep_ < REP_P5; ++rep_) {
        pg8::Gemm g{PROJ + C_M, WOUT, MT, 1024, 1024, NPJ}; pg8::StaticOrder S; S.init(MT, 1024, G, bx);
        EpiOut E{p.xp, p.xs, p.out, ROWSS};
        pg8::gemm_phase<EpiOut>((LAS unsigned char*)lds, g, S, E);
    }
    SEAM(5);
    if (IN(6)) {
        for (int m = gw; m < MROWS; m += NGW) {
            float* yr = (m < MP) ? p.out + O_YP + (size_t)m * DM : p.out + O_YS + (size_t)(m - MP) * DM;
            float ssum = (lane < 16) ? ROWSS[(size_t)m * 16 + lane] : 0.f; ssum = wave_sum(ssum);
            const float r = rsqrtf(ssum * (1.f / 1024.f) + 1e-6f);
            f32x4* y4 = (f32x4*)yr + lane; const f32x4* g4 = (const f32x4*)p.final_g + lane;
#pragma unroll
            for (int j = 0; j < 4; ++j) { f32x4 v = y4[64 * j]; const f32x4 gg = g4[64 * j]; v = v * r * gg; y4[64 * j] = v; }
        }
    }
    if (TSEL != 0 && bx == 0 && tid == 0) { const unsigned long long t0 = rt_(); while (rt_() - t0 < tacc) __builtin_amdgcn_s_sleep(8); }
#undef IN
#undef SEAM
}

extern "C" void kernel_launch(void* const* d_in, const int* in_sizes, int n_in, void* d_out, int out_size, void* d_ws, size_t ws_size, hipStream_t stream) {
    static int grid_blocks = 0;
    if (grid_blocks == 0) {
        if (ws_size < WS_END) { fprintf(stderr, "kernel_launch: workspace too small: %zu < %zu\n", ws_size, (size_t)WS_END); grid_blocks = -1; return; }
        int dev = 0, cus = 0, per_cu = 0;
        hipGetDevice(&dev);
        hipDeviceGetAttribute(&cus, hipDeviceAttributeMultiprocessorCount, dev);
        hipFuncSetAttribute((const void*)mk_fwd, hipFuncAttributeMaxDynamicSharedMemorySize, LDS_BYTES);
        hipOccupancyMaxActiveBlocksPerMultiprocessor(&per_cu, (const void*)mk_fwd, 512, LDS_BYTES);
        if (per_cu < 1) { fprintf(stderr, "kernel_launch: occupancy query says %d blocks per CU\n", per_cu); per_cu = 1; }
        grid_blocks = cus * per_cu;
        (void)hipGetLastError();
    }
    if (grid_blocks < 0) return;
    Params p{};
    p.xp = (const float*)d_in[0]; p.xs = (const float*)d_in[1]; p.ck = (const float*)d_in[2]; p.cv = (const float*)d_in[3]; p.cki = (const float*)d_in[4];
    p.norm_g = (const float*)d_in[5]; p.w_in = (const float*)d_in[6]; p.ln_g = (const float*)d_in[7]; p.ln_b = (const float*)d_in[8];
    p.sgu_w = (const float*)d_in[9]; p.sgu_b = (const float*)d_in[10]; p.w_pa = (const float*)d_in[11]; p.w_pb = (const float*)d_in[12];
    p.w_out = (const float*)d_in[13]; p.final_g = (const float*)d_in[14];
    p.out = (float*)d_out; p.ws = (unsigned char*)d_ws; p.ph_lo = 0; p.ph_hi = 7;
    void* args[] = {&p};
    hipError_t e = hipLaunchCooperativeKernel((const void*)mk_fwd, dim3(grid_blocks), dim3(512), args, LDS_BYTES, stream);
    if (e != hipSuccess) fprintf(stderr, "cooperative launch failed: %s (grid %d)\n", hipGetErrorString(e), grid_blocks);
}
```

```cpp
#include <hip/hip_runtime.h>
#include <hip/hip_cooperative_groups.h>
#include <cstdio>
#include <cstdint>
namespace cg = cooperative_groups;
#define REP_P0 1
#define REP_P1 1
#define REP_P2 1
#define REP_P3 1
#define REP_IDX 1
#define REP_ATT 1
#define TSEL 0
__device__ __forceinline__ unsigned long long rt_() { return __builtin_amdgcn_s_memrealtime(); }
#define TBEG(k) unsigned long long tb_##k = 0; if (TSEL == (k)) tb_##k = rt_();
#define TEND(k) if (TSEL == (k)) tacc += rt_() - tb_##k;
#define REP_P4 1
#define REP_P5 1

#define LAS __attribute__((address_space(3)))
typedef _Float16 h16;
typedef _Float16 h16x8 __attribute__((ext_vector_type(8)));
typedef _Float16 h16x4 __attribute__((ext_vector_type(4)));
typedef _Float16 h16x2 __attribute__((ext_vector_type(2)));
typedef float f32x2 __attribute__((ext_vector_type(2)));
typedef float f32x4 __attribute__((ext_vector_type(4)));
typedef float f32x16 __attribute__((ext_vector_type(16)));
typedef unsigned u32x4 __attribute__((ext_vector_type(4)));
typedef unsigned u32x2 __attribute__((ext_vector_type(2)));
typedef unsigned long long u64;

constexpr int DM = 1024, SEQ = 8192, NB = 8, MP = NB * SEQ;
constexpr int DSQ = 16, MS = NB * DSQ, PAST = 1024, NKS = PAST + DSQ, NKSP = 1056;
constexpr int MROWS = MP + MS;
constexpr int MT = MP + 256;
constexpr int INW = 5704, NPJ = 5888;
constexpr int C_U = 0, C_V = 512, C_ZA = 1024, C_Q = 1536, C_K = 2048, C_VV = 2304, C_ZB = 2560, C_QI = 3072, C_KI = 3584, C_WI = 3648, C_GA = 3840, C_GB = 4864;
constexpr size_t O_YP = 0, O_YS = 67108864, O_PK = 67239936, O_PV = 84017152, O_PKI = 100794368, O_SK = 104988672, O_SV = 105021440, O_SKI = 105054208, O_SSV = 105062400;
constexpr size_t WS_XH = 0;
constexpr size_t WS_PROJ = WS_XH + (size_t)MT * DM * 2;
constexpr size_t WS_WIN = WS_PROJ + (size_t)MT * NPJ * 2;
constexpr size_t WS_WPA = WS_WIN + (size_t)NPJ * DM * 2;
constexpr size_t WS_WPB = WS_WPA + (size_t)1024 * 512 * 2;
constexpr size_t WS_WOUT = WS_WPB + (size_t)1024 * 512 * 2;
constexpr size_t WS_WSM = WS_WOUT + (size_t)1024 * 1024 * 2;
constexpr size_t WS_KVS = WS_WSM + (size_t)8 * 128 * 128 * 2;
constexpr size_t WS_KIS = WS_KVS + (size_t)NB * NKSP * 512 * 2;
constexpr size_t WS_RSTD = WS_KIS + (size_t)NB * NKSP * 64 * 2;
constexpr size_t WS_ROWSS = WS_RSTD + (size_t)MT * 4;
constexpr size_t WS_KIC = WS_ROWSS + (size_t)MT * 16 * 4;
constexpr size_t WS_KVC = WS_KIC + (size_t)MP * 64 * 2;
constexpr size_t WS_END = WS_KVC + (size_t)MP * 512 * 2;
constexpr size_t WS_AOUT = WS_XH, WS_BOUT = WS_XH + (size_t)MT * 512 * 2;
constexpr int C_T = 0, C_M = 1024;
constexpr int LDS_BYTES = 155648;

__device__ __forceinline__ float sigmoidf_(float x) { return 1.f / (1.f + __expf(-x)); }
__device__ __forceinline__ float siluf_(float x) { return x / (1.f + __expf(-x)); }
__device__ __forceinline__ float geluf_(float x) { const float t = 1.5957691216057308f * (x + 0.044715f * x * x * x); return x / (1.f + __expf(-t)); }
__device__ __forceinline__ int lane_id() { int l; asm volatile("v_mbcnt_lo_u32_b32 %0, -1, 0\n\tv_mbcnt_hi_u32_b32 %0, -1, %0" : "=v"(l)); return l; }
__device__ __forceinline__ float wave_sum(float v) {
#pragma unroll
    for (int o = 1; o < 64; o <<= 1) v += __shfl_xor(v, o);
    return v;
}

namespace pg8 {
constexpr int BM = 256, BK = 64, HALF = 128, HTB = HALF * BK * 2, STAGE_BYTES = 8 * HTB, NXCD = 8, WGM = 8;
__host__ __device__ __forceinline__ int lds_byte(int r, int c) { const int st = (r >> 4) * 2 + (c >> 5), rr = r & 15, cc = c & 31, ob = rr * 64 + cc * 2; return st * 1024 + (ob ^ (((ob >> 9) & 1) << 5)); }
__host__ __device__ __forceinline__ void stage_rc(int b, int& R, int& C) { const int st = b / 1024, sb = b % 1024, swz = sb ^ (((sb >> 9) & 1) << 5); R = (st >> 1) * 16 + swz / 64; C = (st & 1) * 32 + (swz % 64) / 2; }
__host__ __device__ __forceinline__ int perm32(int rho) { const int n = rho >> 4, i = rho & 15; return 8 * (i >> 2) + 4 * n + (i & 3); }
struct Unit { int pm, pn; };
struct Gemm { const h16* A; const h16* Bt; int M, N, K, lda; };
struct StaticOrder {
    int nM, nN, nwg, G, c;
    __device__ void init(int M, int N, int G_, int c_) { nM = M / BM; nN = N / BM; nwg = nM * nN; G = G_; c = c_; }
    __device__ bool next(int i, Unit& u) const {
        const long L = (long)i * G + c; if (L >= nwg) return false;
        int wgid = (int)L; { const int q = nwg / NXCD, r = nwg % NXCD, xcd = wgid % NXCD, off = wgid / NXCD; wgid = (xcd < r ? xcd * (q + 1) : r * (q + 1) + (xcd - r) * q) + off; }
        const int nig = WGM * nN, gid = wgid / nig, fm = gid * WGM, gsz = (nM - fm) < WGM ? (nM - fm) : WGM;
        u.pm = fm + ((wgid % nig) % gsz); u.pn = (wgid % nig) / gsz; return true;
    }
};
template <class Epi>
__device__ __forceinline__ void gemm_phase(LAS unsigned char* lds, const Gemm g, const StaticOrder& S, const Epi& E) {
    const int tid = threadIdx.x, wid = __builtin_amdgcn_readfirstlane(tid >> 6), lane = tid & 63, wr = wid >> 2, wc = wid & 3, fr = lane & 15, fq = lane >> 4;
    const int K = g.K, nt = K / BK, lda = g.lda;
    unsigned voffA[2], voffB[2];
#pragma unroll
    for (int i = 0; i < 2; ++i) { int R, C; stage_rc(tid * 16 + i * 8192, R, C); const int Rb = (R & ~31) + perm32(R & 31);
        voffA[i] = (unsigned)(R * lda + C) * 2u; voffB[i] = (unsigned)(Rb * K + C) * 2u; }
    const size_t kstep = (size_t)(BK * 2);
    const size_t hstepA = (size_t)HALF * lda * 2, hstepB = (size_t)HALF * K * 2;
    const size_t tstepA = 2 * hstepA, tstepB = 2 * hstepB;
    const unsigned ldsw = (unsigned)wid * 1024u;
    const int aoff = lds_byte(wr * 64 + fr, fq * 8), boff = lds_byte(wc * 32 + fr, fq * 8);
#define PG8_SA(b, h) (((b) * 2 + (h)) * HTB)
#define PG8_SB(b, h) ((4 + (b) * 2 + (h)) * HTB)
#define PG8_STAGE(bufoff, gbase, voff) do { _Pragma("unroll") for (int _i = 0; _i < 2; ++_i) \
        __builtin_amdgcn_global_load_lds((const unsigned*)((const char*)(gbase) + (voff)[_i]), (LAS unsigned*)(lds + (bufoff) + ldsw + _i * 8192), 16, 0, 0); } while (0)
#define PG8_LDA(dst, b, h) do { _Pragma("unroll") for (int m = 0; m < 4; ++m) _Pragma("unroll") for (int k = 0; k < 2; ++k) dst[m][k] = *(const LAS h16x8*)(lds + PG8_SA(b, h) + aoff + m * 2048 + k * 1024); } while (0)
#define PG8_LDB(dst, b, h) do { _Pragma("unroll") for (int n = 0; n < 2; ++n) _Pragma("unroll") for (int k = 0; k < 2; ++k) dst[n][k] = *(const LAS h16x8*)(lds + PG8_SB(b, h) + boff + n * 2048 + k * 1024); } while (0)
#define PG8_MMA(ai, bj, At, Bt) do { __builtin_amdgcn_s_setprio(1); _Pragma("unroll") for (int m = 0; m < 4; ++m) _Pragma("unroll") for (int n = 0; n < 2; ++n) _Pragma("unroll") for (int k = 0; k < 2; ++k) \
        acc[ai][bj][m][n] = __builtin_amdgcn_mfma_f32_16x16x32_f16(Bt[n][k], At[m][k], acc[ai][bj][m][n], 0, 0, 0); __builtin_amdgcn_s_setprio(0); } while (0)
#define PG8_WAIT_V(n) asm volatile("s_waitcnt vmcnt(" #n ")" ::: "memory")
#define PG8_WAIT_L(n) asm volatile("s_waitcnt lgkmcnt(" #n ")" ::: "memory")
#define PG8_BAR __builtin_amdgcn_s_barrier()
#define PG8_SCHED __builtin_amdgcn_sched_barrier(0)
    Unit cur, nxt; int ui = 0;
    if (!S.next(0, cur)) return;
    f32x4 acc[2][2][4][2];
#pragma unroll
    for (int a = 0; a < 2; ++a)
#pragma unroll
        for (int b = 0; b < 2; ++b)
#pragma unroll
            for (int m = 0; m < 4; ++m)
#pragma unroll
                for (int n = 0; n < 2; ++n) acc[a][b][m][n] = (f32x4){0.f, 0.f, 0.f, 0.f};
    h16x8 At[4][2], B0[2][2], B1[2][2];
    const char* cA = (const char*)g.A + (size_t)cur.pm * tstepA; const char* cB = (const char*)g.Bt + (size_t)cur.pn * tstepB;
    PG8_STAGE(PG8_SB(0, 0), cB, voffB); PG8_STAGE(PG8_SB(0, 1), cB + hstepB, voffB); PG8_STAGE(PG8_SA(0, 0), cA, voffA); PG8_STAGE(PG8_SA(0, 1), cA + hstepA, voffA);
    if (wr == 1) PG8_BAR;
    PG8_WAIT_V(2); PG8_BAR;
    PG8_STAGE(PG8_SB(1, 0), cB + kstep, voffB); PG8_STAGE(PG8_SA(1, 0), cA + kstep, voffA); PG8_STAGE(PG8_SB(1, 1), cB + hstepB + kstep, voffB);
    PG8_WAIT_V(6); PG8_BAR;
    for (;;) {
        const bool has_next = S.next(ui + 1, nxt);
        const char* nA = has_next ? (const char*)g.A + (size_t)nxt.pm * tstepA : cA; const char* nB = has_next ? (const char*)g.Bt + (size_t)nxt.pn * tstepB : cB;
        for (int t = 0; t < nt; t += 2) {
            const bool last = (t == nt - 2);
            const char* a1 = cA + (size_t)(t + 1) * kstep;
            const char* a2 = last ? nA : cA + (size_t)(t + 2) * kstep; const char* b2 = last ? nB : cB + (size_t)(t + 2) * kstep;
            const char* a3 = a2 + kstep; const char* b3 = b2 + kstep;
            PG8_LDB(B0, 0, 0); PG8_LDB(B1, 0, 1); PG8_SCHED; PG8_LDA(At, 0, 0); PG8_STAGE(PG8_SA(1, 1), a1 + hstepA, voffA);
            PG8_WAIT_V(8); PG8_WAIT_L(0); PG8_BAR; PG8_MMA(0, 0, At, B0); PG8_MMA(0, 1, At, B1); PG8_BAR; PG8_SCHED;
            PG8_LDA(At, 0, 1); PG8_STAGE(PG8_SB(0, 0), b2, voffB); PG8_STAGE(PG8_SB(0, 1), b2 + hstepB, voffB); PG8_STAGE(PG8_SA(0, 0), a2, voffA);
            PG8_WAIT_V(8); PG8_WAIT_L(0); PG8_BAR; PG8_MMA(1, 0, At, B0); PG8_MMA(1, 1, At, B1); PG8_BAR; PG8_SCHED;
            PG8_LDB(B0, 1, 0); PG8_LDB(B1, 1, 1); PG8_SCHED; PG8_LDA(At, 1, 0); PG8_STAGE(PG8_SA(0, 1), a2 + hstepA, voffA);
            PG8_WAIT_V(8); PG8_WAIT_L(0); PG8_BAR; PG8_MMA(0, 0, At, B0); PG8_MMA(0, 1, At, B1); PG8_BAR; PG8_SCHED;
            PG8_LDA(At, 1, 1); PG8_STAGE(PG8_SB(1, 0), b3, voffB); PG8_STAGE(PG8_SB(1, 1), b3 + hstepB, voffB); PG8_STAGE(PG8_SA(1, 0), a3, voffA);
            PG8_WAIT_V(8); PG8_WAIT_L(0); PG8_BAR; PG8_MMA(1, 0, At, B0); PG8_MMA(1, 1, At, B1); PG8_BAR; PG8_SCHED;
        }
        if (wr == 0) PG8_BAR;
        E(acc, cur, wr, wc, fr, fq);
        if (!has_next) break;
#pragma unroll
        for (int a = 0; a < 2; ++a)
#pragma unroll
            for (int b = 0; b < 2; ++b)
#pragma unroll
                for (int m = 0; m < 4; ++m)
#pragma unroll
                    for (int n = 0; n < 2; ++n) acc[a][b][m][n] = (f32x4){0.f, 0.f, 0.f, 0.f};
        cur = nxt; cA = nA; cB = nB; ++ui;
        if (wr == 1) PG8_BAR;
    }
    PG8_WAIT_V(0);
    PG8_BAR;
#undef PG8_SA
#undef PG8_SB
#undef PG8_STAGE
#undef PG8_LDA
#undef PG8_LDB
#undef PG8_MMA
#undef PG8_WAIT_V
#undef PG8_WAIT_L
#undef PG8_BAR
#undef PG8_SCHED
}
}

__device__ __forceinline__ u64 pack8_fp8(const f32x4 a, const f32x4 b) {
    int w0 = __builtin_amdgcn_cvt_pk_fp8_f32(a[0], a[1], 0, false); w0 = __builtin_amdgcn_cvt_pk_fp8_f32(a[2], a[3], w0, true);
    int w1 = __builtin_amdgcn_cvt_pk_fp8_f32(b[0], b[1], 0, false); w1 = __builtin_amdgcn_cvt_pk_fp8_f32(b[2], b[3], w1, true);
    return (u64)(unsigned)w0 | ((u64)(unsigned)w1 << 32);
}
__device__ __forceinline__ h16x8 fp8x8_to_h16(const u64 v) {
    const int w0 = (int)(unsigned)v, w1 = (int)(unsigned)(v >> 32);
    const f32x2 a = __builtin_amdgcn_cvt_pk_f32_fp8(w0, false), b = __builtin_amdgcn_cvt_pk_f32_fp8(w0, true), c = __builtin_amdgcn_cvt_pk_f32_fp8(w1, false), d = __builtin_amdgcn_cvt_pk_f32_fp8(w1, true);
    h16x8 h; h[0] = (h16)a.x; h[1] = (h16)a.y; h[2] = (h16)b.x; h[3] = (h16)b.y; h[4] = (h16)c.x; h[5] = (h16)c.y; h[6] = (h16)d.x; h[7] = (h16)d.y;
    return h;
}
__device__ __forceinline__ int kvpos(int lc) { if (lc >= 256) return lc; const int j = lc >> 6, d = lc & 63; return j * 64 + ((d & 31) >> 3) * 16 + (d >> 5) * 8; }
__device__ __forceinline__ u32x4 pack8(const f32x4 a, const f32x4 b) {
    h16x8 h; h[0] = (h16)a[0]; h[1] = (h16)a[1]; h[2] = (h16)a[2]; h[3] = (h16)a[3]; h[4] = (h16)b[0]; h[5] = (h16)b[1]; h[6] = (h16)b[2]; h[7] = (h16)b[3];
    return __builtin_bit_cast(u32x4, h);
}

struct EpiProj {
    h16* PROJ; const float* rstd; float* dout; unsigned char* KVS; h16* KIS; unsigned char* KVC; h16* KIC;
    __device__ __forceinline__ void operator()(const f32x4 (&acc)[2][2][4][2], const pg8::Unit& u, int wr, int wc, int fr, int fq) const {
        const int row0 = u.pm * 256 + wr * 64 + fr, col0 = u.pn * 256 + wc * 32 + 8 * fq;
        const int pn = u.pn;
#pragma unroll
        for (int ai = 0; ai < 2; ++ai)
#pragma unroll
            for (int m = 0; m < 4; ++m) {
                const int row = row0 + ai * 128 + m * 16; const float rs = rstd[row];
#pragma unroll
                for (int bj = 0; bj < 2; ++bj) {
                    const int c = col0 + bj * 128;
                    const f32x4 v0 = acc[ai][bj][m][0] * rs, v1 = acc[ai][bj][m][1] * rs;
                    if (pn != 8 && pn != 9) *(u32x4*)(PROJ + (size_t)row * NPJ + c) = pack8(v0, v1);
                    if (pn == 8 || pn == 9 || (pn == 14 && c < C_KI + 64)) {
                        if (row < MP) {
                            float* o = (pn == 8) ? dout + O_PK + (size_t)row * 256 + (c - C_K) : (pn == 9) ? dout + O_PV + (size_t)row * 256 + (c - C_VV) : dout + O_PKI + (size_t)row * 64 + (c - C_KI);
                            *(f32x4*)o = v0; *(f32x4*)(o + 4) = v1;
                            if (pn == 14) *(u32x4*)(KIC + (size_t)row * 64 + (c - C_KI)) = pack8(v0, v1);
                            else *(u64*)(KVC + (size_t)row * 512 + kvpos(c - C_K)) = pack8_fp8(v0, v1);
                        } else if (row < MROWS) {
                            const int t = row - MP, b = t >> 4, s = t & 15; const size_t kr = (size_t)b * NKSP + PAST + s;
                            float* o = (pn == 8) ? dout + O_SK + (size_t)t * 256 + (c - C_K) : (pn == 9) ? dout + O_SV + (size_t)t * 256 + (c - C_VV) : dout + O_SKI + (size_t)t * 64 + (c - C_KI);
                            *(f32x4*)o = v0; *(f32x4*)(o + 4) = v1;
                            if (pn == 14) *(u32x4*)(KIS + kr * 64 + (c - C_KI)) = pack8(v0, v1);
                            else *(u64*)(KVS + kr * 512 + kvpos(c - C_K)) = pack8_fp8(v0, v1);
                        }
                    }
                }
            }
    }
};
template <int FIRST> struct EpiGate {
    h16* PROJ;
    __device__ __forceinline__ void operator()(const f32x4 (&acc)[2][2][4][2], const pg8::Unit& u, int wr, int wc, int fr, int fq) const {
        const int row0 = u.pm * 256 + wr * 64 + fr, col0 = u.pn * 256 + wc * 32 + 8 * fq;
#pragma unroll
        for (int ai = 0; ai < 2; ++ai)
#pragma unroll
            for (int m = 0; m < 4; ++m) {
                const int row = row0 + ai * 128 + m * 16;
#pragma unroll
                for (int bj = 0; bj < 2; ++bj) {
                    const int c = col0 + bj * 128;
                    h16* pm_ = PROJ + (size_t)row * NPJ + (FIRST ? C_T : C_M) + c;
                    const h16x8 gt = *(const h16x8*)(PROJ + (size_t)row * NPJ + (FIRST ? C_GA : C_GB) + c);
                    f32x4 v0, v1;
#pragma unroll
                    for (int j = 0; j < 4; ++j) { v0[j] = sigmoidf_((float)gt[j]) * acc[ai][bj][m][0][j]; v1[j] = sigmoidf_((float)gt[4 + j]) * acc[ai][bj][m][1][j]; }
                    if (!FIRST) { const h16x8 tp = *(const h16x8*)(PROJ + (size_t)row * NPJ + C_T + c);
#pragma unroll
                        for (int j = 0; j < 4; ++j) { v0[j] += (float)tp[j]; v1[j] += (float)tp[4 + j]; } }
                    *(u32x4*)pm_ = pack8(v0, v1);
                }
            }
    }
};
struct EpiOut {
    const float* xp; const float* xs; float* dout; float* rowss;
    __device__ __forceinline__ void operator()(const f32x4 (&acc)[2][2][4][2], const pg8::Unit& u, int wr, int wc, int fr, int fq) const {
        const int row0 = u.pm * 256 + wr * 64 + fr, col0 = u.pn * 256 + wc * 32 + 8 * fq;
#pragma unroll
        for (int ai = 0; ai < 2; ++ai)
#pragma unroll
            for (int m = 0; m < 4; ++m) {
                const int row = row0 + ai * 128 + m * 16;
                const bool ok = row < MROWS;
                const float* xr = (row < MP) ? xp + (size_t)row * DM : xs + (size_t)(row - MP) * DM;
                float* yr = (row < MP) ? dout + O_YP + (size_t)row * DM : dout + O_YS + (size_t)(row - MP) * DM;
                float ss = 0.f;
                if (ok) {
#pragma unroll
                    for (int bj = 0; bj < 2; ++bj) {
                        const int c = col0 + bj * 128;
                        const f32x4 x0 = *(const f32x4*)(xr + c), x1 = *(const f32x4*)(xr + c + 4);
                        const f32x4 v0 = x0 + acc[ai][bj][m][0], v1 = x1 + acc[ai][bj][m][1];
                        *(f32x4*)(yr + c) = v0; *(f32x4*)(yr + c + 4) = v1;
                        ss += v0[0] * v0[0] + v0[1] * v0[1] + v0[2] * v0[2] + v0[3] * v0[3] + v1[0] * v1[0] + v1[1] * v1[1] + v1[2] * v1[2] + v1[3] * v1[3];
                    }
                }
                ss += __shfl_xor(ss, 16); ss += __shfl_xor(ss, 32);
                if (ok && fq == 0) rowss[(size_t)row * 16 + u.pn * 4 + wc] = ss;
            }
    }
};

struct Params {
    const float *xp, *xs, *ck, *cv, *cki, *norm_g, *w_in, *ln_g, *ln_b, *sgu_w, *sgu_b, *w_pa, *w_pb, *w_out, *final_g;
    float* out; unsigned char* ws; int ph_lo, ph_hi;
};

__device__ __forceinline__ void p0_tr_item(const float* W, int K, int Nsrc, h16* WT, const float* gs, int mode, float* scr, int item, int nblk, int lane) {
    const int kb = item / nblk, nb = item % nblk, k0 = 64 * kb, n0 = 32 * nb;
    const int nn = n0 + (lane & 31);
    int src = nn; bool valid = true;
    if (mode == 1) { if (nn >= C_WI + 8 && nn < C_GA) valid = false; else if (nn >= C_GA) src = nn - (C_GA - (C_WI + 8)); }
#pragma unroll 8
    for (int i = 0; i < 32; ++i) { const int kk = 2 * i + (lane >> 5);
        float v = 0.f; if (valid) { v = W[(size_t)(k0 + kk) * Nsrc + src]; if (gs) v *= gs[k0 + kk]; }
        scr[kk * 33 + (lane & 31)] = v; }
    __builtin_amdgcn_s_waitcnt(0); asm volatile("" ::: "memory");
    const int c = lane & 7;
#pragma unroll
    for (int j = 0; j < 4; ++j) { const int n = (lane >> 3) + 8 * j; const float* s = scr + (8 * c) * 33 + n;
        h16x8 h;
#pragma unroll
        for (int q = 0; q < 8; ++q) h[q] = (h16)s[q * 33];
        *(h16x8*)(WT + (size_t)(n0 + n) * K + k0 + 8 * c) = h; }
    __builtin_amdgcn_s_waitcnt(0); asm volatile("" ::: "memory");
}

constexpr int VNT_LD = 136;
__device__ __forceinline__ void sgu_chunk(const Params& p, unsigned char* lds, int chunk, int wave, int lane) {
    h16* PROJ = (h16*)(p.ws + WS_PROJ);
    h16* vnT = (h16*)lds;
    h16* AOUT = (h16*)(p.ws + WS_AOUT);
    const h16* WSM = (const h16*)(p.ws + WS_WSM);
    {
        float lg[8], lb[8];
#pragma unroll
        for (int j = 0; j < 8; ++j) { lg[j] = p.ln_g[lane * 8 + j]; lb[j] = p.ln_b[lane * 8 + j]; }
        for (int tt = 0; tt < 16; ++tt) {
            const int tok = wave * 16 + tt; const size_t row = (size_t)chunk * 128 + tok;
            const h16x8 vv = *(const h16x8*)(PROJ + row * NPJ + C_V + lane * 8);
            float g[8]; float s = 0.f;
#pragma unroll
            for (int j = 0; j < 8; ++j) { g[j] = geluf_((float)vv[j]); s += g[j]; }
            const float mean = wave_sum(s) * (1.f / 512.f); float q = 0.f;
#pragma unroll
            for (int j = 0; j < 8; ++j) { g[j] -= mean; q += g[j] * g[j]; }
            const float rstd = rsqrtf(wave_sum(q) * (1.f / 512.f) + 1e-5f);
#pragma unroll
            for (int j = 0; j < 8; ++j) vnT[(lane * 8 + j) * VNT_LD + tok] = (h16)(g[j] * rstd * lg[j] + lb[j]);
        }
    }
    __syncthreads();
    {
        const int g = wave, fr = lane & 15, fq = lane >> 4;
        for (int it = 0; it < 8; ++it) {
            f32x4 acc[4];
#pragma unroll
            for (int dt = 0; dt < 4; ++dt) acc[dt] = (f32x4){0.f, 0.f, 0.f, 0.f};
            const int nks = (it < 4) ? 2 : 4;
            for (int ks = 0; ks < nks; ++ks) {
                const h16x8 b = *(const h16x8*)(WSM + ((size_t)g * 128 + it * 16 + fr) * 128 + ks * 32 + fq * 8);
#pragma unroll
                for (int dt = 0; dt < 4; ++dt) {
                    const h16x8 a = *(const h16x8*)(vnT + (g * 64 + dt * 16 + fr) * VNT_LD + ks * 32 + fq * 8);
                    acc[dt] = __builtin_amdgcn_mfma_f32_16x16x32_f16(a, b, acc[dt], 0, 0, 0);
                }
            }
            const int i = it * 16 + fr; const size_t row = (size_t)chunk * 128 + i;
            const float bias = p.sgu_b[g * 128 + i];
#pragma unroll
            for (int dt = 0; dt < 4; ++dt) {
                const int c = g * 64 + dt * 16 + fq * 4;
                const h16x4 uu = *(const h16x4*)(PROJ + row * NPJ + C_U + c); const h16x4 zz = *(const h16x4*)(PROJ + row * NPJ + C_ZA + c);
                h16x4 o;
#pragma unroll
                for (int r = 0; r < 4; ++r) o[r] = (h16)(geluf_((float)uu[r]) * (acc[dt][r] + bias) * siluf_((float)zz[r]));
                *(h16x4*)(AOUT + row * 512 + c) = o;
            }
        }
    }
    __syncthreads();
}
__device__ __forceinline__ void sgu_sample(const Params& p, unsigned char* lds, int b, int wave, int lane) {
    h16* PROJ = (h16*)(p.ws + WS_PROJ);
    float* vnS = (float*)lds;
    for (int tt = 0; tt < 2; ++tt) {
        const int t = wave * 2 + tt; const size_t row = (size_t)MP + b * 16 + t;
        const h16x8 vv = *(const h16x8*)(PROJ + row * NPJ + C_V + lane * 8);
        float g[8]; float s = 0.f;
#pragma unroll
        for (int j = 0; j < 8; ++j) { g[j] = geluf_((float)vv[j]); s += g[j]; }
        const float mean = wave_sum(s) * (1.f / 512.f); float q = 0.f;
#pragma unroll
        for (int j = 0; j < 8; ++j) { g[j] -= mean; q += g[j] * g[j]; }
        const float rstd = rsqrtf(wave_sum(q) * (1.f / 512.f) + 1e-5f);
#pragma unroll
        for (int j = 0; j < 8; ++j) { const int c = lane * 8 + j; const float v = g[j] * rstd * p.ln_g[c] + p.ln_b[c];
            vnS[t * 512 + c] = v; p.out[O_SSV + (size_t)(b * 16 + t) * 512 + c] = v; }
    }
    __syncthreads();
    {
        const int c = threadIdx.x, g = c >> 6;
        float vn[16];
#pragma unroll
        for (int j = 0; j < 16; ++j) vn[j] = vnS[j * 512 + c];
        for (int i = 0; i < 16; ++i) {
            float mixed = p.sgu_b[g * 128 + i];
#pragma unroll
            for (int j = 0; j < 16; ++j) mixed += p.sgu_w[((size_t)g * 128 + i) * 128 + j] * vn[j];
            const size_t row = (size_t)MP + b * 16 + i;
            const float u = (float)PROJ[row * NPJ + C_U + c], za = (float)PROJ[row * NPJ + C_ZA + c];
            ((h16*)(p.ws + WS_AOUT))[row * 512 + c] = (h16)(geluf_(u) * mixed * siluf_(za));
        }
    }
    __syncthreads();
}

constexpr int TK_C = 2048, TK_TRIG = TK_C - 512;
constexpr int L3_QA = 147456;
constexpr int L3_HIST = 131072, L3_CNT = L3_HIST + 8192, L3_THR = L3_CNT + 32, L3_SUM = L3_THR + 32;
__device__ __forceinline__ unsigned fkey(float f) { const unsigned u = __float_as_uint(f); return (u & 0x80000000u) ? ~u : (u | 0x80000000u); }
__device__ __forceinline__ float fkey_inv(unsigned k) { return __uint_as_float((k & 0x80000000u) ? (k ^ 0x80000000u) : ~k); }

template <bool ON_LO>
__device__ __forceinline__ unsigned radix_select(const u64* buf, unsigned* hist, int n, int lane, unsigned fhi, int k, int& ceq_out, int& krem_out) {
    unsigned prefix = 0, pmask = 0; int krem = k; int ceq = 0;
    for (int shift = 24; shift >= 0; shift -= 8) {
        *(u32x4*)(hist + 4 * lane) = (u32x4){0u, 0u, 0u, 0u};
        __builtin_amdgcn_s_waitcnt(0); asm volatile("" ::: "memory");
        for (int i = lane; i < n; i += 64) {
            const u64 e = buf[i]; const unsigned hi = (unsigned)(e >> 32), lo = (unsigned)e;
            const unsigned key = ON_LO ? lo : hi;
            const bool ok = (ON_LO ? (hi == fhi) : true) && ((key & pmask) == prefix);
            if (ok) atomicAdd(hist + ((key >> shift) & 255u), 1u);
        }
        __builtin_amdgcn_s_waitcnt(0); asm volatile("" ::: "memory");
        const u32x4 hv = *(const u32x4*)(hist + 4 * lane);
        const unsigned s = hv.x + hv.y + hv.z + hv.w;
        unsigned S = s;
#pragma unroll
        for (int o = 1; o < 64; o <<= 1) { const unsigned t = __shfl_down(S, o); if (lane + o < 64) S += t; }
        const bool is = (S >= (unsigned)krem) && (S - s < (unsigned)krem);
        const u64 bm = __ballot(is);
        const int L = bm ? (__ffsll((long long)bm) - 1) : 0;
        unsigned d = 0, cab = S - s, ce = 0;
        { unsigned c = S - s;
          if (c + hv.w >= (unsigned)krem) { d = 3; cab = c; ce = hv.w; }
          else { c += hv.w; if (c + hv.z >= (unsigned)krem) { d = 2; cab = c; ce = hv.z; }
          else { c += hv.z; if (c + hv.y >= (unsigned)krem) { d = 1; cab = c; ce = hv.y; }
          else { c += hv.y; d = 0; cab = c; ce = hv.x; } } } }
        d = __shfl(d, L); cab = __shfl(cab, L); ce = __shfl(ce, L);
        const unsigned digit = 4u * (unsigned)L + d;
        krem -= (int)cab; ceq = (int)ce; prefix |= digit << shift; pmask |= 255u << shift;
    }
    ceq_out = ceq; krem_out = krem;
    return prefix;
}
__device__ __forceinline__ int tk_compact(u64* buf, unsigned* hist, int n, int lane_in, float& thr) {
    int lane = lane_in; asm volatile("" : "+v"(lane));
    unsigned ehi[32];
    const unsigned* b32 = (const unsigned*)buf;
#pragma unroll
    for (int j = 0; j < 32; ++j) { ehi[j] = 0u; if (64 * j < n) { const int ic = min(lane + 64 * j, n - 1); ehi[j] = b32[2 * ic + 1]; } }
    unsigned mn = 0xFFFFFFFFu, mx = 0u;
#pragma unroll
    for (int j = 0; j < 32; ++j) { if (64 * j < n) { mn = min(mn, ehi[j]); mx = max(mx, ehi[j]); } }
#pragma unroll
    for (int o = 1; o < 64; o <<= 1) { mn = min(mn, (unsigned)__shfl_xor((int)mn, o)); mx = max(mx, (unsigned)__shfl_xor((int)mx, o)); }
    const unsigned range = mx - mn; const int sh = range ? __clz(range) : 0;
#pragma unroll
    for (int j = 0; j < 32; ++j) { const unsigned nk = (ehi[j] - mn) << sh; ehi[j] = ((lane + 64 * j) < n) ? nk : 0u; }
    const unsigned ninv = (unsigned)(((n + 63) & ~63) - n);
    unsigned prefix = 0, pmask = 0; int krem = 256; bool done = false;
    for (int shift = 24; shift >= 0 && !done; shift -= 8) {
        *(u32x4*)(hist + 4 * lane) = (u32x4){0u, 0u, 0u, 0u};
        __builtin_amdgcn_s_waitcnt(0); asm volatile("" ::: "memory");
#pragma unroll
        for (int j = 0; j < 32; ++j) { if (64 * j < n) { if ((ehi[j] & pmask) == prefix) atomicAdd(hist + ((ehi[j] >> shift) & 255u), 1u); } }
        __builtin_amdgcn_s_waitcnt(0); asm volatile("" ::: "memory");
        u32x4 hv = *(const u32x4*)(hist + 4 * lane);
        if (lane == 0 && prefix == 0u) hv.x -= ninv;
        const unsigned s = hv.x + hv.y + hv.z + hv.w;
        unsigned S = s;
#pragma unroll
        for (int o = 1; o < 64; o <<= 1) { const unsigned t = __shfl_down(S, o); if (lane + o < 64) S += t; }
        const bool is = (S >= (unsigned)krem) && (S - s < (unsigned)krem);
        const u64 bm = __ballot(is);
        const int L = bm ? (__ffsll((long long)bm) - 1) : 0;
        unsigned d = 0, cab = S - s, ce = 0;
        { unsigned c = S - s;
          if (c + hv.w >= (unsigned)krem) { d = 3; cab = c; ce = hv.w; }
          else { c += hv.w; if (c + hv.z >= (unsigned)krem) { d = 2; cab = c; ce = hv.z; }
          else { c += hv.z; if (c + hv.y >= (unsigned)krem) { d = 1; cab = c; ce = hv.y; }
          else { c += hv.y; d = 0; cab = c; ce = hv.x; } } } }
        d = __shfl(d, L); cab = __shfl(cab, L); ce = __shfl(ce, L);
        krem -= (int)cab; prefix |= (4u * (unsigned)L + d) << shift; pmask |= 255u << shift;
        if ((int)ce == krem) done = true;
    }
    unsigned tlo = 0u;
    const unsigned thi_abs = mn + ((prefix + ((1u << sh) - 1u)) >> sh);
    if (!done) { int c2, k2; tlo = radix_select<true>(buf, hist, n, lane, mn + (prefix >> sh), krem, c2, k2); }
    int outn = 0;
#pragma unroll
    for (int j = 0; j < 32; ++j) {
        if (64 * j < n) {
            const int i = lane + 64 * j; const int ic = min(i, n - 1);
            const unsigned elo_ = b32[2 * ic];
            const bool keep = (i < n) && ((ehi[j] > prefix) || ((ehi[j] & pmask) == prefix && (done || elo_ >= tlo)));
            const u64 bm = __ballot(keep);
            const int off = __builtin_amdgcn_mbcnt_hi((unsigned)(bm >> 32), __builtin_amdgcn_mbcnt_lo((unsigned)bm, 0u));
            if (keep) buf[outn + off] = ((u64)(mn + (ehi[j] >> sh)) << 32) | (u64)elo_;
            outn += __popcll(bm);
        }
    }
    __builtin_amdgcn_s_waitcnt(0); asm volatile("" ::: "memory");
    thr = fkey_inv(thi_abs - 1u);
    return outn;
}

struct AUnit { int qrow0, krow0, nk; const h16* kib; int kis; const unsigned char* kvb; int kvs; };

__device__ __forceinline__ void attn_unit(const Params& p, unsigned char* lds, const AUnit U, int wave, int lane, unsigned long long& tacc) {
    h16* PROJ = (h16*)(p.ws + WS_PROJ);
    u64* bufall = (u64*)lds;
    unsigned* hist = (unsigned*)(lds + L3_HIST) + wave * 256;
    unsigned* cnt = (unsigned*)(lds + L3_CNT);
    float* thrs = (float*)(lds + L3_THR);
    float* sums = (float*)(lds + L3_SUM) + wave * 8;
    int lane_r = lane; asm volatile("" : "+v"(lane_r));
    const int half = lane_r >> 5, l31 = lane_r & 31;
    h16x8 wq[2][2];
    h16x8* qalds = (h16x8*)(lds + L3_QA);
#define LOADQ() do { _Pragma("unroll") for (int mt = 0; mt < 2; ++mt) _Pragma("unroll") for (int e = 0; e < 2; ++e) \
        wq[mt][e] = *(const h16x8*)(PROJ + (size_t)(U.qrow0 + mt * 4 + 2 * half + e) * NPJ + C_WI); } while (0)
    {
        int lane_s = lane; asm volatile("" : "+v"(lane_s)); const int l31 = lane_s & 31, half = lane_s >> 5;
        const int ql = 2 * ((l31 >> 2) & 1) + (l31 >> 4), hh = ((l31 >> 3) & 1) * 4 + (l31 & 3);
        const int mt_ = wave >> 2, ks_ = wave & 3;
        qalds[wave * 64 + lane_s] = *(const h16x8*)(PROJ + (size_t)(U.qrow0 + mt_ * 4 + ql) * NPJ + C_QI + hh * 64 + half * 8 + ks_ * 16);
    }
    __builtin_amdgcn_sched_barrier(0);
    LOADQ();
    __builtin_amdgcn_sched_barrier(0);
    for (int repi_ = 0; repi_ < REP_IDX; ++repi_) {
    __syncthreads();
    { const int t8 = lane_id(); if (wave == 0 && t8 < 8) { cnt[t8] = 0u; thrs[t8] = -__builtin_inff(); } }
    __syncthreads();
    const int nkt = (U.nk + 31) >> 5, rounds = (nkt + 15) >> 4;
    h16x8 bf[2][4], bn[2][4];
#define LOADB(dst, rdx) do { _Pragma("unroll") for (int rr = 0; rr < 2; ++rr) { const int kt_ = (rdx) * 16 + rr * 8 + wave; const int ktc_ = kt_ < nkt ? kt_ : nkt - 1; \
        const h16* kp_ = U.kib + (size_t)(U.krow0 + ktc_ * 32 + l31) * U.kis + half * 8; \
        _Pragma("unroll") for (int ks = 0; ks < 4; ++ks) dst[rr][ks] = *(const h16x8*)(kp_ + ks * 16); } } while (0)
    TBEG(1)
    LOADB(bf, 0);
#pragma unroll 1
    for (int rd = 0; rd < rounds; rd += 2) {
        LOADB(bn, rd + 1);
#pragma unroll
        for (int rr = 0; rr < 2; ++rr) {
            const int kt = (rd) * 16 + rr * 8 + wave;
            if (kt < nkt) {
                const int key = kt * 32 + l31; const bool kvalid = key < U.nk;
#pragma unroll
                for (int mt = 0; mt < 2; ++mt) {
                    f32x16 cc;
#pragma unroll
                    for (int r = 0; r < 16; ++r) cc[r] = 0.f;
#pragma unroll
                    for (int ks = 0; ks < 4; ++ks) cc = __builtin_amdgcn_mfma_f32_32x32x16_f16(qalds[(mt * 4 + ks) * 64 + lane], bf[rr][ks], cc, 0, 0, 0);
                    float sv[2]; bool ps[2];
                    const f32x2 thp = *(const f32x2*)(thrs + mt * 4 + 2 * half);
#pragma unroll
                    for (int e = 0; e < 2; ++e) {
                        float s = 0.f;
#pragma unroll
                        for (int h = 0; h < 8; ++h) s += (float)wq[mt][e][h] * fmaxf(cc[e * 8 + h], 0.f);
                        sv[e] = s; ps[e] = kvalid && (s > thp[e]);
                    }
                    const u64 bm0 = __ballot(ps[0]), bm1 = __ballot(ps[1]);
                    if (bm0 | bm1) {
                        const int ql = lane - mt * 4;
                        unsigned myc = 0u;
                        myc = (ql == 0) ? (unsigned)__popc((unsigned)bm0) : myc;
                        myc = (ql == 1) ? (unsigned)__popc((unsigned)bm1) : myc;
                        myc = (ql == 2) ? (unsigned)__popc((unsigned)(bm0 >> 32)) : myc;
                        myc = (ql == 3) ? (unsigned)__popc((unsigned)(bm1 >> 32)) : myc;
                        unsigned basev = 0u;
                        if ((unsigned)ql < 4u && myc) basev = atomicAdd(cnt + lane, myc);
                        const unsigned b00 = __builtin_amdgcn_readlane(basev, mt * 4), b01 = __builtin_amdgcn_readlane(basev, mt * 4 + 1);
                        const unsigned b10 = __builtin_amdgcn_readlane(basev, mt * 4 + 2), b11 = __builtin_amdgcn_readlane(basev, mt * 4 + 3);
                        const unsigned ltm = (1u << l31) - 1u;
                        if (ps[0]) { const unsigned hm = half ? (unsigned)(bm0 >> 32) : (unsigned)bm0; const unsigned pos = (half ? b10 : b00) + (unsigned)__popc(hm & ltm);
                            bufall[(size_t)(mt * 4 + 2 * half) * TK_C + pos] = ((u64)fkey(sv[0]) << 32) | (u64)(~(unsigned)key); }
                        if (ps[1]) { const unsigned hm = half ? (unsigned)(bm1 >> 32) : (unsigned)bm1; const unsigned pos = (half ? b11 : b01) + (unsigned)__popc(hm & ltm);
                            bufall[(size_t)(mt * 4 + 2 * half + 1) * TK_C + pos] = ((u64)fkey(sv[1]) << 32) | (u64)(~(unsigned)key); }
                    }
                }
            }
        }
        __syncthreads();
        bool need = false;
#pragma unroll
        for (int q = 0; q < 8; ++q) need = need || (cnt[q] > (unsigned)TK_TRIG);
        __syncthreads();
        if (need && (rd) + 1 < rounds) {
            TBEG(2)
            const int n = (int)cnt[wave];
            if (n > 256) { float t; const int nn = tk_compact(bufall + (size_t)wave * TK_C, hist, n, lane, t); if (lane == 0) { cnt[wave] = (unsigned)nn; thrs[wave] = t; } }
            __builtin_amdgcn_sched_barrier(0);
            LOADQ(); LOADB(bn, rd + 1);
            __syncthreads();
            TEND(2)
        }
        if (rd + 1 < rounds) {
        LOADB(bf, rd + 2);
#pragma unroll
        for (int rr = 0; rr < 2; ++rr) {
            const int kt = (rd + 1) * 16 + rr * 8 + wave;
            if (kt < nkt) {
                const int key = kt * 32 + l31; const bool kvalid = key < U.nk;
#pragma unroll
                for (int mt = 0; mt < 2; ++mt) {
                    f32x16 cc;
#pragma unroll
                    for (int r = 0; r < 16; ++r) cc[r] = 0.f;
#pragma unroll
                    for (int ks = 0; ks < 4; ++ks) cc = __builtin_amdgcn_mfma_f32_32x32x16_f16(qalds[(mt * 4 + ks) * 64 + lane], bn[rr][ks], cc, 0, 0, 0);
                    float sv[2]; bool ps[2];
                    const f32x2 thp = *(const f32x2*)(thrs + mt * 4 + 2 * half);
#pragma unroll
                    for (int e = 0; e < 2; ++e) {
                        float s = 0.f;
#pragma unroll
                        for (int h = 0; h < 8; ++h) s += (float)wq[mt][e][h] * fmaxf(cc[e * 8 + h], 0.f);
                        sv[e] = s; ps[e] = kvalid && (s > thp[e]);
                    }
                    const u64 bm0 = __ballot(ps[0]), bm1 = __ballot(ps[1]);
                    if (bm0 | bm1) {
                        const int ql = lane - mt * 4;
                        unsigned myc = 0u;
                        myc = (ql == 0) ? (unsigned)__popc((unsigned)bm0) : myc;
                        myc = (ql == 1) ? (unsigned)__popc((unsigned)bm1) : myc;
                        myc = (ql == 2) ? (unsigned)__popc((unsigned)(bm0 >> 32)) : myc;
                        myc = (ql == 3) ? (unsigned)__popc((unsigned)(bm1 >> 32)) : myc;
                        unsigned basev = 0u;
                        if ((unsigned)ql < 4u && myc) basev = atomicAdd(cnt + lane, myc);
                        const unsigned b00 = __builtin_amdgcn_readlane(basev, mt * 4), b01 = __builtin_amdgcn_readlane(basev, mt * 4 + 1);
                        const unsigned b10 = __builtin_amdgcn_readlane(basev, mt * 4 + 2), b11 = __builtin_amdgcn_readlane(basev, mt * 4 + 3);
                        const unsigned ltm = (1u << l31) - 1u;
                        if (ps[0]) { const unsigned hm = half ? (unsigned)(bm0 >> 32) : (unsigned)bm0; const unsigned pos = (half ? b10 : b00) + (unsigned)__popc(hm & ltm);
                            bufall[(size_t)(mt * 4 + 2 * half) * TK_C + pos] = ((u64)fkey(sv[0]) << 32) | (u64)(~(unsigned)key); }
                        if (ps[1]) { const unsigned hm = half ? (unsigned)(bm1 >> 32) : (unsigned)bm1; const unsigned pos = (half ? b11 : b01) + (unsigned)__popc(hm & ltm);
                            bufall[(size_t)(mt * 4 + 2 * half + 1) * TK_C + pos] = ((u64)fkey(sv[1]) << 32) | (u64)(~(unsigned)key); }
                    }
                }
            }
        }
        __syncthreads();
        bool need = false;
#pragma unroll
        for (int q = 0; q < 8; ++q) need = need || (cnt[q] > (unsigned)TK_TRIG);
        __syncthreads();
        if (need && (rd + 1) + 1 < rounds) {
            TBEG(2)
            const int n = (int)cnt[wave];
            if (n > 256) { float t; const int nn = tk_compact(bufall + (size_t)wave * TK_C, hist, n, lane, t); if (lane == 0) { cnt[wave] = (unsigned)nn; thrs[wave] = t; } }
            __builtin_amdgcn_sched_barrier(0);
            LOADQ(); LOADB(bf, rd + 2);
            __syncthreads();
            TEND(2)
        }
        }
    }
#undef LOADB
#undef LOADQ
    TEND(1)
    }
    u64* buf = bufall + (size_t)wave * TK_C;
    TBEG(3)
    int n = (int)cnt[wave];
    if (n > 256) { float t; n = tk_compact(buf, hist, n, lane, t); }
    TEND(3)
    const int qrow = U.qrow0 + wave;
    int lane_o = lane; asm volatile("" : "+v"(lane_o));
    for (int repa_ = 0; repa_ < REP_ATT; ++repa_) {
    TBEG(4)
    float* P = (float*)((unsigned char*)buf + 4096);
    {
        const int fr = lane_o & 15, fq = lane_o >> 4;
        h16x8 qf[2];
#pragma unroll
        for (int ks = 0; ks < 2; ++ks) {
            if (fr < 8) qf[ks] = *(const h16x8*)(PROJ + (size_t)qrow * NPJ + C_Q + fr * 64 + ks * 32 + fq * 8);
            else {
#pragma unroll
                for (int j = 0; j < 8; ++j) qf[ks][j] = (h16)0.f; }
        }
        h16x8 zero8;
#pragma unroll
        for (int j = 0; j < 8; ++j) zero8[j] = (h16)0.f;
        u32x4 ka[8], kb[8];
#define ISSUEK4(dst, g) do { _Pragma("unroll") for (int tt = 0; tt < 2; ++tt) { const int s_ = ((g) * 2 + tt) * 16 + fr; const unsigned idx_ = (s_ < n) ? ~(unsigned)buf[s_] : 0u; \
        const unsigned char* kr_ = U.kvb + (size_t)(U.krow0 + (int)idx_) * 512 + fq * 16; \
        _Pragma("unroll") for (int j = 0; j < 4; ++j) dst[tt * 4 + j] = *(const u32x4*)(kr_ + j * 64); } } while (0)
#define COMPK4(src, g) do { _Pragma("unroll") for (int tt = 0; tt < 2; ++tt) { f32x4 c_ = (f32x4){0.f, 0.f, 0.f, 0.f}; \
        _Pragma("unroll") for (int j = 0; j < 4; ++j) { const u32x4 w_ = src[tt * 4 + j]; \
            const h16x8 a0_ = ((fr >> 1) == j) ? qf[0] : zero8, a1_ = ((fr >> 1) == j) ? qf[1] : zero8; \
            c_ = __builtin_amdgcn_mfma_f32_16x16x32_f16(a0_, fp8x8_to_h16((u64)w_.x | ((u64)w_.y << 32)), c_, 0, 0, 0); \
            c_ = __builtin_amdgcn_mfma_f32_16x16x32_f16(a1_, fp8x8_to_h16((u64)w_.z | ((u64)w_.w << 32)), c_, 0, 0, 0); } \
        const int s_ = ((g) * 2 + tt) * 16 + fr; const bool v_ = s_ < n; \
        _Pragma("unroll") for (int r = 0; r < 4; ++r) c_[r] = v_ ? c_[r] * 0.125f : -1e30f; \
        if (fq < 2) *(f32x4*)(P + s_ * 8 + fq * 4) = c_; } } while (0)
        ISSUEK4(ka, 0);
#pragma unroll 1
        for (int g = 0; g < 8; g += 2) {
            ISSUEK4(kb, g + 1);
            COMPK4(ka, g);
            ISSUEK4(ka, g + 2);
            COMPK4(kb, g + 1);
        }
#undef ISSUEK4
#undef COMPK4
        __builtin_amdgcn_s_waitcnt(0); asm volatile("" ::: "memory");
        f32x4 acc[16];
#pragma unroll
        for (int t = 0; t < 16; ++t) acc[t] = *(const f32x4*)(P + (t * 16 + fr) * 8 + (fq & 1) * 4);
        float mx[4] = {-1e30f, -1e30f, -1e30f, -1e30f};
#pragma unroll
        for (int t = 0; t < 16; ++t) { const bool v = (t * 16 + fr) < n;
#pragma unroll
            for (int r = 0; r < 4; ++r) { mx[r] = fmaxf(mx[r], acc[t][r]); } }
#pragma unroll
        for (int r = 0; r < 4; ++r) {
#pragma unroll
            for (int o = 1; o < 16; o <<= 1) mx[r] = fmaxf(mx[r], __shfl_xor(mx[r], o)); }
        float sm[4] = {0.f, 0.f, 0.f, 0.f};
#pragma unroll
        for (int t = 0; t < 16; ++t) { const bool v = (t * 16 + fr) < n;
#pragma unroll
            for (int r = 0; r < 4; ++r) { const float e = v ? __expf(acc[t][r] - mx[r]) : 0.f; acc[t][r] = e; sm[r] += e; } }
#pragma unroll
        for (int r = 0; r < 4; ++r) {
#pragma unroll
            for (int o = 1; o < 16; o <<= 1) sm[r] += __shfl_xor(sm[r], o); }
        __builtin_amdgcn_s_waitcnt(0); asm volatile("" ::: "memory");
        if (fq < 2) {
#pragma unroll
            for (int t = 0; t < 16; ++t) *(f32x4*)(P + (t * 16 + fr) * 8 + fq * 4) = acc[t];
            if (fr == 0) {
#pragma unroll
                for (int r = 0; r < 4; ++r) sums[fq * 4 + r] = sm[r]; }
        }
        __builtin_amdgcn_s_waitcnt(0); asm volatile("" ::: "memory");
    }
    TEND(4)
    TBEG(5)
    {
        const int sg = lane_o >> 4, part = lane_o & 15, kv = part >> 2, d0 = (part & 3) * 16;
        float o0[16], o1[16];
#pragma unroll
        for (int j = 0; j < 16; ++j) { o0[j] = 0.f; o1[j] = 0.f; }
        u32x4 va[8], vb[8];
        const unsigned char* vbase = U.kvb + 256 + kv * 64 + d0;
#define ISSUEV16(dst, gi) do { _Pragma("unroll") for (int ii = 0; ii < 8; ++ii) { const int s_ = 4 * ((gi) * 8 + ii) + sg; const unsigned idx_ = (s_ < n) ? ~(unsigned)buf[s_] : 0u; \
        dst[ii] = *(const u32x4*)(vbase + (size_t)(U.krow0 + (int)idx_) * 512); } } while (0)
#define COMPV16(src, gi) do { _Pragma("unroll") for (int ii = 0; ii < 8; ++ii) { const int s_ = 4 * ((gi) * 8 + ii) + sg; const f32x2 pp = *(const f32x2*)(P + (s_ & 255) * 8 + 2 * kv); const u32x4 w_ = src[ii]; \
        _Pragma("unroll") for (int q_ = 0; q_ < 4; ++q_) { const int ww_ = (int)w_[q_]; \
            const f32x2 xa_ = __builtin_amdgcn_cvt_pk_f32_fp8(ww_, false), xb_ = __builtin_amdgcn_cvt_pk_f32_fp8(ww_, true); \
            o0[q_ * 4 + 0] += pp.x * xa_.x; o0[q_ * 4 + 1] += pp.x * xa_.y; o0[q_ * 4 + 2] += pp.x * xb_.x; o0[q_ * 4 + 3] += pp.x * xb_.y; \
            o1[q_ * 4 + 0] += pp.y * xa_.x; o1[q_ * 4 + 1] += pp.y * xa_.y; o1[q_ * 4 + 2] += pp.y * xb_.x; o1[q_ * 4 + 3] += pp.y * xb_.y; } } } while (0)
        ISSUEV16(va, 0);
#pragma unroll 1
        for (int gi = 0; gi < 8; gi += 2) {
            ISSUEV16(vb, gi + 1);
            COMPV16(va, gi);
            ISSUEV16(va, gi + 2);
            COMPV16(vb, gi + 1);
        }
#undef ISSUEV16
#undef COMPV16
#pragma unroll
        for (int j = 0; j < 16; ++j) { o0[j] += __shfl_xor(o0[j], 16); o0[j] += __shfl_xor(o0[j], 32); o1[j] += __shfl_xor(o1[j], 16); o1[j] += __shfl_xor(o1[j], 32); }
        if (sg == 0) {
            const float i0 = 1.f / sums[2 * kv], i1 = 1.f / sums[2 * kv + 1];
            const h16* pz = PROJ + (size_t)qrow * NPJ + C_ZB + (2 * kv) * 64 + d0;
            h16* po = (h16*)(p.ws + WS_BOUT) + (size_t)qrow * 512 + (2 * kv) * 64 + d0;
#pragma unroll
            for (int hh = 0; hh < 2; ++hh) {
                const h16x8 za = *(const h16x8*)(pz + hh * 64), zb = *(const h16x8*)(pz + hh * 64 + 8);
                h16x8 ra, rb;
#pragma unroll
                for (int j = 0; j < 8; ++j) { const float oa = hh ? o1[j] : o0[j], ob = hh ? o1[8 + j] : o0[8 + j]; const float ii = hh ? i1 : i0;
                    ra[j] = (h16)(oa * ii * siluf_((float)za[j])); rb[j] = (h16)(ob * ii * siluf_((float)zb[j])); }
                *(h16x8*)(po + hh * 64) = ra; *(h16x8*)(po + hh * 64 + 8) = rb;
            }
        }
    }
    TEND(5)
    }
    __syncthreads();
}

__global__ void __launch_bounds__(512, 2) mk_fwd(Params p) {
    __builtin_assume(__builtin_amdgcn_workitem_id_y() == 0); __builtin_assume(__builtin_amdgcn_workitem_id_z() == 0);
    extern __shared__ __attribute__((aligned(16))) unsigned char lds[];
    cg::grid_group grid = cg::this_grid();
    const int wave = __builtin_amdgcn_readfirstlane((int)threadIdx.x >> 6);
    const int G = gridDim.x, bx = blockIdx.x;
    const int gw = bx * 8 + wave, NGW = G * 8;
    const int lo = p.ph_lo, hi = p.ph_hi;
    unsigned long long tacc = 0;
#define IN(k) (lo <= (k) && (k) < hi)
#define SEAM(k) do { if (IN(k) && IN((k) + 1)) grid.sync(); } while (0)
    h16* XH = (h16*)(p.ws + WS_XH); h16* PROJ = (h16*)(p.ws + WS_PROJ);
    h16* WIN = (h16*)(p.ws + WS_WIN); h16* WPA = (h16*)(p.ws + WS_WPA); h16* WPB = (h16*)(p.ws + WS_WPB); h16* WOUT = (h16*)(p.ws + WS_WOUT);
    h16* WSM = (h16*)(p.ws + WS_WSM); h16* KVS = (h16*)(p.ws + WS_KVS); h16* KIS = (h16*)(p.ws + WS_KIS);
    float* RSTD = (float*)(p.ws + WS_RSTD); float* ROWSS = (float*)(p.ws + WS_ROWSS);

    if (IN(0)) for (int rep_ = 0; rep_ < REP_P0; ++rep_) {
        const int lane = lane_id(), tid = wave * 64 + lane;
        float* scr = (float*)(lds + wave * 16384);
        constexpr int I_IN = 16 * (NPJ / 32), I_PA = 8 * 32, I_PB = 8 * 32, I_OUT = 16 * 32;
        for (int it = gw; it < I_IN + I_PA + I_PB + I_OUT; it += NGW) {
            int r = it;
            if (r < I_IN) { p0_tr_item(p.w_in, 1024, INW, WIN, p.norm_g, 1, scr, r, NPJ / 32, lane); continue; } r -= I_IN;
            if (r < I_PA) { p0_tr_item(p.w_pa, 512, 1024, WPA, nullptr, 0, scr, r, 32, lane); continue; } r -= I_PA;
            if (r < I_PB) { p0_tr_item(p.w_pb, 512, 1024, WPB, nullptr, 0, scr, r, 32, lane); continue; } r -= I_PB;
            p0_tr_item(p.w_out, 1024, 1024, WOUT, nullptr, 0, scr, r, 32, lane);
        }
        for (int m = gw; m < MT; m += NGW) {
            u64* o8 = (u64*)(XH + (size_t)m * DM) + lane;
            if (m < MROWS) {
                const float* xr = (m < MP) ? p.xp + (size_t)m * DM : p.xs + (size_t)(m - MP) * DM;
                const f32x4* x4 = (const f32x4*)xr + lane;
                f32x4 v[4]; float s = 0.f;
#pragma unroll
                for (int j = 0; j < 4; ++j) { v[j] = x4[64 * j]; s += (v[j].x * v[j].x + v[j].y * v[j].y) + (v[j].z * v[j].z + v[j].w * v[j].w); }
                s = wave_sum(s);
                if (lane == 0) RSTD[m] = rsqrtf(s * (1.f / 1024.f) + 1e-6f);
#pragma unroll
                for (int j = 0; j < 4; ++j) { h16x4 h; h[0] = (h16)v[j].x; h[1] = (h16)v[j].y; h[2] = (h16)v[j].z; h[3] = (h16)v[j].w; o8[64 * j] = __builtin_bit_cast(u64, h); }
            } else {
                if (lane == 0) RSTD[m] = 0.f;
#pragma unroll
                for (int j = 0; j < 4; ++j) o8[64 * j] = 0ull;
            }
        }
        const int gt = bx * 512 + tid, NGT = G * 512;
        for (int i = gt; i < NB * NKSP * 64; i += NGT) {
            const int c8 = (i & 63) * 8, r = (i >> 6) % NKSP, b = (i >> 6) / NKSP;
            if (r >= PAST && r < NKS) continue;
            f32x4 f0 = (f32x4){0.f, 0.f, 0.f, 0.f}, f1 = f0;
            if (r < PAST) { const float* src = (c8 < 256) ? p.ck + ((size_t)b * PAST + r) * 256 + c8 : p.cv + ((size_t)b * PAST + r) * 256 + (c8 - 256);
                f0 = *(const f32x4*)src; f1 = *(const f32x4*)(src + 4); }
            *(u64*)((unsigned char*)KVS + ((size_t)b * NKSP + r) * 512 + kvpos(c8)) = pack8_fp8(f0, f1);
        }
        for (int i = gt; i < NB * NKSP * 8; i += NGT) {
            const int c8 = (i & 7) * 8, r = (i >> 3) % NKSP, b = (i >> 3) / NKSP;
            if (r >= PAST && r < NKS) continue;
            h16x8 h;
            if (r < PAST) { const float* src = p.cki + ((size_t)b * PAST + r) * 64 + c8;
#pragma unroll
                for (int j = 0; j < 8; ++j) h[j] = (h16)src[j]; }
            else {
#pragma unroll
                for (int j = 0; j < 8; ++j) h[j] = (h16)0.f; }
            *(h16x8*)(KIS + ((size_t)b * NKSP + r) * 64 + c8) = h;
        }
        for (int i = gt; i < 8 * 128 * 128; i += NGT) { const int j = i & 127, ii = (i >> 7) & 127; WSM[i] = ((j >> 6) <= (ii >> 6)) ? (h16)p.sgu_w[i] : (h16)0.f; }
    }
    SEAM(0);
    if (IN(1)) for (int rep_ = 0; rep_ < REP_P1; ++rep_) {
        pg8::Gemm g{XH, WIN, MT, NPJ, 1024, 1024}; pg8::StaticOrder S; S.init(MT, NPJ, G, bx);
        EpiProj E{PROJ, RSTD, p.out, (unsigned char*)KVS, KIS, (unsigned char*)(p.ws + WS_KVC), (h16*)(p.ws + WS_KIC)};
        pg8::gemm_phase<EpiProj>((LAS unsigned char*)lds, g, S, E);
    }
    SEAM(1);
    if (IN(2)) for (int rep_ = 0; rep_ < REP_P2; ++rep_) {
        for (int u = bx; u < 512 + NB; u += G) { const int lane = lane_id(); if (u < 512) sgu_chunk(p, lds, u, wave, lane); else sgu_sample(p, lds, u - 512, wave, lane); }
    }
    if (IN(3)) for (int rep_ = 0; rep_ < REP_P3; ++rep_) {
        for (int u = bx; u < 8192 + 16; u += G) {
            AUnit U;
            if (u < 8192) { const int i = u >> 8, gp = u & 255, b = gp & 7, s = gp >> 3; const int jt = s + 32 * i;
                U.qrow0 = b * SEQ + jt * 8; U.krow0 = b * SEQ; U.nk = ((jt * 8) / 64 + 1) * 64; U.kib = (const h16*)(p.ws + WS_KIC); U.kis = 64; U.kvb = (const unsigned char*)(p.ws + WS_KVC); U.kvs = 512; }
            else { const int v = u - 8192, b = v >> 1, hf = v & 1;
                U.qrow0 = MP + b * 16 + hf * 8; U.krow0 = b * NKSP; U.nk = NKS; U.kib = KIS; U.kis = 64; U.kvb = (const unsigned char*)KVS; U.kvs = 512; }
            attn_unit(p, lds, U, wave, lane_id(), tacc);
        }
    }
    SEAM(3);
    if (IN(4)) for (int rep_ = 0; rep_ < REP_P4; ++rep_) {
        { pg8::Gemm g{(const h16*)(p.ws + WS_AOUT), WPA, MT, 1024, 512, 512}; pg8::StaticOrder S; S.init(MT, 1024, G, bx); EpiGate<1> E{PROJ}; pg8::gemm_phase<EpiGate<1>>((LAS unsigned char*)lds, g, S, E); }
        { pg8::Gemm g{(const h16*)(p.ws + WS_BOUT), WPB, MT, 1024, 512, 512}; pg8::StaticOrder S; S.init(MT, 1024, G, bx); EpiGate<0> E{PROJ}; pg8::gemm_phase<EpiGate<0>>((LAS unsigned char*)lds, g, S, E); }
    }
    SEAM(4);
    if (IN(5)) for (int rep_ = 0; rep_ < REP_P5; ++rep_) {
        pg8::Gemm g{PROJ + C_M, WOUT, MT, 1024, 1024, NPJ}; pg8::StaticOrder S; S.init(MT, 1024, G, bx);
        EpiOut E{p.xp, p.xs, p.out, ROWSS};
        pg8::gemm_phase<EpiOut>((LAS unsigned char*)lds, g, S, E);
    }
    SEAM(5);
    if (IN(6)) {
        const int lane = lane_id();
        for (int m = gw; m < MROWS; m += NGW) {
            float* yr = (m < MP) ? p.out + O_YP + (size_t)m * DM : p.out + O_YS + (size_t)(m - MP) * DM;
            float ssum = (lane < 16) ? ROWSS[(size_t)m * 16 + lane] : 0.f; ssum = wave_sum(ssum);
            const float r = rsqrtf(ssum * (1.f / 1024.f) + 1e-6f);
            const int lane6 = lane;
            f32x4* y4 = (f32x4*)yr + lane6; const f32x4* g4 = (const f32x4*)p.final_g + lane6;
#pragma unroll
            for (int j = 0; j < 4; ++j) { f32x4 v = y4[64 * j]; const f32x4 gg = g4[64 * j]; v = v * r * gg; y4[64 * j] = v; }
        }
    }
    if (TSEL != 0 && bx == 0 && threadIdx.x == 0) { const unsigned long long t0 = rt_(); while (rt_() - t0 < tacc) __builtin_amdgcn_s_sleep(8); }
#undef IN
#undef SEAM
}

extern "C" void kernel_launch(void* const* d_in, const int* in_sizes, int n_in, void* d_out, int out_size, void* d_ws, size_t ws_size, hipStream_t stream) {
    static int grid_blocks = 0;
    if (grid_blocks == 0) {
        if (ws_size < WS_END) { fprintf(stderr, "kernel_launch: workspace too small: %zu < %zu\n", ws_size, (size_t)WS_END); grid_blocks = -1; return; }
        int dev = 0, cus = 0, per_cu = 0;
        hipGetDevice(&dev);
        hipDeviceGetAttribute(&cus, hipDeviceAttributeMultiprocessorCount, dev);
        hipFuncSetAttribute((const void*)mk_fwd, hipFuncAttributeMaxDynamicSharedMemorySize, LDS_BYTES);
        hipOccupancyMaxActiveBlocksPerMultiprocessor(&per_cu, (const void*)mk_fwd, 512, LDS_BYTES);
        if (per_cu < 1) { fprintf(stderr, "kernel_launch: occupancy query says %d blocks per CU\n", per_cu); per_cu = 1; }
        grid_blocks = cus * per_cu;
        (void)hipGetLastError();
    }
    if (grid_blocks < 0) return;
    Params p{};
    p.xp = (const float*)d_in[0]; p.xs = (const float*)d_in[1]; p.ck = (const float*)d_in[2]; p.cv = (const float*)d_in[3]; p.cki = (const float*)d_in[4];
    p.norm_g = (const float*)d_in[5]; p.w_in = (const float*)d_in[6]; p.ln_g = (const float*)d_in[7]; p.ln_b = (const float*)d_in[8];
    p.sgu_w = (const float*)d_in[9]; p.sgu_b = (const float*)d_in[10]; p.w_pa = (const float*)d_in[11]; p.w_pb = (const float*)d_in[12];
    p.w_out = (const float*)d_in[13]; p.final_g = (const float*)d_in[14];
    p.out = (float*)d_out; p.ws = (unsigned char*)d_ws; p.ph_lo = 0; p.ph_hi = 7;
    void* args[] = {&p};
    hipError_t e = hipLaunchCooperativeKernel((const void*)mk_fwd, dim3(grid_blocks), dim3(512), args, LDS_BYTES, stream);
    if (e != hipSuccess) fprintf(stderr, "cooperative launch failed: %s (grid %d)\n", hipGetErrorString(e), grid_blocks);
}
```

```cpp
#include <hip/hip_runtime.h>
#include <hip/hip_cooperative_groups.h>
#include <cstdio>
#include <cstdint>
namespace cg = cooperative_groups;
#define REP_P0 1
#define REP_P1 1
#define REP_P2 1
#define REP_P3 1
#define REP_IDX 1
#define REP_ATT 1
#define TSEL 0
#define LDS_BARRIER() do { asm volatile("s_waitcnt lgkmcnt(0)" ::: "memory"); __builtin_amdgcn_s_barrier(); asm volatile("" ::: "memory"); } while (0)
__device__ __forceinline__ unsigned long long rt_() { return __builtin_amdgcn_s_memrealtime(); }
#define TBEG(k) unsigned long long tb_##k = 0; if (TSEL == (k)) tb_##k = rt_();
#define TEND(k) if (TSEL == (k)) tacc += rt_() - tb_##k;
#define REP_P4 1
#define REP_P5 1

#define LAS __attribute__((address_space(3)))
typedef _Float16 h16;
typedef _Float16 h16x8 __attribute__((ext_vector_type(8)));
typedef _Float16 h16x4 __attribute__((ext_vector_type(4)));
typedef _Float16 h16x2 __attribute__((ext_vector_type(2)));
typedef float f32x2 __attribute__((ext_vector_type(2)));
typedef float f32x4 __attribute__((ext_vector_type(4)));
typedef float f32x16 __attribute__((ext_vector_type(16)));
typedef unsigned u32x4 __attribute__((ext_vector_type(4)));
typedef unsigned u32x2 __attribute__((ext_vector_type(2)));
typedef unsigned long long u64;

constexpr int DM = 1024, SEQ = 8192, NB = 8, MP = NB * SEQ;
constexpr int DSQ = 16, MS = NB * DSQ, PAST = 1024, NKS = PAST + DSQ, NKSP = 1056;
constexpr int MROWS = MP + MS;
constexpr int MT = MP + 256;
constexpr int INW = 5704, NPJ = 5888;
constexpr int C_U = 0, C_V = 512, C_ZA = 1024, C_Q = 1536, C_K = 2048, C_VV = 2304, C_ZB = 2560, C_QI = 3072, C_KI = 3584, C_WI = 3648, C_GA = 3840, C_GB = 4864;
constexpr size_t O_YP = 0, O_YS = 67108864, O_PK = 67239936, O_PV = 84017152, O_PKI = 100794368, O_SK = 104988672, O_SV = 105021440, O_SKI = 105054208, O_SSV = 105062400;
constexpr size_t WS_XH = 0;
constexpr size_t WS_PROJ = WS_XH + (size_t)MT * DM * 2;
constexpr size_t WS_WIN = WS_PROJ + (size_t)MT * NPJ * 2;
constexpr size_t WS_WPA = WS_WIN + (size_t)NPJ * DM * 2;
constexpr size_t WS_WPB = WS_WPA + (size_t)1024 * 512 * 2;
constexpr size_t WS_WOUT = WS_WPB + (size_t)1024 * 512 * 2;
constexpr size_t WS_WSM = WS_WOUT + (size_t)1024 * 1024 * 2;
constexpr size_t WS_KVS = WS_WSM + (size_t)8 * 128 * 128 * 2;
constexpr size_t WS_KIS = WS_KVS + (size_t)NB * NKSP * 512 * 2;
constexpr size_t WS_RSTD = WS_KIS + (size_t)NB * NKSP * 64 * 2;
constexpr size_t WS_ROWSS = WS_RSTD + (size_t)MT * 4;
constexpr size_t WS_KIC = WS_ROWSS + (size_t)MT * 16 * 4;
constexpr size_t WS_KVC = WS_KIC + (size_t)MP * 64 * 2;
constexpr size_t WS_END = WS_KVC + (size_t)MP * 512 * 2;
constexpr size_t WS_AOUT = WS_XH, WS_BOUT = WS_XH + (size_t)MT * 512 * 2;
constexpr int C_T = 0, C_M = 1024;
constexpr int LDS_BYTES = 155648;

__device__ __forceinline__ float sigmoidf_(float x) { return 1.f / (1.f + __expf(-x)); }
__device__ __forceinline__ float siluf_(float x) { return x / (1.f + __expf(-x)); }
__device__ __forceinline__ float geluf_(float x) { const float t = 1.5957691216057308f * (x + 0.044715f * x * x * x); return x / (1.f + __expf(-t)); }
__device__ __forceinline__ int lane_id() { int l; asm volatile("v_mbcnt_lo_u32_b32 %0, -1, 0\n\tv_mbcnt_hi_u32_b32 %0, -1, %0" : "=v"(l)); return l; }
__device__ __forceinline__ float wave_sum(float v) {
#pragma unroll
    for (int o = 1; o < 64; o <<= 1) v += __shfl_xor(v, o);
    return v;
}

namespace pg8 {
constexpr int BM = 256, BK = 64, HALF = 128, HTB = HALF * BK * 2, STAGE_BYTES = 8 * HTB, NXCD = 8, WGM = 8;
__host__ __device__ __forceinline__ int lds_byte(int r, int c) { const int st = (r >> 4) * 2 + (c >> 5), rr = r & 15, cc = c & 31, ob = rr * 64 + cc * 2; return st * 1024 + (ob ^ (((ob >> 9) & 1) << 5)); }
__host__ __device__ __forceinline__ void stage_rc(int b, int& R, int& C) { const int st = b / 1024, sb = b % 1024, swz = sb ^ (((sb >> 9) & 1) << 5); R = (st >> 1) * 16 + swz / 64; C = (st & 1) * 32 + (swz % 64) / 2; }
__host__ __device__ __forceinline__ int perm32(int rho) { const int n = rho >> 4, i = rho & 15; return 8 * (i >> 2) + 4 * n + (i & 3); }
struct Unit { int pm, pn; };
struct Gemm { const h16* A; const h16* Bt; int M, N, K, lda; };
struct StaticOrder {
    int nM, nN, nwg, G, c;
    __device__ void init(int M, int N, int G_, int c_) { nM = M / BM; nN = N / BM; nwg = nM * nN; G = G_; c = c_; }
    __device__ bool next(int i, Unit& u) const {
        const long L = (long)i * G + c; if (L >= nwg) return false;
        int wgid = (int)L; { const int q = nwg / NXCD, r = nwg % NXCD, xcd = wgid % NXCD, off = wgid / NXCD; wgid = (xcd < r ? xcd * (q + 1) : r * (q + 1) + (xcd - r) * q) + off; }
        const int nig = WGM * nN, gid = wgid / nig, fm = gid * WGM, gsz = (nM - fm) < WGM ? (nM - fm) : WGM;
        u.pm = fm + ((wgid % nig) % gsz); u.pn = (wgid % nig) / gsz; return true;
    }
};
template <class Epi>
__device__ __forceinline__ void gemm_phase(LAS unsigned char* lds, const Gemm g, const StaticOrder& S, const Epi& E) {
    const int tid = threadIdx.x, wid = __builtin_amdgcn_readfirstlane(tid >> 6), lane = tid & 63, wr = wid >> 2, wc = wid & 3, fr = lane & 15, fq = lane >> 4;
    const int K = g.K, nt = K / BK, lda = g.lda;
    unsigned voffA[2], voffB[2];
#pragma unroll
    for (int i = 0; i < 2; ++i) { int R, C; stage_rc(tid * 16 + i * 8192, R, C); const int Rb = (R & ~31) + perm32(R & 31);
        voffA[i] = (unsigned)(R * lda + C) * 2u; voffB[i] = (unsigned)(Rb * K + C) * 2u; }
    const size_t kstep = (size_t)(BK * 2);
    const size_t hstepA = (size_t)HALF * lda * 2, hstepB = (size_t)HALF * K * 2;
    const size_t tstepA = 2 * hstepA, tstepB = 2 * hstepB;
    const unsigned ldsw = (unsigned)wid * 1024u;
    const int aoff = lds_byte(wr * 64 + fr, fq * 8), boff = lds_byte(wc * 32 + fr, fq * 8);
#define PG8_SA(b, h) (((b) * 2 + (h)) * HTB)
#define PG8_SB(b, h) ((4 + (b) * 2 + (h)) * HTB)
#define PG8_STAGE(bufoff, gbase, voff) do { _Pragma("unroll") for (int _i = 0; _i < 2; ++_i) \
        __builtin_amdgcn_global_load_lds((const unsigned*)((const char*)(gbase) + (voff)[_i]), (LAS unsigned*)(lds + (bufoff) + ldsw + _i * 8192), 16, 0, 0); } while (0)
#define PG8_LDA(dst, b, h) do { _Pragma("unroll") for (int m = 0; m < 4; ++m) _Pragma("unroll") for (int k = 0; k < 2; ++k) dst[m][k] = *(const LAS h16x8*)(lds + PG8_SA(b, h) + aoff + m * 2048 + k * 1024); } while (0)
#define PG8_LDB(dst, b, h) do { _Pragma("unroll") for (int n = 0; n < 2; ++n) _Pragma("unroll") for (int k = 0; k < 2; ++k) dst[n][k] = *(const LAS h16x8*)(lds + PG8_SB(b, h) + boff + n * 2048 + k * 1024); } while (0)
#define PG8_MMA(ai, bj, At, Bt) do { __builtin_amdgcn_s_setprio(1); _Pragma("unroll") for (int m = 0; m < 4; ++m) _Pragma("unroll") for (int n = 0; n < 2; ++n) _Pragma("unroll") for (int k = 0; k < 2; ++k) \
        acc[ai][bj][m][n] = __builtin_amdgcn_mfma_f32_16x16x32_f16(Bt[n][k], At[m][k], acc[ai][bj][m][n], 0, 0, 0); __builtin_amdgcn_s_setprio(0); } while (0)
#define PG8_WAIT_V(n) asm volatile("s_waitcnt vmcnt(" #n ")" ::: "memory")
#define PG8_WAIT_L(n) asm volatile("s_waitcnt lgkmcnt(" #n ")" ::: "memory")
#define PG8_BAR __builtin_amdgcn_s_barrier()
#define PG8_SCHED __builtin_amdgcn_sched_barrier(0)
    Unit cur, nxt; int ui = 0;
    if (!S.next(0, cur)) return;
    f32x4 acc[2][2][4][2];
#pragma unroll
    for (int a = 0; a < 2; ++a)
#pragma unroll
        for (int b = 0; b < 2; ++b)
#pragma unroll
            for (int m = 0; m < 4; ++m)
#pragma unroll
                for (int n = 0; n < 2; ++n) acc[a][b][m][n] = (f32x4){0.f, 0.f, 0.f, 0.f};
    h16x8 At[4][2], B0[2][2], B1[2][2];
    const char* cA = (const char*)g.A + (size_t)cur.pm * tstepA; const char* cB = (const char*)g.Bt + (size_t)cur.pn * tstepB;
    PG8_STAGE(PG8_SB(0, 0), cB, voffB); PG8_STAGE(PG8_SB(0, 1), cB + hstepB, voffB); PG8_STAGE(PG8_SA(0, 0), cA, voffA); PG8_STAGE(PG8_SA(0, 1), cA + hstepA, voffA);
    if (wr == 1) PG8_BAR;
    PG8_WAIT_V(2); PG8_BAR;
    PG8_STAGE(PG8_SB(1, 0), cB + kstep, voffB); PG8_STAGE(PG8_SA(1, 0), cA + kstep, voffA); PG8_STAGE(PG8_SB(1, 1), cB + hstepB + kstep, voffB);
    PG8_WAIT_V(6); PG8_BAR;
    for (;;) {
        const bool has_next = S.next(ui + 1, nxt);
        const char* nA = has_next ? (const char*)g.A + (size_t)nxt.pm * tstepA : cA; const char* nB = has_next ? (const char*)g.Bt + (size_t)nxt.pn * tstepB : cB;
        for (int t = 0; t < nt; t += 2) {
            const bool last = (t == nt - 2);
            const char* a1 = cA + (size_t)(t + 1) * kstep;
            const char* a2 = last ? nA : cA + (size_t)(t + 2) * kstep; const char* b2 = last ? nB : cB + (size_t)(t + 2) * kstep;
            const char* a3 = a2 + kstep; const char* b3 = b2 + kstep;
            PG8_LDB(B0, 0, 0); PG8_LDB(B1, 0, 1); PG8_SCHED; PG8_LDA(At, 0, 0); PG8_STAGE(PG8_SA(1, 1), a1 + hstepA, voffA);
            PG8_WAIT_V(8); PG8_WAIT_L(0); PG8_BAR; PG8_MMA(0, 0, At, B0); PG8_MMA(0, 1, At, B1); PG8_BAR; PG8_SCHED;
            PG8_LDA(At, 0, 1); PG8_STAGE(PG8_SB(0, 0), b2, voffB); PG8_STAGE(PG8_SB(0, 1), b2 + hstepB, voffB); PG8_STAGE(PG8_SA(0, 0), a2, voffA);
            PG8_WAIT_V(8); PG8_WAIT_L(0); PG8_BAR; PG8_MMA(1, 0, At, B0); PG8_MMA(1, 1, At, B1); PG8_BAR; PG8_SCHED;
            PG8_LDB(B0, 1, 0); PG8_LDB(B1, 1, 1); PG8_SCHED; PG8_LDA(At, 1, 0); PG8_STAGE(PG8_SA(0, 1), a2 + hstepA, voffA);
            PG8_WAIT_V(8); PG8_WAIT_L(0); PG8_BAR; PG8_MMA(0, 0, At, B0); PG8_MMA(0, 1, At, B1); PG8_BAR; PG8_SCHED;
            PG8_LDA(At, 1, 1); PG8_STAGE(PG8_SB(1, 0), b3, voffB); PG8_STAGE(PG8_SB(1, 1), b3 + hstepB, voffB); PG8_STAGE(PG8_SA(1, 0), a3, voffA);
            PG8_WAIT_V(8); PG8_WAIT_L(0); PG8_BAR; PG8_MMA(1, 0, At, B0); PG8_MMA(1, 1, At, B1); PG8_BAR; PG8_SCHED;
        }
        if (wr == 0) PG8_BAR;
        E(acc, cur, wr, wc, fr, fq);
        if (!has_next) break;
#pragma unroll
        for (int a = 0; a < 2; ++a)
#pragma unroll
            for (int b = 0; b < 2; ++b)
#pragma unroll
                for (int m = 0; m < 4; ++m)
#pragma unroll
                    for (int n = 0; n < 2; ++n) acc[a][b][m][n] = (f32x4){0.f, 0.f, 0.f, 0.f};
        cur = nxt; cA = nA; cB = nB; ++ui;
        if (wr == 1) PG8_BAR;
    }
    PG8_WAIT_V(0);
    PG8_BAR;
#undef PG8_SA
#undef PG8_SB
#undef PG8_STAGE
#undef PG8_LDA
#undef PG8_LDB
#undef PG8_MMA
#undef PG8_WAIT_V
#undef PG8_WAIT_L
#undef PG8_BAR
#undef PG8_SCHED
}
}

__device__ __forceinline__ u64 pack8_fp8(const f32x4 a, const f32x4 b) {
    int w0 = __builtin_amdgcn_cvt_pk_fp8_f32(a[0], a[1], 0, false); w0 = __builtin_amdgcn_cvt_pk_fp8_f32(a[2], a[3], w0, true);
    int w1 = __builtin_amdgcn_cvt_pk_fp8_f32(b[0], b[1], 0, false); w1 = __builtin_amdgcn_cvt_pk_fp8_f32(b[2], b[3], w1, true);
    return (u64)(unsigned)w0 | ((u64)(unsigned)w1 << 32);
}
__device__ __forceinline__ h16x8 fp8x8_to_h16(const u64 v) {
    const int w0 = (int)(unsigned)v, w1 = (int)(unsigned)(v >> 32);
    const f32x2 a = __builtin_amdgcn_cvt_pk_f32_fp8(w0, false), b = __builtin_amdgcn_cvt_pk_f32_fp8(w0, true), c = __builtin_amdgcn_cvt_pk_f32_fp8(w1, false), d = __builtin_amdgcn_cvt_pk_f32_fp8(w1, true);
    h16x8 h; h[0] = (h16)a.x; h[1] = (h16)a.y; h[2] = (h16)b.x; h[3] = (h16)b.y; h[4] = (h16)c.x; h[5] = (h16)c.y; h[6] = (h16)d.x; h[7] = (h16)d.y;
    return h;
}
__device__ __forceinline__ int kvpos(int lc) { if (lc >= 256) return lc; const int j = lc >> 6, d = lc & 63; return j * 64 + ((d & 31) >> 3) * 16 + (d >> 5) * 8; }
__device__ __forceinline__ u32x4 pack8(const f32x4 a, const f32x4 b) {
    h16x8 h; h[0] = (h16)a[0]; h[1] = (h16)a[1]; h[2] = (h16)a[2]; h[3] = (h16)a[3]; h[4] = (h16)b[0]; h[5] = (h16)b[1]; h[6] = (h16)b[2]; h[7] = (h16)b[3];
    return __builtin_bit_cast(u32x4, h);
}

struct EpiProj {
    h16* PROJ; const float* rstd; float* dout; unsigned char* KVS; h16* KIS; unsigned char* KVC; h16* KIC;
    __device__ __forceinline__ void operator()(const f32x4 (&acc)[2][2][4][2], const pg8::Unit& u, int wr, int wc, int fr, int fq) const {
        const int row0 = u.pm * 256 + wr * 64 + fr, col0 = u.pn * 256 + wc * 32 + 8 * fq;
        const int pn = u.pn;
#pragma unroll
        for (int ai = 0; ai < 2; ++ai)
#pragma unroll
            for (int m = 0; m < 4; ++m) {
                const int row = row0 + ai * 128 + m * 16; const float rs = rstd[row];
#pragma unroll
                for (int bj = 0; bj < 2; ++bj) {
                    const int c = col0 + bj * 128;
                    const f32x4 v0 = acc[ai][bj][m][0] * rs, v1 = acc[ai][bj][m][1] * rs;
                    if (pn != 8 && pn != 9) *(u32x4*)(PROJ + (size_t)row * NPJ + c) = pack8(v0, v1);
                    if (pn == 8 || pn == 9 || (pn == 14 && c < C_KI + 64)) {
                        if (row < MP) {
                            float* o = (pn == 8) ? dout + O_PK + (size_t)row * 256 + (c - C_K) : (pn == 9) ? dout + O_PV + (size_t)row * 256 + (c - C_VV) : dout + O_PKI + (size_t)row * 64 + (c - C_KI);
                            *(f32x4*)o = v0; *(f32x4*)(o + 4) = v1;
                            if (pn == 14) *(u32x4*)(KIC + (size_t)row * 64 + (c - C_KI)) = pack8(v0, v1);
                            else *(u64*)(KVC + (size_t)row * 512 + kvpos(c - C_K)) = pack8_fp8(v0, v1);
                        } else if (row < MROWS) {
                            const int t = row - MP, b = t >> 4, s = t & 15; const size_t kr = (size_t)b * NKSP + PAST + s;
                            float* o = (pn == 8) ? dout + O_SK + (size_t)t * 256 + (c - C_K) : (pn == 9) ? dout + O_SV + (size_t)t * 256 + (c - C_VV) : dout + O_SKI + (size_t)t * 64 + (c - C_KI);
                            *(f32x4*)o = v0; *(f32x4*)(o + 4) = v1;
                            if (pn == 14) *(u32x4*)(KIS + kr * 64 + (c - C_KI)) = pack8(v0, v1);
                            else *(u64*)(KVS + kr * 512 + kvpos(c - C_K)) = pack8_fp8(v0, v1);
                        }
                    }
                }
            }
    }
};
template <int FIRST> struct EpiGate {
    h16* PROJ;
    __device__ __forceinline__ void operator()(const f32x4 (&acc)[2][2][4][2], const pg8::Unit& u, int wr, int wc, int fr, int fq) const {
        const int row0 = u.pm * 256 + wr * 64 + fr, col0 = u.pn * 256 + wc * 32 + 8 * fq;
#pragma unroll
        for (int ai = 0; ai < 2; ++ai)
#pragma unroll
            for (int m = 0; m < 4; ++m) {
                const int row = row0 + ai * 128 + m * 16;
#pragma unroll
                for (int bj = 0; bj < 2; ++bj) {
                    const int c = col0 + bj * 128;
                    h16* pm_ = PROJ + (size_t)row * NPJ + (FIRST ? C_T : C_M) + c;
                    const h16x8 gt = *(const h16x8*)(PROJ + (size_t)row * NPJ + (FIRST ? C_GA : C_GB) + c);
                    f32x4 v0, v1;
#pragma unroll
                    for (int j = 0; j < 4; ++j) { v0[j] = sigmoidf_((float)gt[j]) * acc[ai][bj][m][0][j]; v1[j] = sigmoidf_((float)gt[4 + j]) * acc[ai][bj][m][1][j]; }
                    if (!FIRST) { const h16x8 tp = *(const h16x8*)(PROJ + (size_t)row * NPJ + C_T + c);
#pragma unroll
                        for (int j = 0; j < 4; ++j) { v0[j] += (float)tp[j]; v1[j] += (float)tp[4 + j]; } }
                    *(u32x4*)pm_ = pack8(v0, v1);
                }
            }
    }
};
struct EpiOut {
    const float* xp; const float* xs; float* dout; float* rowss;
    __device__ __forceinline__ void operator()(const f32x4 (&acc)[2][2][4][2], const pg8::Unit& u, int wr, int wc, int fr, int fq) const {
        const int row0 = u.pm * 256 + wr * 64 + fr, col0 = u.pn * 256 + wc * 32 + 8 * fq;
#pragma unroll
        for (int ai = 0; ai < 2; ++ai)
#pragma unroll
            for (int m = 0; m < 4; ++m) {
                const int row = row0 + ai * 128 + m * 16;
                const bool ok = row < MROWS;
                const float* xr = (row < MP) ? xp + (size_t)row * DM : xs + (size_t)(row - MP) * DM;
                float* yr = (row < MP) ? dout + O_YP + (size_t)row * DM : dout + O_YS + (size_t)(row - MP) * DM;
                float ss = 0.f;
                if (ok) {
#pragma unroll
                    for (int bj = 0; bj < 2; ++bj) {
                        const int c = col0 + bj * 128;
                        const f32x4 x0 = *(const f32x4*)(xr + c), x1 = *(const f32x4*)(xr + c + 4);
                        const f32x4 v0 = x0 + acc[ai][bj][m][0], v1 = x1 + acc[ai][bj][m][1];
                        *(f32x4*)(yr + c) = v0; *(f32x4*)(yr + c + 4) = v1;
                        ss += v0[0] * v0[0] + v0[1] * v0[1] + v0[2] * v0[2] + v0[3] * v0[3] + v1[0] * v1[0] + v1[1] * v1[1] + v1[2] * v1[2] + v1[3] * v1[3];
                    }
                }
                ss += __shfl_xor(ss, 16); ss += __shfl_xor(ss, 32);
                if (ok && fq == 0) rowss[(size_t)row * 16 + u.pn * 4 + wc] = ss;
            }
    }
};

struct Params {
    const float *xp, *xs, *ck, *cv, *cki, *norm_g, *w_in, *ln_g, *ln_b, *sgu_w, *sgu_b, *w_pa, *w_pb, *w_out, *final_g;
    float* out; unsigned char* ws; int ph_lo, ph_hi;
};

__device__ __forceinline__ void p0_tr_item(const float* W, int K, int Nsrc, h16* WT, const float* gs, int mode, float* scr, int item, int nblk, int lane) {
    const int kb = item / nblk, nb = item % nblk, k0 = 64 * kb, n0 = 32 * nb;
    const int nn = n0 + (lane & 31);
    int src = nn; bool valid = true;
    if (mode == 1) { if (nn >= C_WI + 8 && nn < C_GA) valid = false; else if (nn >= C_GA) src = nn - (C_GA - (C_WI + 8)); }
#pragma unroll 8
    for (int i = 0; i < 32; ++i) { const int kk = 2 * i + (lane >> 5);
        float v = 0.f; if (valid) { v = W[(size_t)(k0 + kk) * Nsrc + src]; if (gs) v *= gs[k0 + kk]; }
        scr[kk * 33 + (lane & 31)] = v; }
    __builtin_amdgcn_s_waitcnt(0); asm volatile("" ::: "memory");
    const int c = lane & 7;
#pragma unroll
    for (int j = 0; j < 4; ++j) { const int n = (lane >> 3) + 8 * j; const float* s = scr + (8 * c) * 33 + n;
        h16x8 h;
#pragma unroll
        for (int q = 0; q < 8; ++q) h[q] = (h16)s[q * 33];
        *(h16x8*)(WT + (size_t)(n0 + n) * K + k0 + 8 * c) = h; }
    __builtin_amdgcn_s_waitcnt(0); asm volatile("" ::: "memory");
}

constexpr int VNT_LD = 136;
__device__ __forceinline__ void sgu_chunk(const Params& p, unsigned char* lds, int chunk, int wave, int lane) {
    h16* PROJ = (h16*)(p.ws + WS_PROJ);
    h16* vnT = (h16*)lds;
    h16* AOUT = (h16*)(p.ws + WS_AOUT);
    const h16* WSM = (const h16*)(p.ws + WS_WSM);
    {
        float lg[8], lb[8];
#pragma unroll
        for (int j = 0; j < 8; ++j) { lg[j] = p.ln_g[lane * 8 + j]; lb[j] = p.ln_b[lane * 8 + j]; }
        for (int tt = 0; tt < 16; ++tt) {
            const int tok = wave * 16 + tt; const size_t row = (size_t)chunk * 128 + tok;
            const h16x8 vv = *(const h16x8*)(PROJ + row * NPJ + C_V + lane * 8);
            float g[8]; float s = 0.f;
#pragma unroll
            for (int j = 0; j < 8; ++j) { g[j] = geluf_((float)vv[j]); s += g[j]; }
            const float mean = wave_sum(s) * (1.f / 512.f); float q = 0.f;
#pragma unroll
            for (int j = 0; j < 8; ++j) { g[j] -= mean; q += g[j] * g[j]; }
            const float rstd = rsqrtf(wave_sum(q) * (1.f / 512.f) + 1e-5f);
#pragma unroll
            for (int j = 0; j < 8; ++j) vnT[(lane * 8 + j) * VNT_LD + tok] = (h16)(g[j] * rstd * lg[j] + lb[j]);
        }
    }
    __syncthreads();
    {
        const int g = wave, fr = lane & 15, fq = lane >> 4;
        for (int it = 0; it < 8; ++it) {
            f32x4 acc[4];
#pragma unroll
            for (int dt = 0; dt < 4; ++dt) acc[dt] = (f32x4){0.f, 0.f, 0.f, 0.f};
            const int nks = (it < 4) ? 2 : 4;
            for (int ks = 0; ks < nks; ++ks) {
                const h16x8 b = *(const h16x8*)(WSM + ((size_t)g * 128 + it * 16 + fr) * 128 + ks * 32 + fq * 8);
#pragma unroll
                for (int dt = 0; dt < 4; ++dt) {
                    const h16x8 a = *(const h16x8*)(vnT + (g * 64 + dt * 16 + fr) * VNT_LD + ks * 32 + fq * 8);
                    acc[dt] = __builtin_amdgcn_mfma_f32_16x16x32_f16(a, b, acc[dt], 0, 0, 0);
                }
            }
            const int i = it * 16 + fr; const size_t row = (size_t)chunk * 128 + i;
            const float bias = p.sgu_b[g * 128 + i];
#pragma unroll
            for (int dt = 0; dt < 4; ++dt) {
                const int c = g * 64 + dt * 16 + fq * 4;
                const h16x4 uu = *(const h16x4*)(PROJ + row * NPJ + C_U + c); const h16x4 zz = *(const h16x4*)(PROJ + row * NPJ + C_ZA + c);
                h16x4 o;
#pragma unroll
                for (int r = 0; r < 4; ++r) o[r] = (h16)(geluf_((float)uu[r]) * (acc[dt][r] + bias) * siluf_((float)zz[r]));
                *(h16x4*)(AOUT + row * 512 + c) = o;
            }
        }
    }
    __syncthreads();
}
__device__ __forceinline__ void sgu_sample(const Params& p, unsigned char* lds, int b, int wave, int lane) {
    h16* PROJ = (h16*)(p.ws + WS_PROJ);
    float* vnS = (float*)lds;
    for (int tt = 0; tt < 2; ++tt) {
        const int t = wave * 2 + tt; const size_t row = (size_t)MP + b * 16 + t;
        const h16x8 vv = *(const h16x8*)(PROJ + row * NPJ + C_V + lane * 8);
        float g[8]; float s = 0.f;
#pragma unroll
        for (int j = 0; j < 8; ++j) { g[j] = geluf_((float)vv[j]); s += g[j]; }
        const float mean = wave_sum(s) * (1.f / 512.f); float q = 0.f;
#pragma unroll
        for (int j = 0; j < 8; ++j) { g[j] -= mean; q += g[j] * g[j]; }
        const float rstd = rsqrtf(wave_sum(q) * (1.f / 512.f) + 1e-5f);
#pragma unroll
        for (int j = 0; j < 8; ++j) { const int c = lane * 8 + j; const float v = g[j] * rstd * p.ln_g[c] + p.ln_b[c];
            vnS[t * 512 + c] = v; p.out[O_SSV + (size_t)(b * 16 + t) * 512 + c] = v; }
    }
    __syncthreads();
    {
        const int c = threadIdx.x, g = c >> 6;
        float vn[16];
#pragma unroll
        for (int j = 0; j < 16; ++j) vn[j] = vnS[j * 512 + c];
        for (int i = 0; i < 16; ++i) {
            float mixed = p.sgu_b[g * 128 + i];
#pragma unroll
            for (int j = 0; j < 16; ++j) mixed += p.sgu_w[((size_t)g * 128 + i) * 128 + j] * vn[j];
            const size_t row = (size_t)MP + b * 16 + i;
            const float u = (float)PROJ[row * NPJ + C_U + c], za = (float)PROJ[row * NPJ + C_ZA + c];
            ((h16*)(p.ws + WS_AOUT))[row * 512 + c] = (h16)(geluf_(u) * mixed * siluf_(za));
        }
    }
    __syncthreads();
}

constexpr int TK_C = 2048, TK_TRIG = TK_C - 512;
constexpr int L3_QA = 147456;
constexpr int L3_HIST = 131072, L3_CNT = L3_HIST + 8192, L3_THR = L3_CNT + 32, L3_SUM = L3_THR + 32;
__device__ __forceinline__ unsigned fkey(float f) { const unsigned u = __float_as_uint(f); return (u & 0x80000000u) ? ~u : (u | 0x80000000u); }
__device__ __forceinline__ float fkey_inv(unsigned k) { return __uint_as_float((k & 0x80000000u) ? (k ^ 0x80000000u) : ~k); }

template <bool ON_LO>
__device__ __forceinline__ unsigned radix_select(const u64* buf, unsigned* hist, int n, int lane, unsigned fhi, int k, int& ceq_out, int& krem_out) {
    unsigned prefix = 0, pmask = 0; int krem = k; int ceq = 0;
    for (int shift = 24; shift >= 0; shift -= 8) {
        *(u32x4*)(hist + 4 * lane) = (u32x4){0u, 0u, 0u, 0u};
        __builtin_amdgcn_s_waitcnt(0); asm volatile("" ::: "memory");
        for (int i = lane; i < n; i += 64) {
            const u64 e = buf[i]; const unsigned hi = (unsigned)(e >> 32), lo = (unsigned)e;
            const unsigned key = ON_LO ? lo : hi;
            const bool ok = (ON_LO ? (hi == fhi) : true) && ((key & pmask) == prefix);
            if (ok) atomicAdd(hist + ((key >> shift) & 255u), 1u);
        }
        __builtin_amdgcn_s_waitcnt(0); asm volatile("" ::: "memory");
        const u32x4 hv = *(const u32x4*)(hist + 4 * lane);
        const unsigned s = hv.x + hv.y + hv.z + hv.w;
        unsigned S = s;
#pragma unroll
        for (int o = 1; o < 64; o <<= 1) { const unsigned t = __shfl_down(S, o); if (lane + o < 64) S += t; }
        const bool is = (S >= (unsigned)krem) && (S - s < (unsigned)krem);
        const u64 bm = __ballot(is);
        const int L = bm ? (__ffsll((long long)bm) - 1) : 0;
        unsigned d = 0, cab = S - s, ce = 0;
        { unsigned c = S - s;
          if (c + hv.w >= (unsigned)krem) { d = 3; cab = c; ce = hv.w; }
          else { c += hv.w; if (c + hv.z >= (unsigned)krem) { d = 2; cab = c; ce = hv.z; }
          else { c += hv.z; if (c + hv.y >= (unsigned)krem) { d = 1; cab = c; ce = hv.y; }
          else { c += hv.y; d = 0; cab = c; ce = hv.x; } } } }
        d = __shfl(d, L); cab = __shfl(cab, L); ce = __shfl(ce, L);
        const unsigned digit = 4u * (unsigned)L + d;
        krem -= (int)cab; ceq = (int)ce; prefix |= digit << shift; pmask |= 255u << shift;
    }
    ceq_out = ceq; krem_out = krem;
    return prefix;
}
__device__ __forceinline__ int tk_compact(u64* buf, unsigned* hist, int n, int lane_in, float& thr) {
    int lane = lane_in; asm volatile("" : "+v"(lane));
    unsigned ehi[32];
    const unsigned* b32 = (const unsigned*)buf;
#pragma unroll
    for (int j = 0; j < 32; ++j) { ehi[j] = 0u; if (64 * j < n) { const int ic = min(lane + 64 * j, n - 1); ehi[j] = b32[2 * ic + 1]; } }
    unsigned mn = 0xFFFFFFFFu, mx = 0u;
#pragma unroll
    for (int j = 0; j < 32; ++j) { if (64 * j < n) { mn = min(mn, ehi[j]); mx = max(mx, ehi[j]); } }
#pragma unroll
    for (int o = 1; o < 64; o <<= 1) { mn = min(mn, (unsigned)__shfl_xor((int)mn, o)); mx = max(mx, (unsigned)__shfl_xor((int)mx, o)); }
    const unsigned range = mx - mn; const int sh = range ? __clz(range) : 0;
#pragma unroll
    for (int j = 0; j < 32; ++j) { const unsigned nk = (ehi[j] - mn) << sh; ehi[j] = ((lane + 64 * j) < n) ? nk : 0u; }
    const unsigned ninv = (unsigned)(((n + 63) & ~63) - n);
    unsigned prefix = 0, pmask = 0; int krem = 256; bool done = false;
    for (int shift = 24; shift >= 0 && !done; shift -= 8) {
        *(u32x4*)(hist + 4 * lane) = (u32x4){0u, 0u, 0u, 0u};
        __builtin_amdgcn_s_waitcnt(0); asm volatile("" ::: "memory");
#pragma unroll
        for (int j = 0; j < 32; ++j) { if (64 * j < n) { if ((ehi[j] & pmask) == prefix) atomicAdd(hist + ((ehi[j] >> shift) & 255u), 1u); } }
        __builtin_amdgcn_s_waitcnt(0); asm volatile("" ::: "memory");
        u32x4 hv = *(const u32x4*)(hist + 4 * lane);
        if (lane == 0 && prefix == 0u) hv.x -= ninv;
        const unsigned s = hv.x + hv.y + hv.z + hv.w;
        unsigned S = s;
#pragma unroll
        for (int o = 1; o < 64; o <<= 1) { const unsigned t = __shfl_down(S, o); if (lane + o < 64) S += t; }
        const bool is = (S >= (unsigned)krem) && (S - s < (unsigned)krem);
        const u64 bm = __ballot(is);
        const int L = bm ? (__ffsll((long long)bm) - 1) : 0;
        unsigned d = 0, cab = S - s, ce = 0;
        { unsigned c = S - s;
          if (c + hv.w >= (unsigned)krem) { d = 3; cab = c; ce = hv.w; }
          else { c += hv.w; if (c + hv.z >= (unsigned)krem) { d = 2; cab = c; ce = hv.z; }
          else { c += hv.z; if (c + hv.y >= (unsigned)krem) { d = 1; cab = c; ce = hv.y; }
          else { c += hv.y; d = 0; cab = c; ce = hv.x; } } } }
        d = __shfl(d, L); cab = __shfl(cab, L); ce = __shfl(ce, L);
        krem -= (int)cab; prefix |= (4u * (unsigned)L + d) << shift; pmask |= 255u << shift;
        if ((int)ce == krem) done = true;
    }
    unsigned tlo = 0u;
    const unsigned thi_abs = mn + ((prefix + ((1u << sh) - 1u)) >> sh);
    if (!done) { int c2, k2; tlo = radix_select<true>(buf, hist, n, lane, mn + (prefix >> sh), krem, c2, k2); }
    int outn = 0;
#pragma unroll
    for (int j = 0; j < 32; ++j) {
        if (64 * j < n) {
            const int i = lane + 64 * j; const int ic = min(i, n - 1);
            const unsigned elo_ = b32[2 * ic];
            const bool keep = (i < n) && ((ehi[j] > prefix) || ((ehi[j] & pmask) == prefix && (done || elo_ >= tlo)));
            const u64 bm = __ballot(keep);
            const int off = __builtin_amdgcn_mbcnt_hi((unsigned)(bm >> 32), __builtin_amdgcn_mbcnt_lo((unsigned)bm, 0u));
            if (keep) buf[outn + off] = ((u64)(mn + (ehi[j] >> sh)) << 32) | (u64)elo_;
            outn += __popcll(bm);
        }
    }
    __builtin_amdgcn_s_waitcnt(0); asm volatile("" ::: "memory");
    thr = fkey_inv(thi_abs - 1u);
    return outn;
}

struct AUnit { int qrow0, krow0, nk; const h16* kib; int kis; const unsigned char* kvb; int kvs; };

__device__ __forceinline__ void attn_unit(const Params& p, unsigned char* lds, const AUnit U, int wave, int lane, unsigned long long& tacc) {
    h16* PROJ = (h16*)(p.ws + WS_PROJ);
    u64* bufall = (u64*)lds;
    unsigned* hist = (unsigned*)(lds + L3_HIST) + wave * 256;
    unsigned* cnt = (unsigned*)(lds + L3_CNT);
    float* thrs = (float*)(lds + L3_THR);
    float* sums = (float*)(lds + L3_SUM) + wave * 8;
    int lane_r = lane; asm volatile("" : "+v"(lane_r));
    const int half = lane_r >> 5, l31 = lane_r & 31;
    f32x2 wq[2][2][4];
    h16x8* qalds = (h16x8*)(lds + L3_QA);
#define LOADQ() do { _Pragma("unroll") for (int mt = 0; mt < 2; ++mt) _Pragma("unroll") for (int e = 0; e < 2; ++e) \
        { const h16x8 w8_ = *(const h16x8*)(PROJ + (size_t)(U.qrow0 + mt * 4 + 2 * half + e) * NPJ + C_WI); \
          _Pragma("unroll") for (int h = 0; h < 4; ++h) wq[mt][e][h] = (f32x2){(float)w8_[2 * h], (float)w8_[2 * h + 1]}; } } while (0)
    {
        int lane_s = lane; asm volatile("" : "+v"(lane_s)); const int l31 = lane_s & 31, half = lane_s >> 5;
        const int ql = 2 * ((l31 >> 2) & 1) + (l31 >> 4), hh = ((l31 >> 3) & 1) * 4 + (l31 & 3);
        const int mt_ = wave >> 2, ks_ = wave & 3;
        qalds[wave * 64 + lane_s] = *(const h16x8*)(PROJ + (size_t)(U.qrow0 + mt_ * 4 + ql) * NPJ + C_QI + hh * 64 + half * 8 + ks_ * 16);
    }
    __builtin_amdgcn_sched_barrier(0);
    LOADQ();
    __builtin_amdgcn_sched_barrier(0);
    for (int repi_ = 0; repi_ < REP_IDX; ++repi_) {
    __syncthreads();
    { const int t8 = lane_id(); if (wave == 0 && t8 < 8) { cnt[t8] = 0u; thrs[t8] = -__builtin_inff(); } }
    __syncthreads();
    const int nkt = (U.nk + 31) >> 5, rounds = (nkt + 15) >> 4;
    h16x8 bf[2][4], bn[2][4];
#define LOADB(dst, rdx) do { _Pragma("unroll") for (int rr = 0; rr < 2; ++rr) { const int kt_ = (rdx) * 16 + rr * 8 + wave; const int ktc_ = kt_ < nkt ? kt_ : nkt - 1; \
        const h16* kp_ = U.kib + (size_t)(U.krow0 + ktc_ * 32 + l31) * U.kis + half * 8; \
        _Pragma("unroll") for (int ks = 0; ks < 4; ++ks) dst[rr][ks] = *(const h16x8*)(kp_ + ks * 16); } } while (0)
    TBEG(1)
    LOADB(bf, 0);
#pragma unroll 1
    for (int rd = 0; rd < rounds; rd += 2) {
        LOADB(bn, rd + 1);
#pragma unroll
        for (int rr = 0; rr < 2; ++rr) {
            const int kt = (rd) * 16 + rr * 8 + wave;
            if (kt < nkt) {
                const int key = kt * 32 + l31; const bool kvalid = key < U.nk;
#pragma unroll
                for (int mt = 0; mt < 2; ++mt) {
                    f32x16 cc;
#pragma unroll
                    for (int r = 0; r < 16; ++r) cc[r] = 0.f;
#pragma unroll
                    for (int ks = 0; ks < 4; ++ks) cc = __builtin_amdgcn_mfma_f32_32x32x16_f16(qalds[(mt * 4 + ks) * 64 + lane], bf[rr][ks], cc, 0, 0, 0);
                    float sv[2]; bool ps[2];
                    const f32x2 thp = *(const f32x2*)(thrs + mt * 4 + 2 * half);
#pragma unroll
                    for (int e = 0; e < 2; ++e) {
                        f32x2 s2 = (f32x2){0.f, 0.f};
#pragma unroll
                        for (int h = 0; h < 4; ++h) {
                            const f32x2 r2 = (f32x2){__int_as_float(max(__float_as_int(cc[e * 8 + 2 * h]), 0)), __int_as_float(max(__float_as_int(cc[e * 8 + 2 * h + 1]), 0))};
                            s2 = __builtin_elementwise_fma(r2, wq[mt][e][h], s2);
                        }
                        const float s = s2.x + s2.y;
                        sv[e] = s; ps[e] = kvalid && (s > thp[e]);
                    }
                    const u64 bm0 = __ballot(ps[0]), bm1 = __ballot(ps[1]);
                    if (bm0 | bm1) {
                        const int ql = lane - mt * 4;
                        unsigned myc = 0u;
                        myc = (ql == 0) ? (unsigned)__popc((unsigned)bm0) : myc;
                        myc = (ql == 1) ? (unsigned)__popc((unsigned)bm1) : myc;
                        myc = (ql == 2) ? (unsigned)__popc((unsigned)(bm0 >> 32)) : myc;
                        myc = (ql == 3) ? (unsigned)__popc((unsigned)(bm1 >> 32)) : myc;
                        unsigned basev = 0u;
                        if ((unsigned)ql < 4u && myc) basev = atomicAdd(cnt + lane, myc);
                        const unsigned b00 = __builtin_amdgcn_readlane(basev, mt * 4), b01 = __builtin_amdgcn_readlane(basev, mt * 4 + 1);
                        const unsigned b10 = __builtin_amdgcn_readlane(basev, mt * 4 + 2), b11 = __builtin_amdgcn_readlane(basev, mt * 4 + 3);
                        const unsigned ltm = (1u << l31) - 1u;
                        if (ps[0]) { const unsigned hm = half ? (unsigned)(bm0 >> 32) : (unsigned)bm0; const unsigned pos = (half ? b10 : b00) + (unsigned)__popc(hm & ltm);
                            bufall[(size_t)(mt * 4 + 2 * half) * TK_C + pos] = ((u64)fkey(sv[0]) << 32) | (u64)(~(unsigned)key); }
                        if (ps[1]) { const unsigned hm = half ? (unsigned)(bm1 >> 32) : (unsigned)bm1; const unsigned pos = (half ? b11 : b01) + (unsigned)__popc(hm & ltm);
                            bufall[(size_t)(mt * 4 + 2 * half + 1) * TK_C + pos] = ((u64)fkey(sv[1]) << 32) | (u64)(~(unsigned)key); }
                    }
                }
            }
        }
        { TBEG(6)
        LDS_BARRIER();
        TEND(6) }
        bool need;
        { const u32x4 c0_ = *(const u32x4*)cnt, c1_ = *(const u32x4*)(cnt + 4); const unsigned m_ = max(max(max(c0_.x, c0_.y), max(c0_.z, c0_.w)), max(max(c1_.x, c1_.y), max(c1_.z, c1_.w))); need = m_ > (unsigned)TK_TRIG; }
        { TBEG(6)
        LDS_BARRIER();
        TEND(6) }
        if (need && (rd) + 1 < rounds) {
            TBEG(2)
            const int n = (int)cnt[wave];
            if (n > 256) { float t; const int nn = tk_compact(bufall + (size_t)wave * TK_C, hist, n, lane, t); if (lane == 0) { cnt[wave] = (unsigned)nn; thrs[wave] = t; } }
            __builtin_amdgcn_sched_barrier(0);
            LOADQ(); LOADB(bn, rd + 1);
            LDS_BARRIER();
            TEND(2)
        }
        if (rd + 1 < rounds) {
        LOADB(bf, rd + 2);
#pragma unroll
        for (int rr = 0; rr < 2; ++rr) {
            const int kt = (rd + 1) * 16 + rr * 8 + wave;
            if (kt < nkt) {
                const int key = kt * 32 + l31; const bool kvalid = key < U.nk;
#pragma unroll
                for (int mt = 0; mt < 2; ++mt) {
                    f32x16 cc;
#pragma unroll
                    for (int r = 0; r < 16; ++r) cc[r] = 0.f;
#pragma unroll
                    for (int ks = 0; ks < 4; ++ks) cc = __builtin_amdgcn_mfma_f32_32x32x16_f16(qalds[(mt * 4 + ks) * 64 + lane], bn[rr][ks], cc, 0, 0, 0);
                    float sv[2]; bool ps[2];
                    const f32x2 thp = *(const f32x2*)(thrs + mt * 4 + 2 * half);
#pragma unroll
                    for (int e = 0; e < 2; ++e) {
                        f32x2 s2 = (f32x2){0.f, 0.f};
#pragma unroll
                        for (int h = 0; h < 4; ++h) {
                            const f32x2 r2 = (f32x2){__int_as_float(max(__float_as_int(cc[e * 8 + 2 * h]), 0)), __int_as_float(max(__float_as_int(cc[e * 8 + 2 * h + 1]), 0))};
                            s2 = __builtin_elementwise_fma(r2, wq[mt][e][h], s2);
                        }
                        const float s = s2.x + s2.y;
                        sv[e] = s; ps[e] = kvalid && (s > thp[e]);
                    }
                    const u64 bm0 = __ballot(ps[0]), bm1 = __ballot(ps[1]);
                    if (bm0 | bm1) {
                        const int ql = lane - mt * 4;
                        unsigned myc = 0u;
                        myc = (ql == 0) ? (unsigned)__popc((unsigned)bm0) : myc;
                        myc = (ql == 1) ? (unsigned)__popc((unsigned)bm1) : myc;
                        myc = (ql == 2) ? (unsigned)__popc((unsigned)(bm0 >> 32)) : myc;
                        myc = (ql == 3) ? (unsigned)__popc((unsigned)(bm1 >> 32)) : myc;
                        unsigned basev = 0u;
                        if ((unsigned)ql < 4u && myc) basev = atomicAdd(cnt + lane, myc);
                        const unsigned b00 = __builtin_amdgcn_readlane(basev, mt * 4), b01 = __builtin_amdgcn_readlane(basev, mt * 4 + 1);
                        const unsigned b10 = __builtin_amdgcn_readlane(basev, mt * 4 + 2), b11 = __builtin_amdgcn_readlane(basev, mt * 4 + 3);
                        const unsigned ltm = (1u << l31) - 1u;
                        if (ps[0]) { const unsigned hm = half ? (unsigned)(bm0 >> 32) : (unsigned)bm0; const unsigned pos = (half ? b10 : b00) + (unsigned)__popc(hm & ltm);
                            bufall[(size_t)(mt * 4 + 2 * half) * TK_C + pos] = ((u64)fkey(sv[0]) << 32) | (u64)(~(unsigned)key); }
                        if (ps[1]) { const unsigned hm = half ? (unsigned)(bm1 >> 32) : (unsigned)bm1; const unsigned pos = (half ? b11 : b01) + (unsigned)__popc(hm & ltm);
                            bufall[(size_t)(mt * 4 + 2 * half + 1) * TK_C + pos] = ((u64)fkey(sv[1]) << 32) | (u64)(~(unsigned)key); }
                    }
                }
            }
        }
        { TBEG(6)
        LDS_BARRIER();
        TEND(6) }
        bool need;
        { const u32x4 c0_ = *(const u32x4*)cnt, c1_ = *(const u32x4*)(cnt + 4); const unsigned m_ = max(max(max(c0_.x, c0_.y), max(c0_.z, c0_.w)), max(max(c1_.x, c1_.y), max(c1_.z, c1_.w))); need = m_ > (unsigned)TK_TRIG; }
        { TBEG(6)
        LDS_BARRIER();
        TEND(6) }
        if (need && (rd + 1) + 1 < rounds) {
            TBEG(2)
            const int n = (int)cnt[wave];
            if (n > 256) { float t; const int nn = tk_compact(bufall + (size_t)wave * TK_C, hist, n, lane, t); if (lane == 0) { cnt[wave] = (unsigned)nn; thrs[wave] = t; } }
            __builtin_amdgcn_sched_barrier(0);
            LOADQ(); LOADB(bf, rd + 2);
            LDS_BARRIER();
            TEND(2)
        }
        }
    }
#undef LOADB
#undef LOADQ
    TEND(1)
    }
    u64* buf = bufall + (size_t)wave * TK_C;
    TBEG(3)
    int n = (int)cnt[wave];
    if (n > 256) { float t; n = tk_compact(buf, hist, n, lane, t); }
    TEND(3)
    const int qrow = U.qrow0 + wave;
    int lane_o = lane; asm volatile("" : "+v"(lane_o));
    for (int repa_ = 0; repa_ < REP_ATT; ++repa_) {
    TBEG(4)
    float* P = (float*)((unsigned char*)buf + 4096);
    {
        const int fr = lane_o & 15, fq = lane_o >> 4;
        h16x8 qf[2];
#pragma unroll
        for (int ks = 0; ks < 2; ++ks) {
            if (fr < 8) qf[ks] = *(const h16x8*)(PROJ + (size_t)qrow * NPJ + C_Q + fr * 64 + ks * 32 + fq * 8);
            else {
#pragma unroll
                for (int j = 0; j < 8; ++j) qf[ks][j] = (h16)0.f; }
        }
        h16x8 zero8;
#pragma unroll
        for (int j = 0; j < 8; ++j) zero8[j] = (h16)0.f;
        u32x4 ka[8], kb[8];
#define ISSUEK4(dst, g) do { _Pragma("unroll") for (int tt = 0; tt < 2; ++tt) { const int s_ = ((g) * 2 + tt) * 16 + fr; const unsigned idx_ = (s_ < n) ? ~(unsigned)buf[s_] : 0u; \
        const unsigned char* kr_ = U.kvb + (size_t)(U.krow0 + (int)idx_) * 512 + fq * 16; \
        _Pragma("unroll") for (int j = 0; j < 4; ++j) dst[tt * 4 + j] = *(const u32x4*)(kr_ + j * 64); } } while (0)
#define COMPK4(src, g) do { _Pragma("unroll") for (int tt = 0; tt < 2; ++tt) { f32x4 c_ = (f32x4){0.f, 0.f, 0.f, 0.f}; \
        _Pragma("unroll") for (int j = 0; j < 4; ++j) { const u32x4 w_ = src[tt * 4 + j]; \
            const h16x8 a0_ = ((fr >> 1) == j) ? qf[0] : zero8, a1_ = ((fr >> 1) == j) ? qf[1] : zero8; \
            c_ = __builtin_amdgcn_mfma_f32_16x16x32_f16(a0_, fp8x8_to_h16((u64)w_.x | ((u64)w_.y << 32)), c_, 0, 0, 0); \
            c_ = __builtin_amdgcn_mfma_f32_16x16x32_f16(a1_, fp8x8_to_h16((u64)w_.z | ((u64)w_.w << 32)), c_, 0, 0, 0); } \
        const int s_ = ((g) * 2 + tt) * 16 + fr; const bool v_ = s_ < n; \
        _Pragma("unroll") for (int r = 0; r < 4; ++r) c_[r] = v_ ? c_[r] * 0.125f : -1e30f; \
        if (fq < 2) *(f32x4*)(P + s_ * 8 + fq * 4) = c_; } } while (0)
        ISSUEK4(ka, 0);
#pragma unroll 1
        for (int g = 0; g < 8; g += 2) {
            ISSUEK4(kb, g + 1);
            COMPK4(ka, g);
            ISSUEK4(ka, g + 2);
            COMPK4(kb, g + 1);
        }
#undef ISSUEK4
#undef COMPK4
        __builtin_amdgcn_s_waitcnt(0); asm volatile("" ::: "memory");
        f32x4 acc[16];
#pragma unroll
        for (int t = 0; t < 16; ++t) acc[t] = *(const f32x4*)(P + (t * 16 + fr) * 8 + (fq & 1) * 4);
        float mx[4] = {-1e30f, -1e30f, -1e30f, -1e30f};
#pragma unroll
        for (int t = 0; t < 16; ++t) { const bool v = (t * 16 + fr) < n;
#pragma unroll
            for (int r = 0; r < 4; ++r) { mx[r] = fmaxf(mx[r], acc[t][r]); } }
#pragma unroll
        for (int r = 0; r < 4; ++r) {
#pragma unroll
            for (int o = 1; o < 16; o <<= 1) mx[r] = fmaxf(mx[r], __shfl_xor(mx[r], o)); }
        float sm[4] = {0.f, 0.f, 0.f, 0.f};
#pragma unroll
        for (int t = 0; t < 16; ++t) { const bool v = (t * 16 + fr) < n;
#pragma unroll
            for (int r = 0; r < 4; ++r) { const float e = v ? __expf(acc[t][r] - mx[r]) : 0.f; acc[t][r] = e; sm[r] += e; } }
#pragma unroll
        for (int r = 0; r < 4; ++r) {
#pragma unroll
            for (int o = 1; o < 16; o <<= 1) sm[r] += __shfl_xor(sm[r], o); }
        __builtin_amdgcn_s_waitcnt(0); asm volatile("" ::: "memory");
        if (fq < 2) {
#pragma unroll
            for (int t = 0; t < 16; ++t) *(f32x4*)(P + (t * 16 + fr) * 8 + fq * 4) = acc[t];
            if (fr == 0) {
#pragma unroll
                for (int r = 0; r < 4; ++r) sums[fq * 4 + r] = sm[r]; }
        }
        __builtin_amdgcn_s_waitcnt(0); asm volatile("" ::: "memory");
    }
    TEND(4)
    TBEG(5)
    {
        const int sg = lane_o >> 4, part = lane_o & 15, kv = part >> 2, d0 = (part & 3) * 16;
        f32x2 o0[8], o1[8];
#pragma unroll
        for (int j = 0; j < 8; ++j) { o0[j] = (f32x2){0.f, 0.f}; o1[j] = (f32x2){0.f, 0.f}; }
        u32x4 va[8], vb[8];
        const unsigned char* vbase = U.kvb + 256 + kv * 64 + d0;
#define ISSUEV16(dst, gi) do { _Pragma("unroll") for (int ii = 0; ii < 8; ++ii) { const int s_ = 4 * ((gi) * 8 + ii) + sg; const unsigned idx_ = (s_ < n) ? ~(unsigned)buf[s_] : 0u; \
        dst[ii] = *(const u32x4*)(vbase + (size_t)(U.krow0 + (int)idx_) * 512); } } while (0)
#define COMPV16(src, gi) do { _Pragma("unroll") for (int ii = 0; ii < 8; ++ii) { const int s_ = 4 * ((gi) * 8 + ii) + sg; const f32x2 pp = *(const f32x2*)(P + (s_ & 255) * 8 + 2 * kv); const f32x2 px_ = (f32x2){pp.x, pp.x}, py_ = (f32x2){pp.y, pp.y}; const u32x4 w_ = src[ii]; \
        _Pragma("unroll") for (int q_ = 0; q_ < 4; ++q_) { const int ww_ = (int)w_[q_]; \
            const f32x2 xa_ = __builtin_amdgcn_cvt_pk_f32_fp8(ww_, false), xb_ = __builtin_amdgcn_cvt_pk_f32_fp8(ww_, true); \
            o0[q_ * 2] = __builtin_elementwise_fma(xa_, px_, o0[q_ * 2]); o0[q_ * 2 + 1] = __builtin_elementwise_fma(xb_, px_, o0[q_ * 2 + 1]); \
            o1[q_ * 2] = __builtin_elementwise_fma(xa_, py_, o1[q_ * 2]); o1[q_ * 2 + 1] = __builtin_elementwise_fma(xb_, py_, o1[q_ * 2 + 1]); } } } while (0)
        ISSUEV16(va, 0);
#pragma unroll 1
        for (int gi = 0; gi < 8; gi += 2) {
            ISSUEV16(vb, gi + 1);
            COMPV16(va, gi);
            ISSUEV16(va, gi + 2);
            COMPV16(vb, gi + 1);
        }
#undef ISSUEV16
#undef COMPV16
#pragma unroll
        for (int j = 0; j < 8; ++j) { o0[j].x += __shfl_xor(o0[j].x, 16); o0[j].x += __shfl_xor(o0[j].x, 32); o0[j].y += __shfl_xor(o0[j].y, 16); o0[j].y += __shfl_xor(o0[j].y, 32);
            o1[j].x += __shfl_xor(o1[j].x, 16); o1[j].x += __shfl_xor(o1[j].x, 32); o1[j].y += __shfl_xor(o1[j].y, 16); o1[j].y += __shfl_xor(o1[j].y, 32); }
        if (sg == 0) {
            const float i0 = 1.f / sums[2 * kv], i1 = 1.f / sums[2 * kv + 1];
            const h16* pz = PROJ + (size_t)qrow * NPJ + C_ZB + (2 * kv) * 64 + d0;
            h16* po = (h16*)(p.ws + WS_BOUT) + (size_t)qrow * 512 + (2 * kv) * 64 + d0;
#pragma unroll
            for (int hh = 0; hh < 2; ++hh) {
                const h16x8 za = *(const h16x8*)(pz + hh * 64), zb = *(const h16x8*)(pz + hh * 64 + 8);
                h16x8 ra, rb;
#pragma unroll
                for (int j = 0; j < 8; ++j) { const float oa = hh ? o1[j >> 1][j & 1] : o0[j >> 1][j & 1], ob = hh ? o1[4 + (j >> 1)][j & 1] : o0[4 + (j >> 1)][j & 1]; const float ii = hh ? i1 : i0;
                    ra[j] = (h16)(oa * ii * siluf_((float)za[j])); rb[j] = (h16)(ob * ii * siluf_((float)zb[j])); }
                *(h16x8*)(po + hh * 64) = ra; *(h16x8*)(po + hh * 64 + 8) = rb;
            }
        }
    }
    TEND(5)
    }
    __syncthreads();
}

__global__ void __launch_bounds__(512, 2) mk_fwd(Params p) {
    __builtin_assume(__builtin_amdgcn_workitem_id_y() == 0); __builtin_assume(__builtin_amdgcn_workitem_id_z() == 0);
    extern __shared__ __attribute__((aligned(16))) unsigned char lds[];
    cg::grid_group grid = cg::this_grid();
    const int wave = __builtin_amdgcn_readfirstlane((int)threadIdx.x >> 6);
    const int G = gridDim.x, bx = blockIdx.x;
    const int gw = bx * 8 + wave, NGW = G * 8;
    const int lo = p.ph_lo, hi = p.ph_hi;
    unsigned long long tacc = 0;
#define IN(k) (lo <= (k) && (k) < hi)
#define SEAM(k) do { if (IN(k) && IN((k) + 1)) grid.sync(); } while (0)
    h16* XH = (h16*)(p.ws + WS_XH); h16* PROJ = (h16*)(p.ws + WS_PROJ);
    h16* WIN = (h16*)(p.ws + WS_WIN); h16* WPA = (h16*)(p.ws + WS_WPA); h16* WPB = (h16*)(p.ws + WS_WPB); h16* WOUT = (h16*)(p.ws + WS_WOUT);
    h16* WSM = (h16*)(p.ws + WS_WSM); h16* KVS = (h16*)(p.ws + WS_KVS); h16* KIS = (h16*)(p.ws + WS_KIS);
    float* RSTD = (float*)(p.ws + WS_RSTD); float* ROWSS = (float*)(p.ws + WS_ROWSS);

    if (IN(0)) for (int rep_ = 0; rep_ < REP_P0; ++rep_) {
        const int lane = lane_id(), tid = wave * 64 + lane;
        float* scr = (float*)(lds + wave * 16384);
        constexpr int I_IN = 16 * (NPJ / 32), I_PA = 8 * 32, I_PB = 8 * 32, I_OUT = 16 * 32;
        for (int it = gw; it < I_IN + I_PA + I_PB + I_OUT; it += NGW) {
            int r = it;
            if (r < I_IN) { p0_tr_item(p.w_in, 1024, INW, WIN, p.norm_g, 1, scr, r, NPJ / 32, lane); continue; } r -= I_IN;
            if (r < I_PA) { p0_tr_item(p.w_pa, 512, 1024, WPA, nullptr, 0, scr, r, 32, lane); continue; } r -= I_PA;
            if (r < I_PB) { p0_tr_item(p.w_pb, 512, 1024, WPB, nullptr, 0, scr, r, 32, lane); continue; } r -= I_PB;
            p0_tr_item(p.w_out, 1024, 1024, WOUT, nullptr, 0, scr, r, 32, lane);
        }
        for (int m = gw; m < MT; m += NGW) {
            u64* o8 = (u64*)(XH + (size_t)m * DM) + lane;
            if (m < MROWS) {
                const float* xr = (m < MP) ? p.xp + (size_t)m * DM : p.xs + (size_t)(m - MP) * DM;
                const f32x4* x4 = (const f32x4*)xr + lane;
                f32x4 v[4]; float s = 0.f;
#pragma unroll
                for (int j = 0; j < 4; ++j) { v[j] = x4[64 * j]; s += (v[j].x * v[j].x + v[j].y * v[j].y) + (v[j].z * v[j].z + v[j].w * v[j].w); }
                s = wave_sum(s);
                if (lane == 0) RSTD[m] = rsqrtf(s * (1.f / 1024.f) + 1e-6f);
#pragma unroll
                for (int j = 0; j < 4; ++j) { h16x4 h; h[0] = (h16)v[j].x; h[1] = (h16)v[j].y; h[2] = (h16)v[j].z; h[3] = (h16)v[j].w; o8[64 * j] = __builtin_bit_cast(u64, h); }
            } else {
                if (lane == 0) RSTD[m] = 0.f;
#pragma unroll
                for (int j = 0; j < 4; ++j) o8[64 * j] = 0ull;
            }
        }
        const int gt = bx * 512 + tid, NGT = G * 512;
        for (int i = gt; i < NB * NKSP * 64; i += NGT) {
            const int c8 = (i & 63) * 8, r = (i >> 6) % NKSP, b = (i >> 6) / NKSP;
            if (r >= PAST && r < NKS) continue;
            f32x4 f0 = (f32x4){0.f, 0.f, 0.f, 0.f}, f1 = f0;
            if (r < PAST) { const float* src = (c8 < 256) ? p.ck + ((size_t)b * PAST + r) * 256 + c8 : p.cv + ((size_t)b * PAST + r) * 256 + (c8 - 256);
                f0 = *(const f32x4*)src; f1 = *(const f32x4*)(src + 4); }
            *(u64*)((unsigned char*)KVS + ((size_t)b * NKSP + r) * 512 + kvpos(c8)) = pack8_fp8(f0, f1);
        }
        for (int i = gt; i < NB * NKSP * 8; i += NGT) {
            const int c8 = (i & 7) * 8, r = (i >> 3) % NKSP, b = (i >> 3) / NKSP;
            if (r >= PAST && r < NKS) continue;
            h16x8 h;
            if (r < PAST) { const float* src = p.cki + ((size_t)b * PAST + r) * 64 + c8;
#pragma unroll
                for (int j = 0; j < 8; ++j) h[j] = (h16)src[j]; }
            else {
#pragma unroll
                for (int j = 0; j < 8; ++j) h[j] = (h16)0.f; }
            *(h16x8*)(KIS + ((size_t)b * NKSP + r) * 64 + c8) = h;
        }
        for (int i = gt; i < 8 * 128 * 128; i += NGT) { const int j = i & 127, ii = (i >> 7) & 127; WSM[i] = ((j >> 6) <= (ii >> 6)) ? (h16)p.sgu_w[i] : (h16)0.f; }
    }
    SEAM(0);
    if (IN(1)) for (int rep_ = 0; rep_ < REP_P1; ++rep_) {
        pg8::Gemm g{XH, WIN, MT, NPJ, 1024, 1024}; pg8::StaticOrder S; S.init(MT, NPJ, G, bx);
        EpiProj E{PROJ, RSTD, p.out, (unsigned char*)KVS, KIS, (unsigned char*)(p.ws + WS_KVC), (h16*)(p.ws + WS_KIC)};
        pg8::gemm_phase<EpiProj>((LAS unsigned char*)lds, g, S, E);
    }
    SEAM(1);
    if (IN(2)) for (int rep_ = 0; rep_ < REP_P2; ++rep_) {
        for (int u = bx; u < 512 + NB; u += G) { const int lane = lane_id(); if (u < 512) sgu_chunk(p, lds, u, wave, lane); else sgu_sample(p, lds, u - 512, wave, lane); }
    }
    if (IN(3)) for (int rep_ = 0; rep_ < REP_P3; ++rep_) {
        for (int u = bx; u < 8192 + 16; u += G) {
            AUnit U;
            if (u < 8192) { const int i = u >> 8, gp = u & 255, b = gp & 7, s = gp >> 3; const int jt = s + 32 * i;
                U.qrow0 = b * SEQ + jt * 8; U.krow0 = b * SEQ; U.nk = ((jt * 8) / 64 + 1) * 64; U.kib = (const h16*)(p.ws + WS_KIC); U.kis = 64; U.kvb = (const unsigned char*)(p.ws + WS_KVC); U.kvs = 512; }
            else { const int v = u - 8192, b = v >> 1, hf = v & 1;
                U.qrow0 = MP + b * 16 + hf * 8; U.krow0 = b * NKSP; U.nk = NKS; U.kib = KIS; U.kis = 64; U.kvb = (const unsigned char*)KVS; U.kvs = 512; }
            attn_unit(p, lds, U, wave, lane_id(), tacc);
        }
    }
    SEAM(3);
    if (IN(4)) for (int rep_ = 0; rep_ < REP_P4; ++rep_) {
        { pg8::Gemm g{(const h16*)(p.ws + WS_AOUT), WPA, MT, 1024, 512, 512}; pg8::StaticOrder S; S.init(MT, 1024, G, bx); EpiGate<1> E{PROJ}; pg8::gemm_phase<EpiGate<1>>((LAS unsigned char*)lds, g, S, E); }
        { pg8::Gemm g{(const h16*)(p.ws + WS_BOUT), WPB, MT, 1024, 512, 512}; pg8::StaticOrder S; S.init(MT, 1024, G, bx); EpiGate<0> E{PROJ}; pg8::gemm_phase<EpiGate<0>>((LAS unsigned char*)lds, g, S, E); }
    }
    SEAM(4);
    if (IN(5)) for (int rep_ = 0; rep_ < REP_P5; ++rep_) {
        pg8::Gemm g{PROJ + C_M, WOUT, MT, 1024, 1024, NPJ}; pg8::StaticOrder S; S.init(MT, 1024, G, bx);
        EpiOut E{p.xp, p.xs, p.out, ROWSS};
        pg8::gemm_phase<EpiOut>((LAS unsigned char*)lds, g, S, E);
    }
    SEAM(5);
    if (IN(6)) {
        const int lane = lane_id();
        for (int m = gw; m < MROWS; m += NGW) {
            float* yr = (m < MP) ? p.out + O_YP + (size_t)m * DM : p.out + O_YS + (size_t)(m - MP) * DM;
            float ssum = (lane < 16) ? ROWSS[(size_t)m * 16 + lane] : 0.f; ssum = wave_sum(ssum);
            const float r = rsqrtf(ssum * (1.f / 1024.f) + 1e-6f);
            const int lane6 = lane;
            f32x4* y4 = (f32x4*)yr + lane6; const f32x4* g4 = (const f32x4*)p.final_g + lane6;
#pragma unroll
            for (int j = 0; j < 4; ++j) { f32x4 v = y4[64 * j]; const f32x4 gg = g4[64 * j]; v = v * r * gg; y4[64 * j] = v; }
        }
    }
    if (TSEL != 0 && bx == 0 && threadIdx.x == 0) { const unsigned long long t0 = rt_(); while (rt_() - t0 < tacc) __builtin_amdgcn_s_sleep(8); }
#undef IN
#undef SEAM
}

extern "C" void kernel_launch(void* const* d_in, const int* in_sizes, int n_in, void* d_out, int out_size, void* d_ws, size_t ws_size, hipStream_t stream) {
    static int grid_blocks = 0;
    if (grid_blocks == 0) {
        if (ws_size < WS_END) { fprintf(stderr, "kernel_launch: workspace too small: %zu < %zu\n", ws_size, (size_t)WS_END); grid_blocks = -1; return; }
        int dev = 0, cus = 0, per_cu = 0;
        hipGetDevice(&dev);
        hipDeviceGetAttribute(&cus, hipDeviceAttributeMultiprocessorCount, dev);
        hipFuncSetAttribute((const void*)mk_fwd, hipFuncAttributeMaxDynamicSharedMemorySize, LDS_BYTES);
        hipOccupancyMaxActiveBlocksPerMultiprocessor(&per_cu, (const void*)mk_fwd, 512, LDS_BYTES);
        if (per_cu < 1) { fprintf(stderr, "kernel_launch: occupancy query says %d blocks per CU\n", per_cu); per_cu = 1; }
        grid_blocks = cus * per_cu;
        (void)hipGetLastError();
    }
    if (grid_blocks < 0) return;
    Params p{};
    p.xp = (const float*)d_in[0]; p.xs = (const float*)d_in[1]; p.ck = (const float*)d_in[2]; p.cv = (const float*)d_in[3]; p.cki = (const float*)d_in[4];
    p.norm_g = (const float*)d_in[5]; p.w_in = (const float*)d_in[6]; p.ln_g = (const float*)d_in[7]; p.ln_b = (const float*)d_in[8];
    p.sgu_w = (const float*)d_in[9]; p.sgu_b = (const float*)d_in[10]; p.w_pa = (const float*)d_in[11]; p.w_pb = (const float*)d_in[12];
    p.w_out = (const float*)d_in[13]; p.final_g = (const float*)d_in[14];
    p.out = (float*)d_out; p.ws = (unsigned char*)d_ws; p.ph_lo = 0; p.ph_hi = 7;
    void* args[] = {&p};
    hipError_t e = hipLaunchCooperativeKernel((const void*)mk_fwd, dim3(grid_blocks), dim3(512), args, LDS_BYTES, stream);
    if (e != hipSuccess) fprintf(stderr, "cooperative launch failed: %s (grid %d)\n", hipGetErrorString(e), grid_blocks);
}
```

```cpp
#include <hip/hip_runtime.h>
#include <hip/hip_cooperative_groups.h>
#include <cstdio>
#include <cstdint>
namespace cg = cooperative_groups;
#define REP_P0 1
#define REP_P1 1
#define REP_P2 1
#define REP_P3 1
#define REP_IDX 1
#define REP_ATT 1
#define TSEL 0
#define LDS_BARRIER() do { asm volatile("s_waitcnt lgkmcnt(0)" ::: "memory"); __builtin_amdgcn_s_barrier(); asm volatile("" ::: "memory"); } while (0)
__device__ __forceinline__ unsigned long long rt_() { return __builtin_amdgcn_s_memrealtime(); }
#define TBEG(k) unsigned long long tb_##k = 0; if (TSEL == (k)) tb_##k = rt_();
#define TEND(k) if (TSEL == (k)) tacc += rt_() - tb_##k;
#define REP_P4 1
#define REP_P5 1

#define LAS __attribute__((address_space(3)))
typedef _Float16 h16;
typedef _Float16 h16x8 __attribute__((ext_vector_type(8)));
typedef _Float16 h16x4 __attribute__((ext_vector_type(4)));
typedef _Float16 h16x2 __attribute__((ext_vector_type(2)));
typedef float f32x2 __attribute__((ext_vector_type(2)));
typedef float f32x4 __attribute__((ext_vector_type(4)));
typedef float f32x16 __attribute__((ext_vector_type(16)));
typedef unsigned u32x4 __attribute__((ext_vector_type(4)));
typedef unsigned u32x2 __attribute__((ext_vector_type(2)));
typedef unsigned long long u64;

constexpr int DM = 1024, SEQ = 8192, NB = 8, MP = NB * SEQ;
constexpr int DSQ = 16, MS = NB * DSQ, PAST = 1024, NKS = PAST + DSQ, NKSP = 1056;
constexpr int MROWS = MP + MS;
constexpr int MT = MP + 256;
constexpr int INW = 5704, NPJ = 5888;
constexpr int C_U = 0, C_V = 512, C_ZA = 1024, C_Q = 1536, C_K = 2048, C_VV = 2304, C_ZB = 2560, C_QI = 3072, C_KI = 3584, C_WI = 3648, C_GA = 3840, C_GB = 4864;
constexpr size_t O_YP = 0, O_YS = 67108864, O_PK = 67239936, O_PV = 84017152, O_PKI = 100794368, O_SK = 104988672, O_SV = 105021440, O_SKI = 105054208, O_SSV = 105062400;
constexpr size_t WS_XH = 0;
constexpr size_t WS_PROJ = WS_XH + (size_t)MT * DM * 2;
constexpr size_t WS_WIN = WS_PROJ + (size_t)MT * NPJ * 2;
constexpr size_t WS_WPA = WS_WIN + (size_t)NPJ * DM * 2;
constexpr size_t WS_WPB = WS_WPA + (size_t)1024 * 512 * 2;
constexpr size_t WS_WOUT = WS_WPB + (size_t)1024 * 512 * 2;
constexpr size_t WS_WSM = WS_WOUT + (size_t)1024 * 1024 * 2;
constexpr size_t WS_KVS = WS_WSM + (size_t)8 * 128 * 128 * 2;
constexpr size_t WS_KIS = WS_KVS + (size_t)NB * NKSP * 512 * 2;
constexpr size_t WS_RSTD = WS_KIS + (size_t)NB * NKSP * 64 * 2;
constexpr size_t WS_ROWSS = WS_RSTD + (size_t)MT * 4;
constexpr size_t WS_KIC = WS_ROWSS + (size_t)MT * 16 * 4;
constexpr size_t WS_KVC = WS_KIC + (size_t)MP * 64 * 2;
constexpr size_t WS_END = WS_KVC + (size_t)MP * 512 * 2;
constexpr size_t WS_AOUT = WS_XH, WS_BOUT = WS_XH + (size_t)MT * 512 * 2;
constexpr int C_T = 0, C_M = 1024;
constexpr int LDS_BYTES = 155648;

__device__ __forceinline__ float sigmoidf_(float x) { return 1.f / (1.f + __expf(-x)); }
__device__ __forceinline__ float siluf_(float x) { return x / (1.f + __expf(-x)); }
__device__ __forceinline__ float geluf_(float x) { const float t = 1.5957691216057308f * (x + 0.044715f * x * x * x); return x / (1.f + __expf(-t)); }
__device__ __forceinline__ int lane_id() { int l; asm volatile("v_mbcnt_lo_u32_b32 %0, -1, 0\n\tv_mbcnt_hi_u32_b32 %0, -1, %0" : "=v"(l)); return l; }
__device__ __forceinline__ float wave_sum(float v) {
#pragma unroll
    for (int o = 1; o < 64; o <<= 1) v += __shfl_xor(v, o);
    return v;
}

namespace pg8 {
constexpr int BM = 256, BK = 64, HALF = 128, HTB = HALF * BK * 2, STAGE_BYTES = 8 * HTB, NXCD = 8, WGM = 8;
__host__ __device__ __forceinline__ int lds_byte(int r, int c) { const int st = (r >> 4) * 2 + (c >> 5), rr = r & 15, cc = c & 31, ob = rr * 64 + cc * 2; return st * 1024 + (ob ^ (((ob >> 9) & 1) << 5)); }
__host__ __device__ __forceinline__ void stage_rc(int b, int& R, int& C) { const int st = b / 1024, sb = b % 1024, swz = sb ^ (((sb >> 9) & 1) << 5); R = (st >> 1) * 16 + swz / 64; C = (st & 1) * 32 + (swz % 64) / 2; }
__host__ __device__ __forceinline__ int perm32(int rho) { const int n = rho >> 4, i = rho & 15; return 8 * (i >> 2) + 4 * n + (i & 3); }
struct Unit { int pm, pn; };
struct Gemm { const h16* A; const h16* Bt; int M, N, K, lda; };
struct StaticOrder {
    int nM, nN, nwg, G, c;
    __device__ void init(int M, int N, int G_, int c_) { nM = M / BM; nN = N / BM; nwg = nM * nN; G = G_; c = c_; }
    __device__ bool next(int i, Unit& u) const {
        const long L = (long)i * G + c; if (L >= nwg) return false;
        int wgid = (int)L; { const int q = nwg / NXCD, r = nwg % NXCD, xcd = wgid % NXCD, off = wgid / NXCD; wgid = (xcd < r ? xcd * (q + 1) : r * (q + 1) + (xcd - r) * q) + off; }
        const int nig = WGM * nN, gid = wgid / nig, fm = gid * WGM, gsz = (nM - fm) < WGM ? (nM - fm) : WGM;
        u.pm = fm + ((wgid % nig) % gsz); u.pn = (wgid % nig) / gsz; return true;
    }
};
template <class Epi>
__device__ __forceinline__ void gemm_phase(LAS unsigned char* lds, const Gemm g, const StaticOrder& S, const Epi& E) {
    const int tid = threadIdx.x, wid = __builtin_amdgcn_readfirstlane(tid >> 6), lane = tid & 63, wr = wid >> 2, wc = wid & 3, fr = lane & 15, fq = lane >> 4;
    const int K = g.K, nt = K / BK, lda = g.lda;
    unsigned voffA[2], voffB[2];
#pragma unroll
    for (int i = 0; i < 2; ++i) { int R, C; stage_rc(tid * 16 + i * 8192, R, C); const int Rb = (R & ~31) + perm32(R & 31);
        voffA[i] = (unsigned)(R * lda + C) * 2u; voffB[i] = (unsigned)(Rb * K + C) * 2u; }
    const size_t kstep = (size_t)(BK * 2);
    const size_t hstepA = (size_t)HALF * lda * 2, hstepB = (size_t)HALF * K * 2;
    const size_t tstepA = 2 * hstepA, tstepB = 2 * hstepB;
    const unsigned ldsw = (unsigned)wid * 1024u;
    const int aoff = lds_byte(wr * 64 + fr, fq * 8), boff = lds_byte(wc * 32 + fr, fq * 8);
#define PG8_SA(b, h) (((b) * 2 + (h)) * HTB)
#define PG8_SB(b, h) ((4 + (b) * 2 + (h)) * HTB)
#define PG8_STAGE(bufoff, gbase, voff) do { _Pragma("unroll") for (int _i = 0; _i < 2; ++_i) \
        __builtin_amdgcn_global_load_lds((const unsigned*)((const char*)(gbase) + (voff)[_i]), (LAS unsigned*)(lds + (bufoff) + ldsw + _i * 8192), 16, 0, 0); } while (0)
#define PG8_LDA(dst, b, h) do { _Pragma("unroll") for (int m = 0; m < 4; ++m) _Pragma("unroll") for (int k = 0; k < 2; ++k) dst[m][k] = *(const LAS h16x8*)(lds + PG8_SA(b, h) + aoff + m * 2048 + k * 1024); } while (0)
#define PG8_LDB(dst, b, h) do { _Pragma("unroll") for (int n = 0; n < 2; ++n) _Pragma("unroll") for (int k = 0; k < 2; ++k) dst[n][k] = *(const LAS h16x8*)(lds + PG8_SB(b, h) + boff + n * 2048 + k * 1024); } while (0)
#define PG8_MMA(ai, bj, At, Bt) do { __builtin_amdgcn_s_setprio(1); _Pragma("unroll") for (int m = 0; m < 4; ++m) _Pragma("unroll") for (int n = 0; n < 2; ++n) _Pragma("unroll") for (int k = 0; k < 2; ++k) \
        acc[ai][bj][m][n] = __builtin_amdgcn_mfma_f32_16x16x32_f16(Bt[n][k], At[m][k], acc[ai][bj][m][n], 0, 0, 0); __builtin_amdgcn_s_setprio(0); } while (0)
#define PG8_WAIT_V(n) asm volatile("s_waitcnt vmcnt(" #n ")" ::: "memory")
#define PG8_WAIT_L(n) asm volatile("s_waitcnt lgkmcnt(" #n ")" ::: "memory")
#define PG8_BAR __builtin_amdgcn_s_barrier()
#define PG8_SCHED __builtin_amdgcn_sched_barrier(0)
    Unit cur, nxt; int ui = 0;
    if (!S.next(0, cur)) return;
    f32x4 acc[2][2][4][2];
#pragma unroll
    for (int a = 0; a < 2; ++a)
#pragma unroll
        for (int b = 0; b < 2; ++b)
#pragma unroll
            for (int m = 0; m < 4; ++m)
#pragma unroll
                for (int n = 0; n < 2; ++n) acc[a][b][m][n] = (f32x4){0.f, 0.f, 0.f, 0.f};
    h16x8 At[4][2], B0[2][2], B1[2][2];
    const char* cA = (const char*)g.A + (size_t)cur.pm * tstepA; const char* cB = (const char*)g.Bt + (size_t)cur.pn * tstepB;
    PG8_STAGE(PG8_SB(0, 0), cB, voffB); PG8_STAGE(PG8_SB(0, 1), cB + hstepB, voffB); PG8_STAGE(PG8_SA(0, 0), cA, voffA); PG8_STAGE(PG8_SA(0, 1), cA + hstepA, voffA);
    if (wr == 1) PG8_BAR;
    PG8_WAIT_V(2); PG8_BAR;
    PG8_STAGE(PG8_SB(1, 0), cB + kstep, voffB); PG8_STAGE(PG8_SA(1, 0), cA + kstep, voffA); PG8_STAGE(PG8_SB(1, 1), cB + hstepB + kstep, voffB);
    PG8_WAIT_V(6); PG8_BAR;
    for (;;) {
        const bool has_next = S.next(ui + 1, nxt);
        const char* nA = has_next ? (const char*)g.A + (size_t)nxt.pm * tstepA : cA; const char* nB = has_next ? (const char*)g.Bt + (size_t)nxt.pn * tstepB : cB;
        for (int t = 0; t < nt; t += 2) {
            const bool last = (t == nt - 2);
            const char* a1 = cA + (size_t)(t + 1) * kstep;
            const char* a2 = last ? nA : cA + (size_t)(t + 2) * kstep; const char* b2 = last ? nB : cB + (size_t)(t + 2) * kstep;
            const char* a3 = a2 + kstep; const char* b3 = b2 + kstep;
            PG8_LDB(B0, 0, 0); PG8_LDB(B1, 0, 1); PG8_SCHED; PG8_LDA(At, 0, 0); PG8_STAGE(PG8_SA(1, 1), a1 + hstepA, voffA);
            PG8_WAIT_V(8); PG8_WAIT_L(0); PG8_BAR; PG8_MMA(0, 0, At, B0); PG8_MMA(0, 1, At, B1); PG8_BAR; PG8_SCHED;
            PG8_LDA(At, 0, 1); PG8_STAGE(PG8_SB(0, 0), b2, voffB); PG8_STAGE(PG8_SB(0, 1), b2 + hstepB, voffB); PG8_STAGE(PG8_SA(0, 0), a2, voffA);
            PG8_WAIT_V(8); PG8_WAIT_L(0); PG8_BAR; PG8_MMA(1, 0, At, B0); PG8_MMA(1, 1, At, B1); PG8_BAR; PG8_SCHED;
            PG8_LDB(B0, 1, 0); PG8_LDB(B1, 1, 1); PG8_SCHED; PG8_LDA(At, 1, 0); PG8_STAGE(PG8_SA(0, 1), a2 + hstepA, voffA);
            PG8_WAIT_V(8); PG8_WAIT_L(0); PG8_BAR; PG8_MMA(0, 0, At, B0); PG8_MMA(0, 1, At, B1); PG8_BAR; PG8_SCHED;
            PG8_LDA(At, 1, 1); PG8_STAGE(PG8_SB(1, 0), b3, voffB); PG8_STAGE(PG8_SB(1, 1), b3 + hstepB, voffB); PG8_STAGE(PG8_SA(1, 0), a3, voffA);
            PG8_WAIT_V(8); PG8_WAIT_L(0); PG8_BAR; PG8_MMA(1, 0, At, B0); PG8_MMA(1, 1, At, B1); PG8_BAR; PG8_SCHED;
        }
        if (wr == 0) PG8_BAR;
        E(acc, cur, wr, wc, fr, fq);
        if (!has_next) break;
#pragma unroll
        for (int a = 0; a < 2; ++a)
#pragma unroll
            for (int b = 0; b < 2; ++b)
#pragma unroll
                for (int m = 0; m < 4; ++m)
#pragma unroll
                    for (int n = 0; n < 2; ++n) acc[a][b][m][n] = (f32x4){0.f, 0.f, 0.f, 0.f};
        cur = nxt; cA = nA; cB = nB; ++ui;
        if (wr == 1) PG8_BAR;
    }
    PG8_WAIT_V(0);
    PG8_BAR;
#undef PG8_SA
#undef PG8_SB
#undef PG8_STAGE
#undef PG8_LDA
#undef PG8_LDB
#undef PG8_MMA
#undef PG8_WAIT_V
#undef PG8_WAIT_L
#undef PG8_BAR
#undef PG8_SCHED
}
}

__device__ __forceinline__ u64 pack8_fp8(const f32x4 a, const f32x4 b) {
    int w0 = __builtin_amdgcn_cvt_pk_fp8_f32(a[0], a[1], 0, false); w0 = __builtin_amdgcn_cvt_pk_fp8_f32(a[2], a[3], w0, true);
    int w1 = __builtin_amdgcn_cvt_pk_fp8_f32(b[0], b[1], 0, false); w1 = __builtin_amdgcn_cvt_pk_fp8_f32(b[2], b[3], w1, true);
    return (u64)(unsigned)w0 | ((u64)(unsigned)w1 << 32);
}
__device__ __forceinline__ h16x8 fp8x8_to_h16(const u64 v) {
    const int w0 = (int)(unsigned)v, w1 = (int)(unsigned)(v >> 32);
    const f32x2 a = __builtin_amdgcn_cvt_pk_f32_fp8(w0, false), b = __builtin_amdgcn_cvt_pk_f32_fp8(w0, true), c = __builtin_amdgcn_cvt_pk_f32_fp8(w1, false), d = __builtin_amdgcn_cvt_pk_f32_fp8(w1, true);
    h16x8 h; h[0] = (h16)a.x; h[1] = (h16)a.y; h[2] = (h16)b.x; h[3] = (h16)b.y; h[4] = (h16)c.x; h[5] = (h16)c.y; h[6] = (h16)d.x; h[7] = (h16)d.y;
    return h;
}
__device__ __forceinline__ int kvpos(int lc) { if (lc >= 256) return lc; const int j = lc >> 6, d = lc & 63; return j * 64 + ((d & 31) >> 3) * 16 + (d >> 5) * 8; }
__device__ __forceinline__ u32x4 pack8(const f32x4 a, const f32x4 b) {
    h16x8 h; h[0] = (h16)a[0]; h[1] = (h16)a[1]; h[2] = (h16)a[2]; h[3] = (h16)a[3]; h[4] = (h16)b[0]; h[5] = (h16)b[1]; h[6] = (h16)b[2]; h[7] = (h16)b[3];
    return __builtin_bit_cast(u32x4, h);
}

struct EpiProj {
    h16* PROJ; const float* rstd; float* dout; unsigned char* KVS; h16* KIS; unsigned char* KVC; h16* KIC;
    __device__ __forceinline__ void operator()(const f32x4 (&acc)[2][2][4][2], const pg8::Unit& u, int wr, int wc, int fr, int fq) const {
        const int row0 = u.pm * 256 + wr * 64 + fr, col0 = u.pn * 256 + wc * 32 + 8 * fq;
        const int pn = u.pn;
#pragma unroll
        for (int ai = 0; ai < 2; ++ai)
#pragma unroll
            for (int m = 0; m < 4; ++m) {
                const int row = row0 + ai * 128 + m * 16; const float rs = rstd[row];
#pragma unroll
                for (int bj = 0; bj < 2; ++bj) {
                    const int c = col0 + bj * 128;
                    const f32x4 v0 = acc[ai][bj][m][0] * rs, v1 = acc[ai][bj][m][1] * rs;
                    if (pn != 8 && pn != 9) *(u32x4*)(PROJ + (size_t)row * NPJ + c) = pack8(v0, v1);
                    if (pn == 8 || pn == 9 || (pn == 14 && c < C_KI + 64)) {
                        if (row < MP) {
                            float* o = (pn == 8) ? dout + O_PK + (size_t)row * 256 + (c - C_K) : (pn == 9) ? dout + O_PV + (size_t)row * 256 + (c - C_VV) : dout + O_PKI + (size_t)row * 64 + (c - C_KI);
                            *(f32x4*)o = v0; *(f32x4*)(o + 4) = v1;
                            if (pn == 14) *(u32x4*)(KIC + (size_t)row * 64 + (c - C_KI)) = pack8(v0, v1);
                            else *(u64*)(KVC + (size_t)row * 512 + kvpos(c - C_K)) = pack8_fp8(v0, v1);
                        } else if (row < MROWS) {
                            const int t = row - MP, b = t >> 4, s = t & 15; const size_t kr = (size_t)b * NKSP + PAST + s;
                            float* o = (pn == 8) ? dout + O_SK + (size_t)t * 256 + (c - C_K) : (pn == 9) ? dout + O_SV + (size_t)t * 256 + (c - C_VV) : dout + O_SKI + (size_t)t * 64 + (c - C_KI);
                            *(f32x4*)o = v0; *(f32x4*)(o + 4) = v1;
                            if (pn == 14) *(u32x4*)(KIS + kr * 64 + (c - C_KI)) = pack8(v0, v1);
                            else *(u64*)(KVS + kr * 512 + kvpos(c - C_K)) = pack8_fp8(v0, v1);
                        }
                    }
                }
            }
    }
};
template <int FIRST> struct EpiGate {
    h16* PROJ;
    __device__ __forceinline__ void operator()(const f32x4 (&acc)[2][2][4][2], const pg8::Unit& u, int wr, int wc, int fr, int fq) const {
        const int row0 = u.pm * 256 + wr * 64 + fr, col0 = u.pn * 256 + wc * 32 + 8 * fq;
#pragma unroll
        for (int ai = 0; ai < 2; ++ai)
#pragma unroll
            for (int m = 0; m < 4; ++m) {
                const int row = row0 + ai * 128 + m * 16;
#pragma unroll
                for (int bj = 0; bj < 2; ++bj) {
                    const int c = col0 + bj * 128;
                    h16* pm_ = PROJ + (size_t)row * NPJ + (FIRST ? C_T : C_M) + c;
                    const h16x8 gt = *(const h16x8*)(PROJ + (size_t)row * NPJ + (FIRST ? C_GA : C_GB) + c);
                    f32x4 v0, v1;
#pragma unroll
                    for (int j = 0; j < 4; ++j) { v0[j] = sigmoidf_((float)gt[j]) * acc[ai][bj][m][0][j]; v1[j] = sigmoidf_((float)gt[4 + j]) * acc[ai][bj][m][1][j]; }
                    if (!FIRST) { const h16x8 tp = *(const h16x8*)(PROJ + (size_t)row * NPJ + C_T + c);
#pragma unroll
                        for (int j = 0; j < 4; ++j) { v0[j] += (float)tp[j]; v1[j] += (float)tp[4 + j]; } }
                    *(u32x4*)pm_ = pack8(v0, v1);
                }
            }
    }
};
struct EpiOut {
    const float* xp; const float* xs; float* dout; float* rowss;
    __device__ __forceinline__ void operator()(const f32x4 (&acc)[2][2][4][2], const pg8::Unit& u, int wr, int wc, int fr, int fq) const {
        const int row0 = u.pm * 256 + wr * 64 + fr, col0 = u.pn * 256 + wc * 32 + 8 * fq;
#pragma unroll
        for (int ai = 0; ai < 2; ++ai)
#pragma unroll
            for (int m = 0; m < 4; ++m) {
                const int row = row0 + ai * 128 + m * 16;
                const bool ok = row < MROWS;
                const float* xr = (row < MP) ? xp + (size_t)row * DM : xs + (size_t)(row - MP) * DM;
                float* yr = (row < MP) ? dout + O_YP + (size_t)row * DM : dout + O_YS + (size_t)(row - MP) * DM;
                float ss = 0.f;
                if (ok) {
#pragma unroll
                    for (int bj = 0; bj < 2; ++bj) {
                        const int c = col0 + bj * 128;
                        const f32x4 x0 = *(const f32x4*)(xr + c), x1 = *(const f32x4*)(xr + c + 4);
                        const f32x4 v0 = x0 + acc[ai][bj][m][0], v1 = x1 + acc[ai][bj][m][1];
                        *(f32x4*)(yr + c) = v0; *(f32x4*)(yr + c + 4) = v1;
                        ss += v0[0] * v0[0] + v0[1] * v0[1] + v0[2] * v0[2] + v0[3] * v0[3] + v1[0] * v1[0] + v1[1] * v1[1] + v1[2] * v1[2] + v1[3] * v1[3];
                    }
                }
                ss += __shfl_xor(ss, 16); ss += __shfl_xor(ss, 32);
                if (ok && fq == 0) rowss[(size_t)row * 16 + u.pn * 4 + wc] = ss;
            }
    }
};

struct Params {
    const float *xp, *xs, *ck, *cv, *cki, *norm_g, *w_in, *ln_g, *ln_b, *sgu_w, *sgu_b, *w_pa, *w_pb, *w_out, *final_g;
    float* out; unsigned char* ws; int ph_lo, ph_hi;
};

__device__ __forceinline__ void p0_tr_item(const float* W, int K, int Nsrc, h16* WT, const float* gs, int mode, float* scr, int item, int nblk, int lane) {
    const int kb = item / nblk, nb = item % nblk, k0 = 64 * kb, n0 = 32 * nb;
    const int nn = n0 + (lane & 31);
    int src = nn; bool valid = true;
    if (mode == 1) { if (nn >= C_WI + 8 && nn < C_GA) valid = false; else if (nn >= C_GA) src = nn - (C_GA - (C_WI + 8)); }
#pragma unroll 8
    for (int i = 0; i < 32; ++i) { const int kk = 2 * i + (lane >> 5);
        float v = 0.f; if (valid) { v = W[(size_t)(k0 + kk) * Nsrc + src]; if (gs) v *= gs[k0 + kk]; }
        scr[kk * 33 + (lane & 31)] = v; }
    __builtin_amdgcn_s_waitcnt(0); asm volatile("" ::: "memory");
    const int c = lane & 7;
#pragma unroll
    for (int j = 0; j < 4; ++j) { const int n = (lane >> 3) + 8 * j; const float* s = scr + (8 * c) * 33 + n;
        h16x8 h;
#pragma unroll
        for (int q = 0; q < 8; ++q) h[q] = (h16)s[q * 33];
        *(h16x8*)(WT + (size_t)(n0 + n) * K + k0 + 8 * c) = h; }
    __builtin_amdgcn_s_waitcnt(0); asm volatile("" ::: "memory");
}

constexpr int VNT_LD = 136;
__device__ __forceinline__ void sgu_chunk(const Params& p, unsigned char* lds, int chunk, int wave, int lane) {
    h16* PROJ = (h16*)(p.ws + WS_PROJ);
    h16* vnT = (h16*)lds;
    h16* AOUT = (h16*)(p.ws + WS_AOUT);
    const h16* WSM = (const h16*)(p.ws + WS_WSM);
    {
        float lg[8], lb[8];
#pragma unroll
        for (int j = 0; j < 8; ++j) { lg[j] = p.ln_g[lane * 8 + j]; lb[j] = p.ln_b[lane * 8 + j]; }
        for (int tt = 0; tt < 16; ++tt) {
            const int tok = wave * 16 + tt; const size_t row = (size_t)chunk * 128 + tok;
            const h16x8 vv = *(const h16x8*)(PROJ + row * NPJ + C_V + lane * 8);
            float g[8]; float s = 0.f;
#pragma unroll
            for (int j = 0; j < 8; ++j) { g[j] = geluf_((float)vv[j]); s += g[j]; }
            const float mean = wave_sum(s) * (1.f / 512.f); float q = 0.f;
#pragma unroll
            for (int j = 0; j < 8; ++j) { g[j] -= mean; q += g[j] * g[j]; }
            const float rstd = rsqrtf(wave_sum(q) * (1.f / 512.f) + 1e-5f);
#pragma unroll
            for (int j = 0; j < 8; ++j) vnT[(lane * 8 + j) * VNT_LD + tok] = (h16)(g[j] * rstd * lg[j] + lb[j]);
        }
    }
    __syncthreads();
    {
        const int g = wave, fr = lane & 15, fq = lane >> 4;
        for (int it = 0; it < 8; ++it) {
            f32x4 acc[4];
#pragma unroll
            for (int dt = 0; dt < 4; ++dt) acc[dt] = (f32x4){0.f, 0.f, 0.f, 0.f};
            const int nks = (it < 4) ? 2 : 4;
            for (int ks = 0; ks < nks; ++ks) {
                const h16x8 b = *(const h16x8*)(WSM + ((size_t)g * 128 + it * 16 + fr) * 128 + ks * 32 + fq * 8);
#pragma unroll
                for (int dt = 0; dt < 4; ++dt) {
                    const h16x8 a = *(const h16x8*)(vnT + (g * 64 + dt * 16 + fr) * VNT_LD + ks * 32 + fq * 8);
                    acc[dt] = __builtin_amdgcn_mfma_f32_16x16x32_f16(a, b, acc[dt], 0, 0, 0);
                }
            }
            const int i = it * 16 + fr; const size_t row = (size_t)chunk * 128 + i;
            const float bias = p.sgu_b[g * 128 + i];
#pragma unroll
            for (int dt = 0; dt < 4; ++dt) {
                const int c = g * 64 + dt * 16 + fq * 4;
                const h16x4 uu = *(const h16x4*)(PROJ + row * NPJ + C_U + c); const h16x4 zz = *(const h16x4*)(PROJ + row * NPJ + C_ZA + c);
                h16x4 o;
#pragma unroll
                for (int r = 0; r < 4; ++r) o[r] = (h16)(geluf_((float)uu[r]) * (acc[dt][r] + bias) * siluf_((float)zz[r]));
                *(h16x4*)(AOUT + row * 512 + c) = o;
            }
        }
    }
    __syncthreads();
}
__device__ __forceinline__ void sgu_sample(const Params& p, unsigned char* lds, int b, int wave, int lane) {
    h16* PROJ = (h16*)(p.ws + WS_PROJ);
    float* vnS = (float*)lds;
    for (int tt = 0; tt < 2; ++tt) {
        const int t = wave * 2 + tt; const size_t row = (size_t)MP + b * 16 + t;
        const h16x8 vv = *(const h16x8*)(PROJ + row * NPJ + C_V + lane * 8);
        float g[8]; float s = 0.f;
#pragma unroll
        for (int j = 0; j < 8; ++j) { g[j] = geluf_((float)vv[j]); s += g[j]; }
        const float mean = wave_sum(s) * (1.f / 512.f); float q = 0.f;
#pragma unroll
        for (int j = 0; j < 8; ++j) { g[j] -= mean; q += g[j] * g[j]; }
        const float rstd = rsqrtf(wave_sum(q) * (1.f / 512.f) + 1e-5f);
#pragma unroll
        for (int j = 0; j < 8; ++j) { const int c = lane * 8 + j; const float v = g[j] * rstd * p.ln_g[c] + p.ln_b[c];
            vnS[t * 512 + c] = v; p.out[O_SSV + (size_t)(b * 16 + t) * 512 + c] = v; }
    }
    __syncthreads();
    {
        const int c = threadIdx.x, g = c >> 6;
        float vn[16];
#pragma unroll
        for (int j = 0; j < 16; ++j) vn[j] = vnS[j * 512 + c];
        for (int i = 0; i < 16; ++i) {
            float mixed = p.sgu_b[g * 128 + i];
#pragma unroll
            for (int j = 0; j < 16; ++j) mixed += p.sgu_w[((size_t)g * 128 + i) * 128 + j] * vn[j];
            const size_t row = (size_t)MP + b * 16 + i;
            const float u = (float)PROJ[row * NPJ + C_U + c], za = (float)PROJ[row * NPJ + C_ZA + c];
            ((h16*)(p.ws + WS_AOUT))[row * 512 + c] = (h16)(geluf_(u) * mixed * siluf_(za));
        }
    }
    __syncthreads();
}

constexpr int TK_C = 2048, TK_TRIG = TK_C - 512;
constexpr int L3_QA = 147456;
constexpr int L3_HIST = 131072, L3_CNT = L3_HIST + 8192, L3_THR = L3_CNT + 32, L3_SUM = L3_THR + 32;
__device__ __forceinline__ unsigned fkey(float f) { const unsigned u = __float_as_uint(f); return (u & 0x80000000u) ? ~u : (u | 0x80000000u); }
__device__ __forceinline__ float fkey_inv(unsigned k) { return __uint_as_float((k & 0x80000000u) ? (k ^ 0x80000000u) : ~k); }

template <bool ON_LO>
__device__ __forceinline__ unsigned radix_select(const u64* buf, unsigned* hist, int n, int lane, unsigned fhi, int k, int& ceq_out, int& krem_out) {
    unsigned prefix = 0, pmask = 0; int krem = k; int ceq = 0;
    for (int shift = 24; shift >= 0; shift -= 8) {
        *(u32x4*)(hist + 4 * lane) = (u32x4){0u, 0u, 0u, 0u};
        __builtin_amdgcn_s_waitcnt(0); asm volatile("" ::: "memory");
        for (int i = lane; i < n; i += 64) {
            const u64 e = buf[i]; const unsigned hi = (unsigned)(e >> 32), lo = (unsigned)e;
            const unsigned key = ON_LO ? lo : hi;
            const bool ok = (ON_LO ? (hi == fhi) : true) && ((key & pmask) == prefix);
            if (ok) atomicAdd(hist + ((key >> shift) & 255u), 1u);
        }
        __builtin_amdgcn_s_waitcnt(0); asm volatile("" ::: "memory");
        const u32x4 hv = *(const u32x4*)(hist + 4 * lane);
        const unsigned s = hv.x + hv.y + hv.z + hv.w;
        unsigned S = s;
#pragma unroll
        for (int o = 1; o < 64; o <<= 1) { const unsigned t = __shfl_down(S, o); if (lane + o < 64) S += t; }
        const bool is = (S >= (unsigned)krem) && (S - s < (unsigned)krem);
        const u64 bm = __ballot(is);
        const int L = bm ? (__ffsll((long long)bm) - 1) : 0;
        unsigned d = 0, cab = S - s, ce = 0;
        { unsigned c = S - s;
          if (c + hv.w >= (unsigned)krem) { d = 3; cab = c; ce = hv.w; }
          else { c += hv.w; if (c + hv.z >= (unsigned)krem) { d = 2; cab = c; ce = hv.z; }
          else { c += hv.z; if (c + hv.y >= (unsigned)krem) { d = 1; cab = c; ce = hv.y; }
          else { c += hv.y; d = 0; cab = c; ce = hv.x; } } } }
        d = __shfl(d, L); cab = __shfl(cab, L); ce = __shfl(ce, L);
        const unsigned digit = 4u * (unsigned)L + d;
        krem -= (int)cab; ceq = (int)ce; prefix |= digit << shift; pmask |= 255u << shift;
    }
    ceq_out = ceq; krem_out = krem;
    return prefix;
}
__device__ __forceinline__ int tk_compact(u64* buf, unsigned* hist, int n, int lane_in, float& thr) {
    int lane = lane_in; asm volatile("" : "+v"(lane));
    unsigned ehi[32];
    const unsigned* b32 = (const unsigned*)buf;
#pragma unroll
    for (int j = 0; j < 32; ++j) { ehi[j] = 0u; if (64 * j < n) { const int ic = min(lane + 64 * j, n - 1); ehi[j] = b32[2 * ic + 1]; } }
    unsigned mn = 0xFFFFFFFFu, mx = 0u;
#pragma unroll
    for (int j = 0; j < 32; ++j) { if (64 * j < n) { mn = min(mn, ehi[j]); mx = max(mx, ehi[j]); } }
#pragma unroll
    for (int o = 1; o < 64; o <<= 1) { mn = min(mn, (unsigned)__shfl_xor((int)mn, o)); mx = max(mx, (unsigned)__shfl_xor((int)mx, o)); }
    const unsigned range = mx - mn; const int sh = range ? __clz(range) : 0;
#pragma unroll
    for (int j = 0; j < 32; ++j) { const unsigned nk = (ehi[j] - mn) << sh; ehi[j] = ((lane + 64 * j) < n) ? nk : 0u; }
    const unsigned ninv = (unsigned)(((n + 63) & ~63) - n);
    unsigned prefix = 0, pmask = 0; int krem = 256; bool done = false;
    for (int shift = 24; shift >= 0 && !done; shift -= 8) {
        *(u32x4*)(hist + 4 * lane) = (u32x4){0u, 0u, 0u, 0u};
        __builtin_amdgcn_s_waitcnt(0); asm volatile("" ::: "memory");
#pragma unroll
        for (int j = 0; j < 32; ++j) { if (64 * j < n) { if ((ehi[j] & pmask) == prefix) atomicAdd(hist + ((ehi[j] >> shift) & 255u), 1u); } }
        __builtin_amdgcn_s_waitcnt(0); asm volatile("" ::: "memory");
        u32x4 hv = *(const u32x4*)(hist + 4 * lane);
        if (lane == 0 && prefix == 0u) hv.x -= ninv;
        const unsigned s = hv.x + hv.y + hv.z + hv.w;
        unsigned S = s;
#pragma unroll
        for (int o = 1; o < 64; o <<= 1) { const unsigned t = __shfl_down(S, o); if (lane + o < 64) S += t; }
        const bool is = (S >= (unsigned)krem) && (S - s < (unsigned)krem);
        const u64 bm = __ballot(is);
        const int L = bm ? (__ffsll((long long)bm) - 1) : 0;
        unsigned d = 0, cab = S - s, ce = 0;
        { unsigned c = S - s;
          if (c + hv.w >= (unsigned)krem) { d = 3; cab = c; ce = hv.w; }
          else { c += hv.w; if (c + hv.z >= (unsigned)krem) { d = 2; cab = c; ce = hv.z; }
          else { c += hv.z; if (c + hv.y >= (unsigned)krem) { d = 1; cab = c; ce = hv.y; }
          else { c += hv.y; d = 0; cab = c; ce = hv.x; } } } }
        d = __shfl(d, L); cab = __shfl(cab, L); ce = __shfl(ce, L);
        krem -= (int)cab; prefix |= (4u * (unsigned)L + d) << shift; pmask |= 255u << shift;
        if ((int)ce == krem) done = true;
    }
    unsigned tlo = 0u;
    const unsigned thi_abs = mn + ((prefix + ((1u << sh) - 1u)) >> sh);
    if (!done) { int c2, k2; tlo = radix_select<true>(buf, hist, n, lane, mn + (prefix >> sh), krem, c2, k2); }
    int outn = 0;
#pragma unroll
    for (int j = 0; j < 32; ++j) {
        if (64 * j < n) {
            const int i = lane + 64 * j; const int ic = min(i, n - 1);
            const unsigned elo_ = b32[2 * ic];
            const bool keep = (i < n) && ((ehi[j] > prefix) || ((ehi[j] & pmask) == prefix && (done || elo_ >= tlo)));
            const u64 bm = __ballot(keep);
            const int off = __builtin_amdgcn_mbcnt_hi((unsigned)(bm >> 32), __builtin_amdgcn_mbcnt_lo((unsigned)bm, 0u));
            if (keep) buf[outn + off] = ((u64)(mn + (ehi[j] >> sh)) << 32) | (u64)elo_;
            outn += __popcll(bm);
        }
    }
    __builtin_amdgcn_s_waitcnt(0); asm volatile("" ::: "memory");
    thr = fkey_inv(thi_abs - 1u);
    return outn;
}

struct AUnit { int qrow0, krow0, nk; const h16* kib; int kis; const unsigned char* kvb; int kvs; };

__device__ __forceinline__ void attn_unit(const Params& p, unsigned char* lds, const AUnit U, int wave, int lane, unsigned long long& tacc) {
    h16* PROJ = (h16*)(p.ws + WS_PROJ);
    u64* bufall = (u64*)lds;
    unsigned* hist = (unsigned*)(lds + L3_HIST) + wave * 256;
    unsigned* cnt = (unsigned*)(lds + L3_CNT);
    float* thrs = (float*)(lds + L3_THR);
    float* sums = (float*)(lds + L3_SUM) + wave * 8;
    int lane_r = lane; asm volatile("" : "+v"(lane_r));
    const int half = lane_r >> 5, l31 = lane_r & 31;
    f32x2 wq[2][2][4];
    h16x8* qalds = (h16x8*)(lds + L3_QA);
#define LOADQ() do { _Pragma("unroll") for (int mt = 0; mt < 2; ++mt) _Pragma("unroll") for (int e = 0; e < 2; ++e) \
        { const h16x8 w8_ = *(const h16x8*)(PROJ + (size_t)(U.qrow0 + mt * 4 + 2 * half + e) * NPJ + C_WI); \
          _Pragma("unroll") for (int h = 0; h < 4; ++h) wq[mt][e][h] = (f32x2){(float)w8_[2 * h], (float)w8_[2 * h + 1]}; } } while (0)
    {
        int lane_s = lane; asm volatile("" : "+v"(lane_s)); const int l31 = lane_s & 31, half = lane_s >> 5;
        const int ql = 2 * ((l31 >> 2) & 1) + (l31 >> 4), hh = ((l31 >> 3) & 1) * 4 + (l31 & 3);
        const int mt_ = wave >> 2, ks_ = wave & 3;
        qalds[wave * 64 + lane_s] = *(const h16x8*)(PROJ + (size_t)(U.qrow0 + mt_ * 4 + ql) * NPJ + C_QI + hh * 64 + half * 8 + ks_ * 16);
    }
    __builtin_amdgcn_sched_barrier(0);
    LOADQ();
    __builtin_amdgcn_sched_barrier(0);
    for (int repi_ = 0; repi_ < REP_IDX; ++repi_) {
    __syncthreads();
    { const int t8 = lane_id(); if (wave == 0 && t8 < 8) { cnt[t8] = 0u; thrs[t8] = -__builtin_inff(); } }
    __syncthreads();
    const int nkt = (U.nk + 31) >> 5, rounds = (nkt + 15) >> 4;
    h16x8 bf[2][4], bn[2][4];
#define LOADB(dst, rdx) do { _Pragma("unroll") for (int rr = 0; rr < 2; ++rr) { const int kt_ = (rdx) * 16 + rr * 8 + wave; const int ktc_ = kt_ < nkt ? kt_ : nkt - 1; \
        const h16* kp_ = U.kib + (size_t)(U.krow0 + ktc_ * 32 + l31) * U.kis + half * 8; \
        _Pragma("unroll") for (int ks = 0; ks < 4; ++ks) dst[rr][ks] = *(const h16x8*)(kp_ + ks * 16); } } while (0)
    TBEG(1)
    LOADB(bf, 0);
#pragma unroll 1
    for (int rd = 0; rd < rounds; rd += 2) {
        LOADB(bn, rd + 1);
#pragma unroll
        for (int rr = 0; rr < 2; ++rr) {
            const int kt = (rd) * 16 + rr * 8 + wave;
            if (kt < nkt) {
                const int key = kt * 32 + l31; const bool kvalid = key < U.nk;
#pragma unroll
                for (int mt = 0; mt < 2; ++mt) {
                    f32x16 cc;
#pragma unroll
                    for (int r = 0; r < 16; ++r) cc[r] = 0.f;
#pragma unroll
                    for (int ks = 0; ks < 4; ++ks) cc = __builtin_amdgcn_mfma_f32_32x32x16_f16(qalds[(mt * 4 + ks) * 64 + lane], bf[rr][ks], cc, 0, 0, 0);
                    float sv[2]; bool ps[2];
                    const f32x2 thp = *(const f32x2*)(thrs + mt * 4 + 2 * half);
#pragma unroll
                    for (int e = 0; e < 2; ++e) {
                        f32x2 s2 = (f32x2){0.f, 0.f};
#pragma unroll
                        for (int h = 0; h < 4; ++h) {
                            const f32x2 r2 = (f32x2){__int_as_float(max(__float_as_int(cc[e * 8 + 2 * h]), 0)), __int_as_float(max(__float_as_int(cc[e * 8 + 2 * h + 1]), 0))};
                            s2 = __builtin_elementwise_fma(r2, wq[mt][e][h], s2);
                        }
                        const float s = s2.x + s2.y;
                        sv[e] = s; ps[e] = kvalid && (s > thp[e]);
                    }
                    const u64 bm0 = __ballot(ps[0]), bm1 = __ballot(ps[1]);
                    if (bm0 | bm1) {
                        const int ql = lane - mt * 4;
                        unsigned myc = 0u;
                        myc = (ql == 0) ? (unsigned)__popc((unsigned)bm0) : myc;
                        myc = (ql == 1) ? (unsigned)__popc((unsigned)bm1) : myc;
                        myc = (ql == 2) ? (unsigned)__popc((unsigned)(bm0 >> 32)) : myc;
                        myc = (ql == 3) ? (unsigned)__popc((unsigned)(bm1 >> 32)) : myc;
                        unsigned basev = 0u;
                        if ((unsigned)ql < 4u && myc) basev = atomicAdd(cnt + lane, myc);
                        const unsigned b00 = __builtin_amdgcn_readlane(basev, mt * 4), b01 = __builtin_amdgcn_readlane(basev, mt * 4 + 1);
                        const unsigned b10 = __builtin_amdgcn_readlane(basev, mt * 4 + 2), b11 = __builtin_amdgcn_readlane(basev, mt * 4 + 3);
                        const unsigned ltm = (1u << l31) - 1u;
                        if (ps[0]) { const unsigned hm = half ? (unsigned)(bm0 >> 32) : (unsigned)bm0; const unsigned pos = (half ? b10 : b00) + (unsigned)__popc(hm & ltm);
                            bufall[(size_t)(mt * 4 + 2 * half) * TK_C + pos] = ((u64)fkey(sv[0]) << 32) | (u64)(~(unsigned)key); }
                        if (ps[1]) { const unsigned hm = half ? (unsigned)(bm1 >> 32) : (unsigned)bm1; const unsigned pos = (half ? b11 : b01) + (unsigned)__popc(hm & ltm);
                            bufall[(size_t)(mt * 4 + 2 * half + 1) * TK_C + pos] = ((u64)fkey(sv[1]) << 32) | (u64)(~(unsigned)key); }
                    }
                }
            }
        }
        { TBEG(6)
        LDS_BARRIER();
        TEND(6) }
        bool need;
        { const u32x4 c0_ = *(const u32x4*)cnt, c1_ = *(const u32x4*)(cnt + 4); const unsigned m_ = max(max(max(c0_.x, c0_.y), max(c0_.z, c0_.w)), max(max(c1_.x, c1_.y), max(c1_.z, c1_.w))); need = m_ > (unsigned)TK_TRIG; }
        { TBEG(6)
        LDS_BARRIER();
        TEND(6) }
        if (need && (rd) + 1 < rounds) {
            TBEG(2)
            const int n = (int)cnt[wave];
            if (n > 256) { float t; const int nn = tk_compact(bufall + (size_t)wave * TK_C, hist, n, lane, t); if (lane == 0) { cnt[wave] = (unsigned)nn; thrs[wave] = t; } }
            __builtin_amdgcn_sched_barrier(0);
            LOADQ(); LOADB(bn, rd + 1);
            LDS_BARRIER();
            TEND(2)
        }
        if (rd + 1 < rounds) {
        LOADB(bf, rd + 2);
#pragma unroll
        for (int rr = 0; rr < 2; ++rr) {
            const int kt = (rd + 1) * 16 + rr * 8 + wave;
            if (kt < nkt) {
                const int key = kt * 32 + l31; const bool kvalid = key < U.nk;
#pragma unroll
                for (int mt = 0; mt < 2; ++mt) {
                    f32x16 cc;
#pragma unroll
                    for (int r = 0; r < 16; ++r) cc[r] = 0.f;
#pragma unroll
                    for (int ks = 0; ks < 4; ++ks) cc = __builtin_amdgcn_mfma_f32_32x32x16_f16(qalds[(mt * 4 + ks) * 64 + lane], bn[rr][ks], cc, 0, 0, 0);
                    float sv[2]; bool ps[2];
                    const f32x2 thp = *(const f32x2*)(thrs + mt * 4 + 2 * half);
#pragma unroll
                    for (int e = 0; e < 2; ++e) {
                        f32x2 s2 = (f32x2){0.f, 0.f};
#pragma unroll
                        for (int h = 0; h < 4; ++h) {
                            const f32x2 r2 = (f32x2){__int_as_float(max(__float_as_int(cc[e * 8 + 2 * h]), 0)), __int_as_float(max(__float_as_int(cc[e * 8 + 2 * h + 1]), 0))};
                            s2 = __builtin_elementwise_fma(r2, wq[mt][e][h], s2);
                        }
                        const float s = s2.x + s2.y;
                        sv[e] = s; ps[e] = kvalid && (s > thp[e]);
                    }
                    const u64 bm0 = __ballot(ps[0]), bm1 = __ballot(ps[1]);
                    if (bm0 | bm1) {
                        const int ql = lane - mt * 4;
                        unsigned myc = 0u;
                        myc = (ql == 0) ? (unsigned)__popc((unsigned)bm0) : myc;
                        myc = (ql == 1) ? (unsigned)__popc((unsigned)bm1) : myc;
                        myc = (ql == 2) ? (unsigned)__popc((unsigned)(bm0 >> 32)) : myc;
                        myc = (ql == 3) ? (unsigned)__popc((unsigned)(bm1 >> 32)) : myc;
                        unsigned basev = 0u;
                        if ((unsigned)ql < 4u && myc) basev = atomicAdd(cnt + lane, myc);
                        const unsigned b00 = __builtin_amdgcn_readlane(basev, mt * 4), b01 = __builtin_amdgcn_readlane(basev, mt * 4 + 1);
                        const unsigned b10 = __builtin_amdgcn_readlane(basev, mt * 4 + 2), b11 = __builtin_amdgcn_readlane(basev, mt * 4 + 3);
                        const unsigned ltm = (1u << l31) - 1u;
                        if (ps[0]) { const unsigned hm = half ? (unsigned)(bm0 >> 32) : (unsigned)bm0; const unsigned pos = (half ? b10 : b00) + (unsigned)__popc(hm & ltm);
                            bufall[(size_t)(mt * 4 + 2 * half) * TK_C + pos] = ((u64)fkey(sv[0]) << 32) | (u64)(~(unsigned)key); }
                        if (ps[1]) { const unsigned hm = half ? (unsigned)(bm1 >> 32) : (unsigned)bm1; const unsigned pos = (half ? b11 : b01) + (unsigned)__popc(hm & ltm);
                            bufall[(size_t)(mt * 4 + 2 * half + 1) * TK_C + pos] = ((u64)fkey(sv[1]) << 32) | (u64)(~(unsigned)key); }
                    }
                }
            }
        }
        { TBEG(6)
        LDS_BARRIER();
        TEND(6) }
        bool need;
        { const u32x4 c0_ = *(const u32x4*)cnt, c1_ = *(const u32x4*)(cnt + 4); const unsigned m_ = max(max(max(c0_.x, c0_.y), max(c0_.z, c0_.w)), max(max(c1_.x, c1_.y), max(c1_.z, c1_.w))); need = m_ > (unsigned)TK_TRIG; }
        { TBEG(6)
        LDS_BARRIER();
        TEND(6) }
        if (need && (rd + 1) + 1 < rounds) {
            TBEG(2)
            const int n = (int)cnt[wave];
            if (n > 256) { float t; const int nn = tk_compact(bufall + (size_t)wave * TK_C, hist, n, lane, t); if (lane == 0) { cnt[wave] = (unsigned)nn; thrs[wave] = t; } }
            __builtin_amdgcn_sched_barrier(0);
            LOADQ(); LOADB(bf, rd + 2);
            LDS_BARRIER();
            TEND(2)
        }
        }
    }
#undef LOADB
#undef LOADQ
    TEND(1)
    }
    u64* buf = bufall + (size_t)wave * TK_C;
    TBEG(3)
    int n = (int)cnt[wave];
    if (n > 256) { float t; n = tk_compact(buf, hist, n, lane, t); }
    TEND(3)
    const int qrow = U.qrow0 + wave;
    int lane_o = lane; asm volatile("" : "+v"(lane_o));
    for (int repa_ = 0; repa_ < REP_ATT; ++repa_) {
    TBEG(4)
    float* P = (float*)((unsigned char*)buf + 4096);
    {
        const int fr = lane_o & 15, fq = lane_o >> 4;
        h16x8 qf[2];
#pragma unroll
        for (int ks = 0; ks < 2; ++ks) {
            if (fr < 8) qf[ks] = *(const h16x8*)(PROJ + (size_t)qrow * NPJ + C_Q + fr * 64 + ks * 32 + fq * 8);
            else {
#pragma unroll
                for (int j = 0; j < 8; ++j) qf[ks][j] = (h16)0.f; }
        }
        long q8[2];
#pragma unroll
        for (int ks = 0; ks < 2; ++ks) { f32x4 f0_, f1_;
#pragma unroll
            for (int j = 0; j < 4; ++j) { f0_[j] = (float)qf[ks][j]; f1_[j] = (float)qf[ks][4 + j]; }
            q8[ks] = (long)pack8_fp8(f0_, f1_); }
        h16x8 zero8;
#pragma unroll
        for (int j = 0; j < 8; ++j) zero8[j] = (h16)0.f;
        u32x4 ka[8], kb[8];
#define ISSUEK4(dst, g) do { _Pragma("unroll") for (int tt = 0; tt < 2; ++tt) { const int s_ = ((g) * 2 + tt) * 16 + fr; const unsigned idx_ = (s_ < n) ? ~(unsigned)buf[s_] : 0u; \
        const unsigned char* kr_ = U.kvb + (size_t)(U.krow0 + (int)idx_) * 512 + fq * 16; \
        _Pragma("unroll") for (int j = 0; j < 4; ++j) dst[tt * 4 + j] = *(const u32x4*)(kr_ + j * 64); } } while (0)
#define COMPK4(src, g) do { _Pragma("unroll") for (int tt = 0; tt < 2; ++tt) { f32x4 c_ = (f32x4){0.f, 0.f, 0.f, 0.f}; \
        _Pragma("unroll") for (int j = 0; j < 4; ++j) { const u32x4 w_ = src[tt * 4 + j]; \
            const long a0_ = ((fr >> 1) == j) ? q8[0] : 0l, a1_ = ((fr >> 1) == j) ? q8[1] : 0l; \
            c_ = __builtin_amdgcn_mfma_f32_16x16x32_fp8_fp8(a0_, (long)((u64)w_.x | ((u64)w_.y << 32)), c_, 0, 0, 0); \
            c_ = __builtin_amdgcn_mfma_f32_16x16x32_fp8_fp8(a1_, (long)((u64)w_.z | ((u64)w_.w << 32)), c_, 0, 0, 0); } \
        const int s_ = ((g) * 2 + tt) * 16 + fr; const bool v_ = s_ < n; \
        _Pragma("unroll") for (int r = 0; r < 4; ++r) c_[r] = v_ ? c_[r] * 0.125f : -1e30f; \
        if (fq < 2) *(f32x4*)(P + s_ * 8 + fq * 4) = c_; } } while (0)
        ISSUEK4(ka, 0);
#pragma unroll 1
        for (int g = 0; g < 8; g += 2) {
            ISSUEK4(kb, g + 1);
            COMPK4(ka, g);
            ISSUEK4(ka, g + 2);
            COMPK4(kb, g + 1);
        }
#undef ISSUEK4
#undef COMPK4
        __builtin_amdgcn_s_waitcnt(0); asm volatile("" ::: "memory");
        f32x4 acc[16];
#pragma unroll
        for (int t = 0; t < 16; ++t) acc[t] = *(const f32x4*)(P + (t * 16 + fr) * 8 + (fq & 1) * 4);
        float mx[4] = {-1e30f, -1e30f, -1e30f, -1e30f};
#pragma unroll
        for (int t = 0; t < 16; ++t) { const bool v = (t * 16 + fr) < n;
#pragma unroll
            for (int r = 0; r < 4; ++r) { mx[r] = fmaxf(mx[r], acc[t][r]); } }
#pragma unroll
        for (int r = 0; r < 4; ++r) {
#pragma unroll
            for (int o = 1; o < 16; o <<= 1) mx[r] = fmaxf(mx[r], __shfl_xor(mx[r], o)); }
        float sm[4] = {0.f, 0.f, 0.f, 0.f};
#pragma unroll
        for (int t = 0; t < 16; ++t) { const bool v = (t * 16 + fr) < n;
#pragma unroll
            for (int r = 0; r < 4; ++r) { const float e = v ? __expf(acc[t][r] - mx[r]) : 0.f; acc[t][r] = e; sm[r] += e; } }
#pragma unroll
        for (int r = 0; r < 4; ++r) {
#pragma unroll
            for (int o = 1; o < 16; o <<= 1) sm[r] += __shfl_xor(sm[r], o); }
        __builtin_amdgcn_s_waitcnt(0); asm volatile("" ::: "memory");
        if (fq < 2) {
#pragma unroll
            for (int t = 0; t < 16; ++t) *(f32x4*)(P + (t * 16 + fr) * 8 + fq * 4) = acc[t];
            if (fr == 0) {
#pragma unroll
                for (int r = 0; r < 4; ++r) sums[fq * 4 + r] = sm[r]; }
        }
        __builtin_amdgcn_s_waitcnt(0); asm volatile("" ::: "memory");
    }
    TEND(4)
    TBEG(5)
    {
        const int sg = lane_o >> 4, part = lane_o & 15, kv = part >> 2, d0 = (part & 3) * 16;
        f32x2 o0[8], o1[8];
#pragma unroll
        for (int j = 0; j < 8; ++j) { o0[j] = (f32x2){0.f, 0.f}; o1[j] = (f32x2){0.f, 0.f}; }
        u32x4 va[8], vb[8];
        const unsigned char* vbase = U.kvb + 256 + kv * 64 + d0;
#define ISSUEV16(dst, gi) do { _Pragma("unroll") for (int ii = 0; ii < 8; ++ii) { const int s_ = 4 * ((gi) * 8 + ii) + sg; const unsigned idx_ = (s_ < n) ? ~(unsigned)buf[s_] : 0u; \
        dst[ii] = *(const u32x4*)(vbase + (size_t)(U.krow0 + (int)idx_) * 512); } } while (0)
#define COMPV16(src, gi) do { _Pragma("unroll") for (int ii = 0; ii < 8; ++ii) { const int s_ = 4 * ((gi) * 8 + ii) + sg; const f32x2 pp = *(const f32x2*)(P + (s_ & 255) * 8 + 2 * kv); const f32x2 px_ = (f32x2){pp.x, pp.x}, py_ = (f32x2){pp.y, pp.y}; const u32x4 w_ = src[ii]; \
        _Pragma("unroll") for (int q_ = 0; q_ < 4; ++q_) { const int ww_ = (int)w_[q_]; \
            const f32x2 xa_ = __builtin_amdgcn_cvt_pk_f32_fp8(ww_, false), xb_ = __builtin_amdgcn_cvt_pk_f32_fp8(ww_, true); \
            o0[q_ * 2] = __builtin_elementwise_fma(xa_, px_, o0[q_ * 2]); o0[q_ * 2 + 1] = __builtin_elementwise_fma(xb_, px_, o0[q_ * 2 + 1]); \
            o1[q_ * 2] = __builtin_elementwise_fma(xa_, py_, o1[q_ * 2]); o1[q_ * 2 + 1] = __builtin_elementwise_fma(xb_, py_, o1[q_ * 2 + 1]); } } } while (0)
        ISSUEV16(va, 0);
#pragma unroll 1
        for (int gi = 0; gi < 8; gi += 2) {
            ISSUEV16(vb, gi + 1);
            COMPV16(va, gi);
            ISSUEV16(va, gi + 2);
            COMPV16(vb, gi + 1);
        }
#undef ISSUEV16
#undef COMPV16
#pragma unroll
        for (int j = 0; j < 8; ++j) { o0[j].x += __shfl_xor(o0[j].x, 16); o0[j].x += __shfl_xor(o0[j].x, 32); o0[j].y += __shfl_xor(o0[j].y, 16); o0[j].y += __shfl_xor(o0[j].y, 32);
            o1[j].x += __shfl_xor(o1[j].x, 16); o1[j].x += __shfl_xor(o1[j].x, 32); o1[j].y += __shfl_xor(o1[j].y, 16); o1[j].y += __shfl_xor(o1[j].y, 32); }
        if (sg == 0) {
            const float i0 = 1.f / sums[2 * kv], i1 = 1.f / sums[2 * kv + 1];
            const h16* pz = PROJ + (size_t)qrow * NPJ + C_ZB + (2 * kv) * 64 + d0;
            h16* po = (h16*)(p.ws + WS_BOUT) + (size_t)qrow * 512 + (2 * kv) * 64 + d0;
#pragma unroll
            for (int hh = 0; hh < 2; ++hh) {
                const h16x8 za = *(const h16x8*)(pz + hh * 64), zb = *(const h16x8*)(pz + hh * 64 + 8);
                h16x8 ra, rb;
#pragma unroll
                for (int j = 0; j < 8; ++j) { const float oa = hh ? o1[j >> 1][j & 1] : o0[j >> 1][j & 1], ob = hh ? o1[4 + (j >> 1)][j & 1] : o0[4 + (j >> 1)][j & 1]; const float ii = hh ? i1 : i0;
                    ra[j] = (h16)(oa * ii * siluf_((float)za[j])); rb[j] = (h16)(ob * ii * siluf_((float)zb[j])); }
                *(h16x8*)(po + hh * 64) = ra; *(h16x8*)(po + hh * 64 + 8) = rb;
            }
        }
    }
    TEND(5)
    }
    __syncthreads();
}

__global__ void __launch_bounds__(512, 2) mk_fwd(Params p) {
    __builtin_assume(__builtin_amdgcn_workitem_id_y() == 0); __builtin_assume(__builtin_amdgcn_workitem_id_z() == 0);
    extern __shared__ __attribute__((aligned(16))) unsigned char lds[];
    cg::grid_group grid = cg::this_grid();
    const int wave = __builtin_amdgcn_readfirstlane((int)threadIdx.x >> 6);
    const int G = gridDim.x, bx = blockIdx.x;
    const int gw = bx * 8 + wave, NGW = G * 8;
    const int lo = p.ph_lo, hi = p.ph_hi;
    unsigned long long tacc = 0;
#define IN(k) (lo <= (k) && (k) < hi)
#define SEAM(k) do { if (IN(k) && IN((k) + 1)) grid.sync(); } while (0)
    h16* XH = (h16*)(p.ws + WS_XH); h16* PROJ = (h16*)(p.ws + WS_PROJ);
    h16* WIN = (h16*)(p.ws + WS_WIN); h16* WPA = (h16*)(p.ws + WS_WPA); h16* WPB = (h16*)(p.ws + WS_WPB); h16* WOUT = (h16*)(p.ws + WS_WOUT);
    h16* WSM = (h16*)(p.ws + WS_WSM); h16* KVS = (h16*)(p.ws + WS_KVS); h16* KIS = (h16*)(p.ws + WS_KIS);
    float* RSTD = (float*)(p.ws + WS_RSTD); float* ROWSS = (float*)(p.ws + WS_ROWSS);

    if (IN(0)) for (int rep_ = 0; rep_ < REP_P0; ++rep_) {
        const int lane = lane_id(), tid = wave * 64 + lane;
        float* scr = (float*)(lds + wave * 16384);
        constexpr int I_IN = 16 * (NPJ / 32), I_PA = 8 * 32, I_PB = 8 * 32, I_OUT = 16 * 32;
        for (int it = gw; it < I_IN + I_PA + I_PB + I_OUT; it += NGW) {
            int r = it;
            if (r < I_IN) { p0_tr_item(p.w_in, 1024, INW, WIN, p.norm_g, 1, scr, r, NPJ / 32, lane); continue; } r -= I_IN;
            if (r < I_PA) { p0_tr_item(p.w_pa, 512, 1024, WPA, nullptr, 0, scr, r, 32, lane); continue; } r -= I_PA;
            if (r < I_PB) { p0_tr_item(p.w_pb, 512, 1024, WPB, nullptr, 0, scr, r, 32, lane); continue; } r -= I_PB;
            p0_tr_item(p.w_out, 1024, 1024, WOUT, nullptr, 0, scr, r, 32, lane);
        }
        for (int m = gw; m < MT; m += NGW) {
            u64* o8 = (u64*)(XH + (size_t)m * DM) + lane;
            if (m < MROWS) {
                const float* xr = (m < MP) ? p.xp + (size_t)m * DM : p.xs + (size_t)(m - MP) * DM;
                const f32x4* x4 = (const f32x4*)xr + lane;
                f32x4 v[4]; float s = 0.f;
#pragma unroll
                for (int j = 0; j < 4; ++j) { v[j] = x4[64 * j]; s += (v[j].x * v[j].x + v[j].y * v[j].y) + (v[j].z * v[j].z + v[j].w * v[j].w); }
                s = wave_sum(s);
                if (lane == 0) RSTD[m] = rsqrtf(s * (1.f / 1024.f) + 1e-6f);
#pragma unroll
                for (int j = 0; j < 4; ++j) { h16x4 h; h[0] = (h16)v[j].x; h[1] = (h16)v[j].y; h[2] = (h16)v[j].z; h[3] = (h16)v[j].w; o8[64 * j] = __builtin_bit_cast(u64, h); }
            } else {
                if (lane == 0) RSTD[m] = 0.f;
#pragma unroll
                for (int j = 0; j < 4; ++j) o8[64 * j] = 0ull;
            }
        }
        const int gt = bx * 512 + tid, NGT = G * 512;
        for (int i = gt; i < NB * NKSP * 64; i += NGT) {
            const int c8 = (i & 63) * 8, r = (i >> 6) % NKSP, b = (i >> 6) / NKSP;
            if (r >= PAST && r < NKS) continue;
            f32x4 f0 = (f32x4){0.f, 0.f, 0.f, 0.f}, f1 = f0;
            if (r < PAST) { const float* src = (c8 < 256) ? p.ck + ((size_t)b * PAST + r) * 256 + c8 : p.cv + ((size_t)b * PAST + r) * 256 + (c8 - 256);
                f0 = *(const f32x4*)src; f1 = *(const f32x4*)(src + 4); }
            *(u64*)((unsigned char*)KVS + ((size_t)b * NKSP + r) * 512 + kvpos(c8)) = pack8_fp8(f0, f1);
        }
        for (int i = gt; i < NB * NKSP * 8; i += NGT) {
            const int c8 = (i & 7) * 8, r = (i >> 3) % NKSP, b = (i >> 3) / NKSP;
            if (r >= PAST && r < NKS) continue;
            h16x8 h;
            if (r < PAST) { const float* src = p.cki + ((size_t)b * PAST + r) * 64 + c8;
#pragma unroll
                for (int j = 0; j < 8; ++j) h[j] = (h16)src[j]; }
            else {
#pragma unroll
                for (int j = 0; j < 8; ++j) h[j] = (h16)0.f; }
            *(h16x8*)(KIS + ((size_t)b * NKSP + r) * 64 + c8) = h;
        }
        for (int i = gt; i < 8 * 128 * 128; i += NGT) { const int j = i & 127, ii = (i >> 7) & 127; WSM[i] = ((j >> 6) <= (ii >> 6)) ? (h16)p.sgu_w[i] : (h16)0.f; }
    }
    SEAM(0);
    if (IN(1)) for (int rep_ = 0; rep_ < REP_P1; ++rep_) {
        pg8::Gemm g{XH, WIN, MT, NPJ, 1024, 1024}; pg8::StaticOrder S; S.init(MT, NPJ, G, bx);
        EpiProj E{PROJ, RSTD, p.out, (unsigned char*)KVS, KIS, (unsigned char*)(p.ws + WS_KVC), (h16*)(p.ws + WS_KIC)};
        pg8::gemm_phase<EpiProj>((LAS unsigned char*)lds, g, S, E);
    }
    SEAM(1);
    if (IN(2)) for (int rep_ = 0; rep_ < REP_P2; ++rep_) {
        for (int u = bx; u < 512 + NB; u += G) { const int lane = lane_id(); if (u < 512) sgu_chunk(p, lds, u, wave, lane); else sgu_sample(p, lds, u - 512, wave, lane); }
    }
    if (IN(3)) for (int rep_ = 0; rep_ < REP_P3; ++rep_) {
        for (int u = bx; u < 8192 + 16; u += G) {
            AUnit U;
            if (u < 8192) { const int i = u >> 8, gp = u & 255, b = gp & 7, s = gp >> 3; const int jt = s + 32 * i;
                U.qrow0 = b * SEQ + jt * 8; U.krow0 = b * SEQ; U.nk = ((jt * 8) / 64 + 1) * 64; U.kib = (const h16*)(p.ws + WS_KIC); U.kis = 64; U.kvb = (const unsigned char*)(p.ws + WS_KVC); U.kvs = 512; }
            else { const int v = u - 8192, b = v >> 1, hf = v & 1;
                U.qrow0 = MP + b * 16 + hf * 8; U.krow0 = b * NKSP; U.nk = NKS; U.kib = KIS; U.kis = 64; U.kvb = (const unsigned char*)KVS; U.kvs = 512; }
            attn_unit(p, lds, U, wave, lane_id(), tacc);
        }
    }
    SEAM(3);
    if (IN(4)) for (int rep_ = 0; rep_ < REP_P4; ++rep_) {
        { pg8::Gemm g{(const h16*)(p.ws + WS_AOUT), WPA, MT, 1024, 512, 512}; pg8::StaticOrder S; S.init(MT, 1024, G, bx); EpiGate<1> E{PROJ}; pg8::gemm_phase<EpiGate<1>>((LAS unsigned char*)lds, g, S, E); }
        { pg8::Gemm g{(const h16*)(p.ws + WS_BOUT), WPB, MT, 1024, 512, 512}; pg8::StaticOrder S; S.init(MT, 1024, G, bx); EpiGate<0> E{PROJ}; pg8::gemm_phase<EpiGate<0>>((LAS unsigned char*)lds, g, S, E); }
    }
    SEAM(4);
    if (IN(5)) for (int rep_ = 0; rep_ < REP_P5; ++rep_) {
        pg8::Gemm g{PROJ + C_M, WOUT, MT, 1024, 1024, NPJ}; pg8::StaticOrder S; S.init(MT, 1024, G, bx);
        EpiOut E{p.xp, p.xs, p.out, ROWSS};
        pg8::gemm_phase<EpiOut>((LAS unsigned char*)lds, g, S, E);
    }
    SEAM(5);
    if (IN(6)) {
        const int lane = lane_id();
        for (int m = gw; m < MROWS; m += NGW) {
            float* yr = (m < MP) ? p.out + O_YP + (size_t)m * DM : p.out + O_YS + (size_t)(m - MP) * DM;
            float ssum = (lane < 16) ? ROWSS[(size_t)m * 16 + lane] : 0.f; ssum = wave_sum(ssum);
            const float r = rsqrtf(ssum * (1.f / 1024.f) + 1e-6f);
            const int lane6 = lane;
            f32x4* y4 = (f32x4*)yr + lane6; const f32x4* g4 = (const f32x4*)p.final_g + lane6;
#pragma unroll
            for (int j = 0; j < 4; ++j) { f32x4 v = y4[64 * j]; const f32x4 gg = g4[64 * j]; v = v * r * gg; y4[64 * j] = v; }
        }
    }
    if (TSEL != 0 && bx == 0 && threadIdx.x == 0) { const unsigned long long t0 = rt_(); while (rt_() - t0 < tacc) __builtin_amdgcn_s_sleep(8); }
#undef IN
#undef SEAM
}

extern "C" void kernel_launch(void* const* d_in, const int* in_sizes, int n_in, void* d_out, int out_size, void* d_ws, size_t ws_size, hipStream_t stream) {
    static int grid_blocks = 0;
    if (grid_blocks == 0) {
        if (ws_size < WS_END) { fprintf(stderr, "kernel_launch: workspace too small: %zu < %zu\n", ws_size, (size_t)WS_END); grid_blocks = -1; return; }
        int dev = 0, cus = 0, per_cu = 0;
        hipGetDevice(&dev);
        hipDeviceGetAttribute(&cus, hipDeviceAttributeMultiprocessorCount, dev);
        hipFuncSetAttribute((const void*)mk_fwd, hipFuncAttributeMaxDynamicSharedMemorySize, LDS_BYTES);
        hipOccupancyMaxActiveBlocksPerMultiprocessor(&per_cu, (const void*)mk_fwd, 512, LDS_BYTES);
        if (per_cu < 1) { fprintf(stderr, "kernel_launch: occupancy query says %d blocks per CU\n", per_cu); per_cu = 1; }
        grid_blocks = cus * per_cu;
        (void)hipGetLastError();
    }
    if (grid_blocks < 0) return;
    Params p{};
    p.xp = (const float*)d_in[0]; p.xs = (const float*)d_in[1]; p.ck = (const float*)d_in[2]; p.cv = (const float*)d_in[3]; p.cki = (const float*)d_in[4];
    p.norm_g = (const float*)d_in[5]; p.w_in = (const float*)d_in[6]; p.ln_g = (const float*)d_in[7]; p.ln_b = (const float*)d_in[8];
    p.sgu_w = (const float*)d_in[9]; p.sgu_b = (const float*)d_in[10]; p.w_pa = (const float*)d_in[11]; p.w_pb = (const float*)d_in[12];
    p.w_out = (const float*)d_in[13]; p.final_g = (const float*)d_in[14];
    p.out = (float*)d_out; p.ws = (unsigned char*)d_ws; p.ph_lo = 0; p.ph_hi = 7;
    void* args[] = {&p};
    hipError_t e = hipLaunchCooperativeKernel((const void*)mk_fwd, dim3(grid_blocks), dim3(512), args, LDS_BYTES, stream);
    if (e != hipSuccess) fprintf(stderr, "cooperative launch failed: %s (grid %d)\n", hipGetErrorString(e), grid_blocks);
}
```

```cpp
#include <hip/hip_runtime.h>
#include <hip/hip_cooperative_groups.h>
#include <cstdio>
#include <cstdint>
namespace cg = cooperative_groups;
#define REP_P0 1
#define REP_P1 1
#define REP_P2 1
#define REP_P3 1
#define REP_IDX 1
#define REP_ATT 1
#define TSEL 0
#define LDS_BARRIER() do { asm volatile("s_waitcnt lgkmcnt(0)" ::: "memory"); __builtin_amdgcn_s_barrier(); asm volatile("" ::: "memory"); } while (0)
__device__ __forceinline__ unsigned long long rt_() { return __builtin_amdgcn_s_memrealtime(); }
#define TBEG(k) unsigned long long tb_##k = 0; if (TSEL == (k)) tb_##k = rt_();
#define TEND(k) if (TSEL == (k)) tacc += rt_() - tb_##k;
#define REP_P4 1
#define REP_P5 1

#define LAS __attribute__((address_space(3)))
typedef _Float16 h16;
typedef _Float16 h16x8 __attribute__((ext_vector_type(8)));
typedef _Float16 h16x4 __attribute__((ext_vector_type(4)));
typedef _Float16 h16x2 __attribute__((ext_vector_type(2)));
typedef float f32x2 __attribute__((ext_vector_type(2)));
typedef float f32x4 __attribute__((ext_vector_type(4)));
typedef float f32x16 __attribute__((ext_vector_type(16)));
typedef unsigned u32x4 __attribute__((ext_vector_type(4)));
typedef unsigned u32x2 __attribute__((ext_vector_type(2)));
typedef unsigned long long u64;

constexpr int DM = 1024, SEQ = 8192, NB = 8, MP = NB * SEQ;
constexpr int DSQ = 16, MS = NB * DSQ, PAST = 1024, NKS = PAST + DSQ, NKSP = 1056;
constexpr int MROWS = MP + MS;
constexpr int MT = MP + 256;
constexpr int INW = 5704, NPJ = 5888;
constexpr int C_U = 0, C_V = 512, C_ZA = 1024, C_Q = 1536, C_K = 2048, C_VV = 2304, C_ZB = 2560, C_QI = 3072, C_KI = 3584, C_WI = 3648, C_GA = 3840, C_GB = 4864;
constexpr size_t O_YP = 0, O_YS = 67108864, O_PK = 67239936, O_PV = 84017152, O_PKI = 100794368, O_SK = 104988672, O_SV = 105021440, O_SKI = 105054208, O_SSV = 105062400;
constexpr size_t WS_XH = 0;
constexpr size_t WS_PROJ = WS_XH + (size_t)MT * DM * 2;
constexpr size_t WS_WIN = WS_PROJ + (size_t)MT * NPJ * 2;
constexpr size_t WS_WPA = WS_WIN + (size_t)NPJ * DM * 2;
constexpr size_t WS_WPB = WS_WPA + (size_t)1024 * 512 * 2;
constexpr size_t WS_WOUT = WS_WPB + (size_t)1024 * 512 * 2;
constexpr size_t WS_WSM = WS_WOUT + (size_t)1024 * 1024 * 2;
constexpr size_t WS_KVS = WS_WSM + (size_t)8 * 128 * 128 * 2;
constexpr size_t WS_KIS = WS_KVS + (size_t)NB * NKSP * 512 * 2;
constexpr size_t WS_RSTD = WS_KIS + (size_t)NB * NKSP * 64 * 2;
constexpr size_t WS_ROWSS = WS_RSTD + (size_t)MT * 4;
constexpr size_t WS_KIC = WS_ROWSS + (size_t)MT * 16 * 4;
constexpr size_t WS_KVC = WS_KIC + (size_t)MP * 64 * 2;
constexpr size_t WS_END = WS_KVC + (size_t)MP * 512 * 2;
constexpr size_t WS_AOUT = WS_XH, WS_BOUT = WS_XH + (size_t)MT * 512 * 2;
constexpr int C_T = 0, C_M = 1024;
constexpr int LDS_BYTES = 155648;

__device__ __forceinline__ float sigmoidf_(float x) { return 1.f / (1.f + __expf(-x)); }
__device__ __forceinline__ float siluf_(float x) { return x / (1.f + __expf(-x)); }
__device__ __forceinline__ float geluf_(float x) { const float t = 1.5957691216057308f * (x + 0.044715f * x * x * x); return x / (1.f + __expf(-t)); }
__device__ __forceinline__ int lane_id() { int l; asm volatile("v_mbcnt_lo_u32_b32 %0, -1, 0\n\tv_mbcnt_hi_u32_b32 %0, -1, %0" : "=v"(l)); return l; }
__device__ __forceinline__ float wave_sum(float v) {
#pragma unroll
    for (int o = 1; o < 64; o <<= 1) v += __shfl_xor(v, o);
    return v;
}

namespace pg8 {
constexpr int BM = 256, BK = 64, HALF = 128, HTB = HALF * BK * 2, STAGE_BYTES = 8 * HTB, NXCD = 8, WGM = 8;
__host__ __device__ __forceinline__ int lds_byte(int r, int c) { const int st = (r >> 4) * 2 + (c >> 5), rr = r & 15, cc = c & 31, ob = rr * 64 + cc * 2; return st * 1024 + (ob ^ (((ob >> 9) & 1) << 5)); }
__host__ __device__ __forceinline__ void stage_rc(int b, int& R, int& C) { const int st = b / 1024, sb = b % 1024, swz = sb ^ (((sb >> 9) & 1) << 5); R = (st >> 1) * 16 + swz / 64; C = (st & 1) * 32 + (swz % 64) / 2; }
__host__ __device__ __forceinline__ int perm32(int rho) { const int n = rho >> 4, i = rho & 15; return 8 * (i >> 2) + 4 * n + (i & 3); }
struct Unit { int pm, pn; };
struct Gemm { const h16* A; const h16* Bt; int M, N, K, lda; };
struct StaticOrder {
    int nM, nN, nwg, G, c;
    __device__ void init(int M, int N, int G_, int c_) { nM = M / BM; nN = N / BM; nwg = nM * nN; G = G_; c = c_; }
    __device__ bool next(int i, Unit& u) const {
        const long L = (long)i * G + c; if (L >= nwg) return false;
        int wgid = (int)L; { const int q = nwg / NXCD, r = nwg % NXCD, xcd = wgid % NXCD, off = wgid / NXCD; wgid = (xcd < r ? xcd * (q + 1) : r * (q + 1) + (xcd - r) * q) + off; }
        const int nig = WGM * nN, gid = wgid / nig, fm = gid * WGM, gsz = (nM - fm) < WGM ? (nM - fm) : WGM;
        u.pm = fm + ((wgid % nig) % gsz); u.pn = (wgid % nig) / gsz; return true;
    }
};
template <class Epi>
__device__ __forceinline__ void gemm_phase(LAS unsigned char* lds, const Gemm g, const StaticOrder& S, const Epi& E) {
    const int tid = threadIdx.x, wid = __builtin_amdgcn_readfirstlane(tid >> 6), lane = tid & 63, wr = wid >> 2, wc = wid & 3, fr = lane & 15, fq = lane >> 4;
    const int K = g.K, nt = K / BK, lda = g.lda;
    unsigned voffA[2], voffB[2];
#pragma unroll
    for (int i = 0; i < 2; ++i) { int R, C; stage_rc(tid * 16 + i * 8192, R, C); const int Rb = (R & ~31) + perm32(R & 31);
        voffA[i] = (unsigned)(R * lda + C) * 2u; voffB[i] = (unsigned)(Rb * K + C) * 2u; }
    const size_t kstep = (size_t)(BK * 2);
    const size_t hstepA = (size_t)HALF * lda * 2, hstepB = (size_t)HALF * K * 2;
    const size_t tstepA = 2 * hstepA, tstepB = 2 * hstepB;
    const unsigned ldsw = (unsigned)wid * 1024u;
    const int aoff = lds_byte(wr * 64 + fr, fq * 8), boff = lds_byte(wc * 32 + fr, fq * 8);
#define PG8_SA(b, h) (((b) * 2 + (h)) * HTB)
#define PG8_SB(b, h) ((4 + (b) * 2 + (h)) * HTB)
#define PG8_STAGE(bufoff, gbase, voff) do { _Pragma("unroll") for (int _i = 0; _i < 2; ++_i) \
        __builtin_amdgcn_global_load_lds((const unsigned*)((const char*)(gbase) + (voff)[_i]), (LAS unsigned*)(lds + (bufoff) + ldsw + _i * 8192), 16, 0, 0); } while (0)
#define PG8_LDA(dst, b, h) do { _Pragma("unroll") for (int m = 0; m < 4; ++m) _Pragma("unroll") for (int k = 0; k < 2; ++k) dst[m][k] = *(const LAS h16x8*)(lds + PG8_SA(b, h) + aoff + m * 2048 + k * 1024); } while (0)
#define PG8_LDB(dst, b, h) do { _Pragma("unroll") for (int n = 0; n < 2; ++n) _Pragma("unroll") for (int k = 0; k < 2; ++k) dst[n][k] = *(const LAS h16x8*)(lds + PG8_SB(b, h) + boff + n * 2048 + k * 1024); } while (0)
#define PG8_MMA(ai, bj, At, Bt) do { __builtin_amdgcn_s_setprio(1); _Pragma("unroll") for (int m = 0; m < 4; ++m) _Pragma("unroll") for (int n = 0; n < 2; ++n) _Pragma("unroll") for (int k = 0; k < 2; ++k) \
        acc[ai][bj][m][n] = __builtin_amdgcn_mfma_f32_16x16x32_f16(Bt[n][k], At[m][k], acc[ai][bj][m][n], 0, 0, 0); __builtin_amdgcn_s_setprio(0); } while (0)
#define PG8_WAIT_V(n) asm volatile("s_waitcnt vmcnt(" #n ")" ::: "memory")
#define PG8_WAIT_L(n) asm volatile("s_waitcnt lgkmcnt(" #n ")" ::: "memory")
#define PG8_BAR __builtin_amdgcn_s_barrier()
#define PG8_SCHED __builtin_amdgcn_sched_barrier(0)
    Unit cur, nxt; int ui = 0;
    if (!S.next(0, cur)) return;
    f32x4 acc[2][2][4][2];
#pragma unroll
    for (int a = 0; a < 2; ++a)
#pragma unroll
        for (int b = 0; b < 2; ++b)
#pragma unroll
            for (int m = 0; m < 4; ++m)
#pragma unroll
                for (int n = 0; n < 2; ++n) acc[a][b][m][n] = (f32x4){0.f, 0.f, 0.f, 0.f};
    h16x8 At[4][2], B0[2][2], B1[2][2];
    const char* cA = (const char*)g.A + (size_t)cur.pm * tstepA; const char* cB = (const char*)g.Bt + (size_t)cur.pn * tstepB;
    PG8_STAGE(PG8_SB(0, 0), cB, voffB); PG8_STAGE(PG8_SB(0, 1), cB + hstepB, voffB); PG8_STAGE(PG8_SA(0, 0), cA, voffA); PG8_STAGE(PG8_SA(0, 1), cA + hstepA, voffA);
    if (wr == 1) PG8_BAR;
    PG8_WAIT_V(2); PG8_BAR;
    PG8_STAGE(PG8_SB(1, 0), cB + kstep, voffB); PG8_STAGE(PG8_SA(1, 0), cA + kstep, voffA); PG8_STAGE(PG8_SB(1, 1), cB + hstepB + kstep, voffB);
    PG8_WAIT_V(6); PG8_BAR;
    for (;;) {
        const bool has_next = S.next(ui + 1, nxt);
        const char* nA = has_next ? (const char*)g.A + (size_t)nxt.pm * tstepA : cA; const char* nB = has_next ? (const char*)g.Bt + (size_t)nxt.pn * tstepB : cB;
        for (int t = 0; t < nt; t += 2) {
            const bool last = (t == nt - 2);
            const char* a1 = cA + (size_t)(t + 1) * kstep;
            const char* a2 = last ? nA : cA + (size_t)(t + 2) * kstep; const char* b2 = last ? nB : cB + (size_t)(t + 2) * kstep;
            const char* a3 = a2 + kstep; const char* b3 = b2 + kstep;
            PG8_LDB(B0, 0, 0); PG8_LDB(B1, 0, 1); PG8_SCHED; PG8_LDA(At, 0, 0); PG8_STAGE(PG8_SA(1, 1), a1 + hstepA, voffA);
            PG8_WAIT_V(8); PG8_WAIT_L(0); PG8_BAR; PG8_MMA(0, 0, At, B0); PG8_MMA(0, 1, At, B1); PG8_BAR; PG8_SCHED;
            PG8_LDA(At, 0, 1); PG8_STAGE(PG8_SB(0, 0), b2, voffB); PG8_STAGE(PG8_SB(0, 1), b2 + hstepB, voffB); PG8_STAGE(PG8_SA(0, 0), a2, voffA);
            PG8_WAIT_V(8); PG8_WAIT_L(0); PG8_BAR; PG8_MMA(1, 0, At, B0); PG8_MMA(1, 1, At, B1); PG8_BAR; PG8_SCHED;
            PG8_LDB(B0, 1, 0); PG8_LDB(B1, 1, 1); PG8_SCHED; PG8_LDA(At, 1, 0); PG8_STAGE(PG8_SA(0, 1), a2 + hstepA, voffA);
            PG8_WAIT_V(8); PG8_WAIT_L(0); PG8_BAR; PG8_MMA(0, 0, At, B0); PG8_MMA(0, 1, At, B1); PG8_BAR; PG8_SCHED;
            PG8_LDA(At, 1, 1); PG8_STAGE(PG8_SB(1, 0), b3, voffB); PG8_STAGE(PG8_SB(1, 1), b3 + hstepB, voffB); PG8_STAGE(PG8_SA(1, 0), a3, voffA);
            PG8_WAIT_V(8); PG8_WAIT_L(0); PG8_BAR; PG8_MMA(1, 0, At, B0); PG8_MMA(1, 1, At, B1); PG8_BAR; PG8_SCHED;
        }
        if (wr == 0) PG8_BAR;
        E(acc, cur, wr, wc, fr, fq);
        if (!has_next) break;
#pragma unroll
        for (int a = 0; a < 2; ++a)
#pragma unroll
            for (int b = 0; b < 2; ++b)
#pragma unroll
                for (int m = 0; m < 4; ++m)
#pragma unroll
                    for (int n = 0; n < 2; ++n) acc[a][b][m][n] = (f32x4){0.f, 0.f, 0.f, 0.f};
        cur = nxt; cA = nA; cB = nB; ++ui;
        if (wr == 1) PG8_BAR;
    }
    PG8_WAIT_V(0);
    PG8_BAR;
#undef PG8_SA
#undef PG8_SB
#undef PG8_STAGE
#undef PG8_LDA
#undef PG8_LDB
#undef PG8_MMA
#undef PG8_WAIT_V
#undef PG8_WAIT_L
#undef PG8_BAR
#undef PG8_SCHED
}
}

__device__ __forceinline__ u64 pack8_fp8(const f32x4 a, const f32x4 b) {
    int w0 = __builtin_amdgcn_cvt_pk_fp8_f32(a[0], a[1], 0, false); w0 = __builtin_amdgcn_cvt_pk_fp8_f32(a[2], a[3], w0, true);
    int w1 = __builtin_amdgcn_cvt_pk_fp8_f32(b[0], b[1], 0, false); w1 = __builtin_amdgcn_cvt_pk_fp8_f32(b[2], b[3], w1, true);
    return (u64)(unsigned)w0 | ((u64)(unsigned)w1 << 32);
}
__device__ __forceinline__ h16x8 fp8x8_to_h16(const u64 v) {
    const int w0 = (int)(unsigned)v, w1 = (int)(unsigned)(v >> 32);
    const f32x2 a = __builtin_amdgcn_cvt_pk_f32_fp8(w0, false), b = __builtin_amdgcn_cvt_pk_f32_fp8(w0, true), c = __builtin_amdgcn_cvt_pk_f32_fp8(w1, false), d = __builtin_amdgcn_cvt_pk_f32_fp8(w1, true);
    h16x8 h; h[0] = (h16)a.x; h[1] = (h16)a.y; h[2] = (h16)b.x; h[3] = (h16)b.y; h[4] = (h16)c.x; h[5] = (h16)c.y; h[6] = (h16)d.x; h[7] = (h16)d.y;
    return h;
}
__device__ __forceinline__ int kvpos(int lc) { if (lc >= 256) return lc; const int j = lc >> 6, d = lc & 63; return j * 64 + ((d & 31) >> 3) * 16 + (d >> 5) * 8; }
__device__ __forceinline__ u32x4 pack8(const f32x4 a, const f32x4 b) {
    h16x8 h; h[0] = (h16)a[0]; h[1] = (h16)a[1]; h[2] = (h16)a[2]; h[3] = (h16)a[3]; h[4] = (h16)b[0]; h[5] = (h16)b[1]; h[6] = (h16)b[2]; h[7] = (h16)b[3];
    return __builtin_bit_cast(u32x4, h);
}

struct EpiProj {
    h16* PROJ; const float* rstd; float* dout; unsigned char* KVS; h16* KIS; unsigned char* KVC; h16* KIC;
    __device__ __forceinline__ void operator()(const f32x4 (&acc)[2][2][4][2], const pg8::Unit& u, int wr, int wc, int fr, int fq) const {
        const int row0 = u.pm * 256 + wr * 64 + fr, col0 = u.pn * 256 + wc * 32 + 8 * fq;
        const int pn = u.pn;
#pragma unroll
        for (int ai = 0; ai < 2; ++ai)
#pragma unroll
            for (int m = 0; m < 4; ++m) {
                const int row = row0 + ai * 128 + m * 16; const float rs = rstd[row];
#pragma unroll
                for (int bj = 0; bj < 2; ++bj) {
                    const int c = col0 + bj * 128;
                    const f32x4 v0 = acc[ai][bj][m][0] * rs, v1 = acc[ai][bj][m][1] * rs;
                    if (pn != 8 && pn != 9) *(u32x4*)(PROJ + (size_t)row * NPJ + c) = pack8(v0, v1);
                    if (pn == 8 || pn == 9 || (pn == 14 && c < C_KI + 64)) {
                        if (row < MP) {
                            float* o = (pn == 8) ? dout + O_PK + (size_t)row * 256 + (c - C_K) : (pn == 9) ? dout + O_PV + (size_t)row * 256 + (c - C_VV) : dout + O_PKI + (size_t)row * 64 + (c - C_KI);
                            *(f32x4*)o = v0; *(f32x4*)(o + 4) = v1;
                            if (pn == 14) *(u32x4*)(KIC + (size_t)row * 64 + (c - C_KI)) = pack8(v0, v1);
                            else *(u64*)(KVC + (size_t)row * 512 + kvpos(c - C_K)) = pack8_fp8(v0, v1);
                        } else if (row < MROWS) {
                            const int t = row - MP, b = t >> 4, s = t & 15; const size_t kr = (size_t)b * NKSP + PAST + s;
                            float* o = (pn == 8) ? dout + O_SK + (size_t)t * 256 + (c - C_K) : (pn == 9) ? dout + O_SV + (size_t)t * 256 + (c - C_VV) : dout + O_SKI + (size_t)t * 64 + (c - C_KI);
                            *(f32x4*)o = v0; *(f32x4*)(o + 4) = v1;
                            if (pn == 14) *(u32x4*)(KIS + kr * 64 + (c - C_KI)) = pack8(v0, v1);
                            else *(u64*)(KVS + kr * 512 + kvpos(c - C_K)) = pack8_fp8(v0, v1);
                        }
                    }
                }
            }
    }
};
template <int FIRST> struct EpiGate {
    h16* PROJ;
    __device__ __forceinline__ void operator()(const f32x4 (&acc)[2][2][4][2], const pg8::Unit& u, int wr, int wc, int fr, int fq) const {
        const int row0 = u.pm * 256 + wr * 64 + fr, col0 = u.pn * 256 + wc * 32 + 8 * fq;
#pragma unroll
        for (int ai = 0; ai < 2; ++ai)
#pragma unroll
            for (int m = 0; m < 4; ++m) {
                const int row = row0 + ai * 128 + m * 16;
#pragma unroll
                for (int bj = 0; bj < 2; ++bj) {
                    const int c = col0 + bj * 128;
                    h16* pm_ = PROJ + (size_t)row * NPJ + (FIRST ? C_T : C_M) + c;
                    const h16x8 gt = *(const h16x8*)(PROJ + (size_t)row * NPJ + (FIRST ? C_GA : C_GB) + c);
                    f32x4 v0, v1;
#pragma unroll
                    for (int j = 0; j < 4; ++j) { v0[j] = sigmoidf_((float)gt[j]) * acc[ai][bj][m][0][j]; v1[j] = sigmoidf_((float)gt[4 + j]) * acc[ai][bj][m][1][j]; }
                    if (!FIRST) { const h16x8 tp = *(const h16x8*)(PROJ + (size_t)row * NPJ + C_T + c);
#pragma unroll
                        for (int j = 0; j < 4; ++j) { v0[j] += (float)tp[j]; v1[j] += (float)tp[4 + j]; } }
                    *(u32x4*)pm_ = pack8(v0, v1);
                }
            }
    }
};
struct EpiOut {
    const float* xp; const float* xs; float* dout; float* rowss;
    __device__ __forceinline__ void operator()(const f32x4 (&acc)[2][2][4][2], const pg8::Unit& u, int wr, int wc, int fr, int fq) const {
        const int row0 = u.pm * 256 + wr * 64 + fr, col0 = u.pn * 256 + wc * 32 + 8 * fq;
#pragma unroll
        for (int ai = 0; ai < 2; ++ai)
#pragma unroll
            for (int m = 0; m < 4; ++m) {
                const int row = row0 + ai * 128 + m * 16;
                const bool ok = row < MROWS;
                const float* xr = (row < MP) ? xp + (size_t)row * DM : xs + (size_t)(row - MP) * DM;
                float* yr = (row < MP) ? dout + O_YP + (size_t)row * DM : dout + O_YS + (size_t)(row - MP) * DM;
                float ss = 0.f;
                if (ok) {
#pragma unroll
                    for (int bj = 0; bj < 2; ++bj) {
                        const int c = col0 + bj * 128;
                        const f32x4 x0 = *(const f32x4*)(xr + c), x1 = *(const f32x4*)(xr + c + 4);
                        const f32x4 v0 = x0 + acc[ai][bj][m][0], v1 = x1 + acc[ai][bj][m][1];
                        *(f32x4*)(yr + c) = v0; *(f32x4*)(yr + c + 4) = v1;
                        ss += v0[0] * v0[0] + v0[1] * v0[1] + v0[2] * v0[2] + v0[3] * v0[3] + v1[0] * v1[0] + v1[1] * v1[1] + v1[2] * v1[2] + v1[3] * v1[3];
                    }
                }
                ss += __shfl_xor(ss, 16); ss += __shfl_xor(ss, 32);
                if (ok && fq == 0) rowss[(size_t)row * 16 + u.pn * 4 + wc] = ss;
            }
    }
};

struct Params {
    const float *xp, *xs, *ck, *cv, *cki, *norm_g, *w_in, *ln_g, *ln_b, *sgu_w, *sgu_b, *w_pa, *w_pb, *w_out, *final_g;
    float* out; unsigned char* ws; int ph_lo, ph_hi;
};

__device__ __forceinline__ void p0_tr_item(const float* W, int K, int Nsrc, h16* WT, const float* gs, int mode, float* scr, int item, int nblk, int lane) {
    const int kb = item / nblk, nb = item % nblk, k0 = 64 * kb, n0 = 32 * nb;
    const int nn = n0 + (lane & 31);
    int src = nn; bool valid = true;
    if (mode == 1) { if (nn >= C_WI + 8 && nn < C_GA) valid = false; else if (nn >= C_GA) src = nn - (C_GA - (C_WI + 8)); }
#pragma unroll 8
    for (int i = 0; i < 32; ++i) { const int kk = 2 * i + (lane >> 5);
        float v = 0.f; if (valid) { v = W[(size_t)(k0 + kk) * Nsrc + src]; if (gs) v *= gs[k0 + kk]; }
        scr[kk * 33 + (lane & 31)] = v; }
    __builtin_amdgcn_s_waitcnt(0); asm volatile("" ::: "memory");
    const int c = lane & 7;
#pragma unroll
    for (int j = 0; j < 4; ++j) { const int n = (lane >> 3) + 8 * j; const float* s = scr + (8 * c) * 33 + n;
        h16x8 h;
#pragma unroll
        for (int q = 0; q < 8; ++q) h[q] = (h16)s[q * 33];
        *(h16x8*)(WT + (size_t)(n0 + n) * K + k0 + 8 * c) = h; }
    __builtin_amdgcn_s_waitcnt(0); asm volatile("" ::: "memory");
}

constexpr int VNT_LD = 136;
__device__ __forceinline__ void sgu_chunk(const Params& p, unsigned char* lds, int chunk, int wave, int lane) {
    h16* PROJ = (h16*)(p.ws + WS_PROJ);
    h16* vnT = (h16*)lds;
    h16* AOUT = (h16*)(p.ws + WS_AOUT);
    const h16* WSM = (const h16*)(p.ws + WS_WSM);
    {
        float lg[8], lb[8];
#pragma unroll
        for (int j = 0; j < 8; ++j) { lg[j] = p.ln_g[lane * 8 + j]; lb[j] = p.ln_b[lane * 8 + j]; }
        for (int tt = 0; tt < 16; ++tt) {
            const int tok = wave * 16 + tt; const size_t row = (size_t)chunk * 128 + tok;
            const h16x8 vv = *(const h16x8*)(PROJ + row * NPJ + C_V + lane * 8);
            float g[8]; float s = 0.f;
#pragma unroll
            for (int j = 0; j < 8; ++j) { g[j] = geluf_((float)vv[j]); s += g[j]; }
            const float mean = wave_sum(s) * (1.f / 512.f); float q = 0.f;
#pragma unroll
            for (int j = 0; j < 8; ++j) { g[j] -= mean; q += g[j] * g[j]; }
            const float rstd = rsqrtf(wave_sum(q) * (1.f / 512.f) + 1e-5f);
#pragma unroll
            for (int j = 0; j < 8; ++j) vnT[(lane * 8 + j) * VNT_LD + tok] = (h16)(g[j] * rstd * lg[j] + lb[j]);
        }
    }
    __syncthreads();
    {
        const int g = wave, fr = lane & 15, fq = lane >> 4;
        for (int it = 0; it < 8; ++it) {
            f32x4 acc[4];
#pragma unroll
            for (int dt = 0; dt < 4; ++dt) acc[dt] = (f32x4){0.f, 0.f, 0.f, 0.f};
            const int nks = (it < 4) ? 2 : 4;
            for (int ks = 0; ks < nks; ++ks) {
                const h16x8 b = *(const h16x8*)(WSM + ((size_t)g * 128 + it * 16 + fr) * 128 + ks * 32 + fq * 8);
#pragma unroll
                for (int dt = 0; dt < 4; ++dt) {
                    const h16x8 a = *(const h16x8*)(vnT + (g * 64 + dt * 16 + fr) * VNT_LD + ks * 32 + fq * 8);
                    acc[dt] = __builtin_amdgcn_mfma_f32_16x16x32_f16(a, b, acc[dt], 0, 0, 0);
                }
            }
            const int i = it * 16 + fr; const size_t row = (size_t)chunk * 128 + i;
            const float bias = p.sgu_b[g * 128 + i];
#pragma unroll
            for (int dt = 0; dt < 4; ++dt) {
                const int c = g * 64 + dt * 16 + fq * 4;
                const h16x4 uu = *(const h16x4*)(PROJ + row * NPJ + C_U + c); const h16x4 zz = *(const h16x4*)(PROJ + row * NPJ + C_ZA + c);
                h16x4 o;
#pragma unroll
                for (int r = 0; r < 4; ++r) o[r] = (h16)(geluf_((float)uu[r]) * (acc[dt][r] + bias) * siluf_((float)zz[r]));
                *(h16x4*)(AOUT + row * 512 + c) = o;
            }
        }
    }
    __syncthreads();
}
__device__ __forceinline__ void sgu_sample(const Params& p, unsigned char* lds, int b, int wave, int lane) {
    h16* PROJ = (h16*)(p.ws + WS_PROJ);
    float* vnS = (float*)lds;
    for (int tt = 0; tt < 2; ++tt) {
        const int t = wave * 2 + tt; const size_t row = (size_t)MP + b * 16 + t;
        const h16x8 vv = *(const h16x8*)(PROJ + row * NPJ + C_V + lane * 8);
        float g[8]; float s = 0.f;
#pragma unroll
        for (int j = 0; j < 8; ++j) { g[j] = geluf_((float)vv[j]); s += g[j]; }
        const float mean = wave_sum(s) * (1.f / 512.f); float q = 0.f;
#pragma unroll
        for (int j = 0; j < 8; ++j) { g[j] -= mean; q += g[j] * g[j]; }
        const float rstd = rsqrtf(wave_sum(q) * (1.f / 512.f) + 1e-5f);
#pragma unroll
        for (int j = 0; j < 8; ++j) { const int c = lane * 8 + j; const float v = g[j] * rstd * p.ln_g[c] + p.ln_b[c];
            vnS[t * 512 + c] = v; p.out[O_SSV + (size_t)(b * 16 + t) * 512 + c] = v; }
    }
    __syncthreads();
    {
        const int c = threadIdx.x, g = c >> 6;
        float vn[16];
#pragma unroll
        for (int j = 0; j < 16; ++j) vn[j] = vnS[j * 512 + c];
        for (int i = 0; i < 16; ++i) {
            float mixed = p.sgu_b[g * 128 + i];
#pragma unroll
            for (int j = 0; j < 16; ++j) mixed += p.sgu_w[((size_t)g * 128 + i) * 128 + j] * vn[j];
            const size_t row = (size_t)MP + b * 16 + i;
            const float u = (float)PROJ[row * NPJ + C_U + c], za = (float)PROJ[row * NPJ + C_ZA + c];
            ((h16*)(p.ws + WS_AOUT))[row * 512 + c] = (h16)(geluf_(u) * mixed * siluf_(za));
        }
    }
    __syncthreads();
}

constexpr int TK_C = 2048, TK_TRIG = TK_C - 512;
constexpr int L3_QA = 147456;
constexpr int L3_HIST = 131072, L3_CNT = L3_HIST + 8192, L3_THR = L3_CNT + 32, L3_SUM = L3_THR + 32;
__device__ __forceinline__ unsigned fkey(float f) { const unsigned u = __float_as_uint(f); return (u & 0x80000000u) ? ~u : (u | 0x80000000u); }
__device__ __forceinline__ float fkey_inv(unsigned k) { return __uint_as_float((k & 0x80000000u) ? (k ^ 0x80000000u) : ~k); }

template <bool ON_LO>
__device__ __forceinline__ unsigned radix_select(const u64* buf, unsigned* hist, int n, int lane, unsigned fhi, int k, int& ceq_out, int& krem_out) {
    unsigned prefix = 0, pmask = 0; int krem = k; int ceq = 0;
    for (int shift = 24; shift >= 0; shift -= 8) {
        *(u32x4*)(hist + 4 * lane) = (u32x4){0u, 0u, 0u, 0u};
        __builtin_amdgcn_s_waitcnt(0); asm volatile("" ::: "memory");
        for (int i = lane; i < n; i += 64) {
            const u64 e = buf[i]; const unsigned hi = (unsigned)(e >> 32), lo = (unsigned)e;
            const unsigned key = ON_LO ? lo : hi;
            const bool ok = (ON_LO ? (hi == fhi) : true) && ((key & pmask) == prefix);
            if (ok) atomicAdd(hist + ((key >> shift) & 255u), 1u);
        }
        __builtin_amdgcn_s_waitcnt(0); asm volatile("" ::: "memory");
        const u32x4 hv = *(const u32x4*)(hist + 4 * lane);
        const unsigned s = hv.x + hv.y + hv.z + hv.w;
        unsigned S = s;
#pragma unroll
        for (int o = 1; o < 64; o <<= 1) { const unsigned t = __shfl_down(S, o); if (lane + o < 64) S += t; }
        const bool is = (S >= (unsigned)krem) && (S - s < (unsigned)krem);
        const u64 bm = __ballot(is);
        const int L = bm ? (__ffsll((long long)bm) - 1) : 0;
        unsigned d = 0, cab = S - s, ce = 0;
        { unsigned c = S - s;
          if (c + hv.w >= (unsigned)krem) { d = 3; cab = c; ce = hv.w; }
          else { c += hv.w; if (c + hv.z >= (unsigned)krem) { d = 2; cab = c; ce = hv.z; }
          else { c += hv.z; if (c + hv.y >= (unsigned)krem) { d = 1; cab = c; ce = hv.y; }
          else { c += hv.y; d = 0; cab = c; ce = hv.x; } } } }
        d = __shfl(d, L); cab = __shfl(cab, L); ce = __shfl(ce, L);
        const unsigned digit = 4u * (unsigned)L + d;
        krem -= (int)cab; ceq = (int)ce; prefix |= digit << shift; pmask |= 255u << shift;
    }
    ceq_out = ceq; krem_out = krem;
    return prefix;
}
__device__ __forceinline__ int tk_compact(u64* buf, unsigned* hist, int n, int lane_in, float& thr) {
    int lane = lane_in; asm volatile("" : "+v"(lane));
    unsigned ehi[32];
    const unsigned* b32 = (const unsigned*)buf;
#pragma unroll
    for (int j = 0; j < 32; ++j) { ehi[j] = 0u; if (64 * j < n) { const int ic = min(lane + 64 * j, n - 1); ehi[j] = b32[2 * ic + 1]; } }
    unsigned mn = 0xFFFFFFFFu, mx = 0u;
#pragma unroll
    for (int j = 0; j < 32; ++j) { if (64 * j < n) { mn = min(mn, ehi[j]); mx = max(mx, ehi[j]); } }
#pragma unroll
    for (int o = 1; o < 64; o <<= 1) { mn = min(mn, (unsigned)__shfl_xor((int)mn, o)); mx = max(mx, (unsigned)__shfl_xor((int)mx, o)); }
    const unsigned range = mx - mn; const int sh = range ? __clz(range) : 0;
#pragma unroll
    for (int j = 0; j < 32; ++j) { const unsigned nk = (ehi[j] - mn) << sh; ehi[j] = ((lane + 64 * j) < n) ? nk : 0u; }
    const unsigned ninv = (unsigned)(((n + 63) & ~63) - n);
    unsigned prefix = 0, pmask = 0; int krem = 256; bool done = false;
    for (int shift = 24; shift >= 0 && !done; shift -= 8) {
        *(u32x4*)(hist + 4 * lane) = (u32x4){0u, 0u, 0u, 0u};
        __builtin_amdgcn_s_waitcnt(0); asm volatile("" ::: "memory");
#pragma unroll
        for (int j = 0; j < 32; ++j) { if (64 * j < n) { if ((ehi[j] & pmask) == prefix) atomicAdd(hist + ((ehi[j] >> shift) & 255u), 1u); } }
        __builtin_amdgcn_s_waitcnt(0); asm volatile("" ::: "memory");
        u32x4 hv = *(const u32x4*)(hist + 4 * lane);
        if (lane == 0 && prefix == 0u) hv.x -= ninv;
        const unsigned s = hv.x + hv.y + hv.z + hv.w;
        unsigned S = s;
#pragma unroll
        for (int o = 1; o < 64; o <<= 1) { const unsigned t = __shfl_down(S, o); if (lane + o < 64) S += t; }
        const bool is = (S >= (unsigned)krem) && (S - s < (unsigned)krem);
        const u64 bm = __ballot(is);
        const int L = bm ? (__ffsll((long long)bm) - 1) : 0;
        unsigned d = 0, cab = S - s, ce = 0;
        { unsigned c = S - s;
          if (c + hv.w >= (unsigned)krem) { d = 3; cab = c; ce = hv.w; }
          else { c += hv.w; if (c + hv.z >= (unsigned)krem) { d = 2; cab = c; ce = hv.z; }
          else { c += hv.z; if (c + hv.y >= (unsigned)krem) { d = 1; cab = c; ce = hv.y; }
          else { c += hv.y; d = 0; cab = c; ce = hv.x; } } } }
        d = __shfl(d, L); cab = __shfl(cab, L); ce = __shfl(ce, L);
        krem -= (int)cab; prefix |= (4u * (unsigned)L + d) << shift; pmask |= 255u << shift;
        if ((int)ce == krem) done = true;
    }
    unsigned tlo = 0u;
    const unsigned thi_abs = mn + ((prefix + ((1u << sh) - 1u)) >> sh);
    if (!done) { int c2, k2; tlo = radix_select<true>(buf, hist, n, lane, mn + (prefix >> sh), krem, c2, k2); }
    int outn = 0;
#pragma unroll
    for (int j = 0; j < 32; ++j) {
        if (64 * j < n) {
            const int i = lane + 64 * j; const int ic = min(i, n - 1);
            const unsigned elo_ = b32[2 * ic];
            const bool keep = (i < n) && ((ehi[j] > prefix) || ((ehi[j] & pmask) == prefix && (done || elo_ >= tlo)));
            const u64 bm = __ballot(keep);
            const int off = __builtin_amdgcn_mbcnt_hi((unsigned)(bm >> 32), __builtin_amdgcn_mbcnt_lo((unsigned)bm, 0u));
            if (keep) buf[outn + off] = ((u64)(mn + (ehi[j] >> sh)) << 32) | (u64)elo_;
            outn += __popcll(bm);
        }
    }
    __builtin_amdgcn_s_waitcnt(0); asm volatile("" ::: "memory");
    thr = fkey_inv(thi_abs - 1u);
    return outn;
}

struct AUnit { int qrow0, krow0, nk; const h16* kib; int kis; const unsigned char* kvb; int kvs; };

__device__ __forceinline__ void attn_unit(const Params& p, unsigned char* lds, const AUnit U, int wave, int lane, unsigned long long& tacc) {
    h16* PROJ = (h16*)(p.ws + WS_PROJ);
    u64* bufall = (u64*)lds;
    unsigned* hist = (unsigned*)(lds + L3_HIST) + wave * 256;
    unsigned* cnt = (unsigned*)(lds + L3_CNT);
    float* thrs = (float*)(lds + L3_THR);
    float* sums = (float*)(lds + L3_SUM) + wave * 8;
    int lane_r = lane; asm volatile("" : "+v"(lane_r));
    const int half = lane_r >> 5, l31 = lane_r & 31;
    f32x2 wq[2][2][4]; h16x8 qa[2][4];
    h16x8* qalds = (h16x8*)(lds + L3_QA);
#define LOADQA() do { _Pragma("unroll") for (int mt = 0; mt < 2; ++mt) _Pragma("unroll") for (int ks = 0; ks < 4; ++ks) qa[mt][ks] = qalds[(mt * 4 + ks) * 64 + lane_r]; } while (0)
#define LOADQ() do { _Pragma("unroll") for (int mt = 0; mt < 2; ++mt) _Pragma("unroll") for (int e = 0; e < 2; ++e) \
        { const h16x8 w8_ = *(const h16x8*)(PROJ + (size_t)(U.qrow0 + mt * 4 + 2 * half + e) * NPJ + C_WI); \
          _Pragma("unroll") for (int h = 0; h < 4; ++h) wq[mt][e][h] = (f32x2){(float)w8_[2 * h], (float)w8_[2 * h + 1]}; } } while (0)
    {
        int lane_s = lane; asm volatile("" : "+v"(lane_s)); const int l31 = lane_s & 31, half = lane_s >> 5;
        const int ql = 2 * ((l31 >> 2) & 1) + (l31 >> 4), hh = ((l31 >> 3) & 1) * 4 + (l31 & 3);
        const int mt_ = wave >> 2, ks_ = wave & 3;
        qalds[wave * 64 + lane_s] = *(const h16x8*)(PROJ + (size_t)(U.qrow0 + mt_ * 4 + ql) * NPJ + C_QI + hh * 64 + half * 8 + ks_ * 16);
    }
    __builtin_amdgcn_sched_barrier(0);
    LOADQ();
    __builtin_amdgcn_sched_barrier(0);
    for (int repi_ = 0; repi_ < REP_IDX; ++repi_) {
    __syncthreads();
    { const int t8 = lane_id(); if (wave == 0 && t8 < 8) { cnt[t8] = 0u; thrs[t8] = -__builtin_inff(); } }
    __syncthreads();
    const int nkt = (U.nk + 31) >> 5, rounds = (nkt + 15) >> 4;
    LOADQA();
    h16x8 bf[2][4], bn[2][4];
#define LOADB(dst, rdx) do { _Pragma("unroll") for (int rr = 0; rr < 2; ++rr) { const int kt_ = (rdx) * 16 + rr * 8 + wave; const int ktc_ = kt_ < nkt ? kt_ : nkt - 1; \
        const h16* kp_ = U.kib + (size_t)(U.krow0 + ktc_ * 32 + l31) * U.kis + half * 8; \
        _Pragma("unroll") for (int ks = 0; ks < 4; ++ks) dst[rr][ks] = *(const h16x8*)(kp_ + ks * 16); } } while (0)
    TBEG(1)
    LOADB(bf, 0);
#pragma unroll 1
    for (int rd = 0; rd < rounds; rd += 2) {
        LOADB(bn, rd + 1);
#pragma unroll
        for (int rr = 0; rr < 2; ++rr) {
            const int kt = (rd) * 16 + rr * 8 + wave;
            if (kt < nkt) {
                const int key = kt * 32 + l31; const bool kvalid = key < U.nk;
                f32x16 ccs[2];
#pragma unroll
                for (int r = 0; r < 16; ++r) { ccs[0][r] = 0.f; ccs[1][r] = 0.f; }
#pragma unroll
                for (int ks = 0; ks < 4; ++ks) { ccs[0] = __builtin_amdgcn_mfma_f32_32x32x16_f16(qa[0][ks], bf[rr][ks], ccs[0], 0, 0, 0); ccs[1] = __builtin_amdgcn_mfma_f32_32x32x16_f16(qa[1][ks], bf[rr][ks], ccs[1], 0, 0, 0); }
#pragma unroll
                for (int mt = 0; mt < 2; ++mt) {
                    const f32x16 cc = ccs[mt];
                    float sv[2]; bool ps[2];
                    const f32x2 thp = *(const f32x2*)(thrs + mt * 4 + 2 * half);
#pragma unroll
                    for (int e = 0; e < 2; ++e) {
                        f32x2 s2 = (f32x2){0.f, 0.f};
#pragma unroll
                        for (int h = 0; h < 4; ++h) {
                            const f32x2 r2 = (f32x2){__int_as_float(max(__float_as_int(cc[e * 8 + 2 * h]), 0)), __int_as_float(max(__float_as_int(cc[e * 8 + 2 * h + 1]), 0))};
                            s2 = __builtin_elementwise_fma(r2, wq[mt][e][h], s2);
                        }
                        const float s = s2.x + s2.y;
                        sv[e] = s; ps[e] = kvalid && (s > thp[e]);
                    }
                    const u64 bm0 = __ballot(ps[0]), bm1 = __ballot(ps[1]);
                    if (bm0 | bm1) {
                        const int ql = lane - mt * 4;
                        unsigned myc = 0u;
                        myc = (ql == 0) ? (unsigned)__popc((unsigned)bm0) : myc;
                        myc = (ql == 1) ? (unsigned)__popc((unsigned)bm1) : myc;
                        myc = (ql == 2) ? (unsigned)__popc((unsigned)(bm0 >> 32)) : myc;
                        myc = (ql == 3) ? (unsigned)__popc((unsigned)(bm1 >> 32)) : myc;
                        unsigned basev = 0u;
                        if ((unsigned)ql < 4u && myc) basev = atomicAdd(cnt + lane, myc);
                        const unsigned b00 = __builtin_amdgcn_readlane(basev, mt * 4), b01 = __builtin_amdgcn_readlane(basev, mt * 4 + 1);
                        const unsigned b10 = __builtin_amdgcn_readlane(basev, mt * 4 + 2), b11 = __builtin_amdgcn_readlane(basev, mt * 4 + 3);
                        const unsigned ltm = (1u << l31) - 1u;
                        if (ps[0]) { const unsigned hm = half ? (unsigned)(bm0 >> 32) : (unsigned)bm0; const unsigned pos = (half ? b10 : b00) + (unsigned)__popc(hm & ltm);
                            bufall[(size_t)(mt * 4 + 2 * half) * TK_C + pos] = ((u64)fkey(sv[0]) << 32) | (u64)(~(unsigned)key); }
                        if (ps[1]) { const unsigned hm = half ? (unsigned)(bm1 >> 32) : (unsigned)bm1; const unsigned pos = (half ? b11 : b01) + (unsigned)__popc(hm & ltm);
                            bufall[(size_t)(mt * 4 + 2 * half + 1) * TK_C + pos] = ((u64)fkey(sv[1]) << 32) | (u64)(~(unsigned)key); }
                    }
                }
            }
        }
        { TBEG(6)
        LDS_BARRIER();
        TEND(6) }
        bool need;
        { const u32x4 c0_ = *(const u32x4*)cnt, c1_ = *(const u32x4*)(cnt + 4); const unsigned m_ = max(max(max(c0_.x, c0_.y), max(c0_.z, c0_.w)), max(max(c1_.x, c1_.y), max(c1_.z, c1_.w))); need = m_ > (unsigned)TK_TRIG; }
        { TBEG(6)
        LDS_BARRIER();
        TEND(6) }
        if (need && (rd) + 1 < rounds) {
            TBEG(2)
            const int n = (int)cnt[wave];
            if (n > 256) { float t; const int nn = tk_compact(bufall + (size_t)wave * TK_C, hist, n, lane, t); if (lane == 0) { cnt[wave] = (unsigned)nn; thrs[wave] = t; } }
            __builtin_amdgcn_sched_barrier(0);
            LOADQ(); LOADQA(); LOADB(bn, rd + 1);
            LDS_BARRIER();
            TEND(2)
        }
        if (rd + 1 < rounds) {
        LOADB(bf, rd + 2);
#pragma unroll
        for (int rr = 0; rr < 2; ++rr) {
            const int kt = (rd + 1) * 16 + rr * 8 + wave;
            if (kt < nkt) {
                const int key = kt * 32 + l31; const bool kvalid = key < U.nk;
                f32x16 ccs[2];
#pragma unroll
                for (int r = 0; r < 16; ++r) { ccs[0][r] = 0.f; ccs[1][r] = 0.f; }
#pragma unroll
                for (int ks = 0; ks < 4; ++ks) { ccs[0] = __builtin_amdgcn_mfma_f32_32x32x16_f16(qa[0][ks], bn[rr][ks], ccs[0], 0, 0, 0); ccs[1] = __builtin_amdgcn_mfma_f32_32x32x16_f16(qa[1][ks], bn[rr][ks], ccs[1], 0, 0, 0); }
#pragma unroll
                for (int mt = 0; mt < 2; ++mt) {
                    const f32x16 cc = ccs[mt];
                    float sv[2]; bool ps[2];
                    const f32x2 thp = *(const f32x2*)(thrs + mt * 4 + 2 * half);
#pragma unroll
                    for (int e = 0; e < 2; ++e) {
                        f32x2 s2 = (f32x2){0.f, 0.f};
#pragma unroll
                        for (int h = 0; h < 4; ++h) {
                            const f32x2 r2 = (f32x2){__int_as_float(max(__float_as_int(cc[e * 8 + 2 * h]), 0)), __int_as_float(max(__float_as_int(cc[e * 8 + 2 * h + 1]), 0))};
                            s2 = __builtin_elementwise_fma(r2, wq[mt][e][h], s2);
                        }
                        const float s = s2.x + s2.y;
                        sv[e] = s; ps[e] = kvalid && (s > thp[e]);
                    }
                    const u64 bm0 = __ballot(ps[0]), bm1 = __ballot(ps[1]);
                    if (bm0 | bm1) {
                        const int ql = lane - mt * 4;
                        unsigned myc = 0u;
                        myc = (ql == 0) ? (unsigned)__popc((unsigned)bm0) : myc;
                        myc = (ql == 1) ? (unsigned)__popc((unsigned)bm1) : myc;
                        myc = (ql == 2) ? (unsigned)__popc((unsigned)(bm0 >> 32)) : myc;
                        myc = (ql == 3) ? (unsigned)__popc((unsigned)(bm1 >> 32)) : myc;
                        unsigned basev = 0u;
                        if ((unsigned)ql < 4u && myc) basev = atomicAdd(cnt + lane, myc);
                        const unsigned b00 = __builtin_amdgcn_readlane(basev, mt * 4), b01 = __builtin_amdgcn_readlane(basev, mt * 4 + 1);
                        const unsigned b10 = __builtin_amdgcn_readlane(basev, mt * 4 + 2), b11 = __builtin_amdgcn_readlane(basev, mt * 4 + 3);
                        const unsigned ltm = (1u << l31) - 1u;
                        if (ps[0]) { const unsigned hm = half ? (unsigned)(bm0 >> 32) : (unsigned)bm0; const unsigned pos = (half ? b10 : b00) + (unsigned)__popc(hm & ltm);
                            bufall[(size_t)(mt * 4 + 2 * half) * TK_C + pos] = ((u64)fkey(sv[0]) << 32) | (u64)(~(unsigned)key); }
                        if (ps[1]) { const unsigned hm = half ? (unsigned)(bm1 >> 32) : (unsigned)bm1; const unsigned pos = (half ? b11 : b01) + (unsigned)__popc(hm & ltm);
                            bufall[(size_t)(mt * 4 + 2 * half + 1) * TK_C + pos] = ((u64)fkey(sv[1]) << 32) | (u64)(~(unsigned)key); }
                    }
                }
            }
        }
        { TBEG(6)
        LDS_BARRIER();
        TEND(6) }
        bool need;
        { const u32x4 c0_ = *(const u32x4*)cnt, c1_ = *(const u32x4*)(cnt + 4); const unsigned m_ = max(max(max(c0_.x, c0_.y), max(c0_.z, c0_.w)), max(max(c1_.x, c1_.y), max(c1_.z, c1_.w))); need = m_ > (unsigned)TK_TRIG; }
        { TBEG(6)
        LDS_BARRIER();
        TEND(6) }
        if (need && (rd + 1) + 1 < rounds) {
            TBEG(2)
            const int n = (int)cnt[wave];
            if (n > 256) { float t; const int nn = tk_compact(bufall + (size_t)wave * TK_C, hist, n, lane, t); if (lane == 0) { cnt[wave] = (unsigned)nn; thrs[wave] = t; } }
            __builtin_amdgcn_sched_barrier(0);
            LOADQ(); LOADQA(); LOADB(bf, rd + 2);
            LDS_BARRIER();
            TEND(2)
        }
        }
    }
#undef LOADB
#undef LOADQ
#undef LOADQA
    TEND(1)
    }
    u64* buf = bufall + (size_t)wave * TK_C;
    TBEG(3)
    int n = (int)cnt[wave];
    if (n > 256) { float t; n = tk_compact(buf, hist, n, lane, t); }
    TEND(3)
    const int qrow = U.qrow0 + wave;
    int lane_o = lane; asm volatile("" : "+v"(lane_o));
    for (int repa_ = 0; repa_ < REP_ATT; ++repa_) {
    TBEG(4)
    float* P = (float*)((unsigned char*)buf + 4096);
    {
        const int fr = lane_o & 15, fq = lane_o >> 4;
        h16x8 qf[2];
#pragma unroll
        for (int ks = 0; ks < 2; ++ks) {
            if (fr < 8) qf[ks] = *(const h16x8*)(PROJ + (size_t)qrow * NPJ + C_Q + fr * 64 + ks * 32 + fq * 8);
            else {
#pragma unroll
                for (int j = 0; j < 8; ++j) qf[ks][j] = (h16)0.f; }
        }
        long q8[2];
#pragma unroll
        for (int ks = 0; ks < 2; ++ks) { f32x4 f0_, f1_;
#pragma unroll
            for (int j = 0; j < 4; ++j) { f0_[j] = (float)qf[ks][j]; f1_[j] = (float)qf[ks][4 + j]; }
            q8[ks] = (long)pack8_fp8(f0_, f1_); }
        h16x8 zero8;
#pragma unroll
        for (int j = 0; j < 8; ++j) zero8[j] = (h16)0.f;
        u32x4 ka[8], kb[8];
#define ISSUEK4(dst, g) do { _Pragma("unroll") for (int tt = 0; tt < 2; ++tt) { const int s_ = ((g) * 2 + tt) * 16 + fr; const unsigned idx_ = (s_ < n) ? ~(unsigned)buf[s_] : 0u; \
        const unsigned char* kr_ = U.kvb + (size_t)(U.krow0 + (int)idx_) * 512 + fq * 16; \
        _Pragma("unroll") for (int j = 0; j < 4; ++j) dst[tt * 4 + j] = *(const u32x4*)(kr_ + j * 64); } } while (0)
#define COMPK4(src, g) do { _Pragma("unroll") for (int tt = 0; tt < 2; ++tt) { f32x4 c_ = (f32x4){0.f, 0.f, 0.f, 0.f}; \
        _Pragma("unroll") for (int j = 0; j < 4; ++j) { const u32x4 w_ = src[tt * 4 + j]; \
            const long a0_ = ((fr >> 1) == j) ? q8[0] : 0l, a1_ = ((fr >> 1) == j) ? q8[1] : 0l; \
            c_ = __builtin_amdgcn_mfma_f32_16x16x32_fp8_fp8(a0_, (long)((u64)w_.x | ((u64)w_.y << 32)), c_, 0, 0, 0); \
            c_ = __builtin_amdgcn_mfma_f32_16x16x32_fp8_fp8(a1_, (long)((u64)w_.z | ((u64)w_.w << 32)), c_, 0, 0, 0); } \
        const int s_ = ((g) * 2 + tt) * 16 + fr; const bool v_ = s_ < n; \
        _Pragma("unroll") for (int r = 0; r < 4; ++r) c_[r] = v_ ? c_[r] * 0.125f : -1e30f; \
        if (fq < 2) *(f32x4*)(P + s_ * 8 + fq * 4) = c_; } } while (0)
        ISSUEK4(ka, 0);
#pragma unroll 1
        for (int g = 0; g < 8; g += 2) {
            ISSUEK4(kb, g + 1);
            COMPK4(ka, g);
            ISSUEK4(ka, g + 2);
            COMPK4(kb, g + 1);
        }
#undef ISSUEK4
#undef COMPK4
        __builtin_amdgcn_s_waitcnt(0); asm volatile("" ::: "memory");
        f32x4 acc[16];
#pragma unroll
        for (int t = 0; t < 16; ++t) acc[t] = *(const f32x4*)(P + (t * 16 + fr) * 8 + (fq & 1) * 4);
        float mx[4] = {-1e30f, -1e30f, -1e30f, -1e30f};
#pragma unroll
        for (int t = 0; t < 16; ++t) { const bool v = (t * 16 + fr) < n;
#pragma unroll
            for (int r = 0; r < 4; ++r) { mx[r] = fmaxf(mx[r], acc[t][r]); } }
#pragma unroll
        for (int r = 0; r < 4; ++r) {
#pragma unroll
            for (int o = 1; o < 16; o <<= 1) mx[r] = fmaxf(mx[r], __shfl_xor(mx[r], o)); }
        float sm[4] = {0.f, 0.f, 0.f, 0.f};
#pragma unroll
        for (int t = 0; t < 16; ++t) { const bool v = (t * 16 + fr) < n;
#pragma unroll
            for (int r = 0; r < 4; ++r) { const float e = v ? __expf(acc[t][r] - mx[r]) : 0.f; acc[t][r] = e; sm[r] += e; } }
#pragma unroll
        for (int r = 0; r < 4; ++r) {
#pragma unroll
            for (int o = 1; o < 16; o <<= 1) sm[r] += __shfl_xor(sm[r], o); }
        __builtin_amdgcn_s_waitcnt(0); asm volatile("" ::: "memory");
        if (fq < 2) {
#pragma unroll
            for (int t = 0; t < 16; ++t) *(f32x4*)(P + (t * 16 + fr) * 8 + fq * 4) = acc[t];
            if (fr == 0) {
#pragma unroll
                for (int r = 0; r < 4; ++r) sums[fq * 4 + r] = sm[r]; }
        }
        __builtin_amdgcn_s_waitcnt(0); asm volatile("" ::: "memory");
    }
    TEND(4)
    TBEG(5)
    {
        const int sg = lane_o >> 4, part = lane_o & 15, kv = part >> 2, d0 = (part & 3) * 16;
        f32x2 o0[8], o1[8];
#pragma unroll
        for (int j = 0; j < 8; ++j) { o0[j] = (f32x2){0.f, 0.f}; o1[j] = (f32x2){0.f, 0.f}; }
        u32x4 va[8], vb[8];
        const unsigned char* vbase = U.kvb + 256 + kv * 64 + d0;
#define ISSUEV16(dst, gi) do { _Pragma("unroll") for (int ii = 0; ii < 8; ++ii) { const int s_ = 4 * ((gi) * 8 + ii) + sg; const unsigned idx_ = (s_ < n) ? ~(unsigned)buf[s_] : 0u; \
        dst[ii] = *(const u32x4*)(vbase + (size_t)(U.krow0 + (int)idx_) * 512); } } while (0)
#define COMPV16(src, gi) do { _Pragma("unroll") for (int ii = 0; ii < 8; ++ii) { const int s_ = 4 * ((gi) * 8 + ii) + sg; const f32x2 pp = *(const f32x2*)(P + (s_ & 255) * 8 + 2 * kv); const f32x2 px_ = (f32x2){pp.x, pp.x}, py_ = (f32x2){pp.y, pp.y}; const u32x4 w_ = src[ii]; \
        _Pragma("unroll") for (int q_ = 0; q_ < 4; ++q_) { const int ww_ = (int)w_[q_]; \
            const f32x2 xa_ = __builtin_amdgcn_cvt_pk_f32_fp8(ww_, false), xb_ = __builtin_amdgcn_cvt_pk_f32_fp8(ww_, true); \
            o0[q_ * 2] = __builtin_elementwise_fma(xa_, px_, o0[q_ * 2]); o0[q_ * 2 + 1] = __builtin_elementwise_fma(xb_, px_, o0[q_ * 2 + 1]); \
            o1[q_ * 2] = __builtin_elementwise_fma(xa_, py_, o1[q_ * 2]); o1[q_ * 2 + 1] = __builtin_elementwise_fma(xb_, py_, o1[q_ * 2 + 1]); } } } while (0)
        ISSUEV16(va, 0);
#pragma unroll 1
        for (int gi = 0; gi < 8; gi += 2) {
            ISSUEV16(vb, gi + 1);
            COMPV16(va, gi);
            ISSUEV16(va, gi + 2);
            COMPV16(vb, gi + 1);
        }
#undef ISSUEV16
#undef COMPV16
#pragma unroll
        for (int j = 0; j < 8; ++j) { o0[j].x += __shfl_xor(o0[j].x, 16); o0[j].x += __shfl_xor(o0[j].x, 32); o0[j].y += __shfl_xor(o0[j].y, 16); o0[j].y += __shfl_xor(o0[j].y, 32);
            o1[j].x += __shfl_xor(o1[j].x, 16); o1[j].x += __shfl_xor(o1[j].x, 32); o1[j].y += __shfl_xor(o1[j].y, 16); o1[j].y += __shfl_xor(o1[j].y, 32); }
        if (sg == 0) {
            const float i0 = 1.f / sums[2 * kv], i1 = 1.f / sums[2 * kv + 1];
            const h16* pz = PROJ + (size_t)qrow * NPJ + C_ZB + (2 * kv) * 64 + d0;
            h16* po = (h16*)(p.ws + WS_BOUT) + (size_t)qrow * 512 + (2 * kv) * 64 + d0;
#pragma unroll
            for (int hh = 0; hh < 2; ++hh) {
                const h16x8 za = *(const h16x8*)(pz + hh * 64), zb = *(const h16x8*)(pz + hh * 64 + 8);
                h16x8 ra, rb;
#pragma unroll
                for (int j = 0; j < 8; ++j) { const float oa = hh ? o1[j >> 1][j & 1] : o0[j >> 1][j & 1], ob = hh ? o1[4 + (j >> 1)][j & 1] : o0[4 + (j >> 1)][j & 1]; const float ii = hh ? i1 : i0;
                    ra[j] = (h16)(oa * ii * siluf_((float)za[j])); rb[j] = (h16)(ob * ii * siluf_((float)zb[j])); }
                *(h16x8*)(po + hh * 64) = ra; *(h16x8*)(po + hh * 64 + 8) = rb;
            }
        }
    }
    TEND(5)
    }
    __syncthreads();
}

__global__ void __launch_bounds__(512, 2) mk_fwd(Params p) {
    __builtin_assume(__builtin_amdgcn_workitem_id_y() == 0); __builtin_assume(__builtin_amdgcn_workitem_id_z() == 0);
    extern __shared__ __attribute__((aligned(16))) unsigned char lds[];
    cg::grid_group grid = cg::this_grid();
    const int wave = __builtin_amdgcn_readfirstlane((int)threadIdx.x >> 6);
    const int G = gridDim.x, bx = blockIdx.x;
    const int gw = bx * 8 + wave, NGW = G * 8;
    const int lo = p.ph_lo, hi = p.ph_hi;
    unsigned long long tacc = 0;
#define IN(k) (lo <= (k) && (k) < hi)
#define SEAM(k) do { if (IN(k) && IN((k) + 1)) grid.sync(); } while (0)
    h16* XH = (h16*)(p.ws + WS_XH); h16* PROJ = (h16*)(p.ws + WS_PROJ);
    h16* WIN = (h16*)(p.ws + WS_WIN); h16* WPA = (h16*)(p.ws + WS_WPA); h16* WPB = (h16*)(p.ws + WS_WPB); h16* WOUT = (h16*)(p.ws + WS_WOUT);
    h16* WSM = (h16*)(p.ws + WS_WSM); h16* KVS = (h16*)(p.ws + WS_KVS); h16* KIS = (h16*)(p.ws + WS_KIS);
    float* RSTD = (float*)(p.ws + WS_RSTD); float* ROWSS = (float*)(p.ws + WS_ROWSS);

    if (IN(0)) for (int rep_ = 0; rep_ < REP_P0; ++rep_) {
        const int lane = lane_id(), tid = wave * 64 + lane;
        float* scr = (float*)(lds + wave * 16384);
        constexpr int I_IN = 16 * (NPJ / 32), I_PA = 8 * 32, I_PB = 8 * 32, I_OUT = 16 * 32;
        for (int it = gw; it < I_IN + I_PA + I_PB + I_OUT; it += NGW) {
            int r = it;
            if (r < I_IN) { p0_tr_item(p.w_in, 1024, INW, WIN, p.norm_g, 1, scr, r, NPJ / 32, lane); continue; } r -= I_IN;
            if (r < I_PA) { p0_tr_item(p.w_pa, 512, 1024, WPA, nullptr, 0, scr, r, 32, lane); continue; } r -= I_PA;
            if (r < I_PB) { p0_tr_item(p.w_pb, 512, 1024, WPB, nullptr, 0, scr, r, 32, lane); continue; } r -= I_PB;
            p0_tr_item(p.w_out, 1024, 1024, WOUT, nullptr, 0, scr, r, 32, lane);
        }
        for (int m = gw; m < MT; m += NGW) {
            u64* o8 = (u64*)(XH + (size_t)m * DM) + lane;
            if (m < MROWS) {
                const float* xr = (m < MP) ? p.xp + (size_t)m * DM : p.xs + (size_t)(m - MP) * DM;
                const f32x4* x4 = (const f32x4*)xr + lane;
                f32x4 v[4]; float s = 0.f;
#pragma unroll
                for (int j = 0; j < 4; ++j) { v[j] = x4[64 * j]; s += (v[j].x * v[j].x + v[j].y * v[j].y) + (v[j].z * v[j].z + v[j].w * v[j].w); }
                s = wave_sum(s);
                if (lane == 0) RSTD[m] = rsqrtf(s * (1.f / 1024.f) + 1e-6f);
#pragma unroll
                for (int j = 0; j < 4; ++j) { h16x4 h; h[0] = (h16)v[j].x; h[1] = (h16)v[j].y; h[2] = (h16)v[j].z; h[3] = (h16)v[j].w; o8[64 * j] = __builtin_bit_cast(u64, h); }
            } else {
                if (lane == 0) RSTD[m] = 0.f;
#pragma unroll
                for (int j = 0; j < 4; ++j) o8[64 * j] = 0ull;
            }
        }
        const int gt = bx * 512 + tid, NGT = G * 512;
        for (int i = gt; i < NB * NKSP * 64; i += NGT) {
            const int c8 = (i & 63) * 8, r = (i >> 6) % NKSP, b = (i >> 6) / NKSP;
            if (r >= PAST && r < NKS) continue;
            f32x4 f0 = (f32x4){0.f, 0.f, 0.f, 0.f}, f1 = f0;
            if (r < PAST) { const float* src = (c8 < 256) ? p.ck + ((size_t)b * PAST + r) * 256 + c8 : p.cv + ((size_t)b * PAST + r) * 256 + (c8 - 256);
                f0 = *(const f32x4*)src; f1 = *(const f32x4*)(src + 4); }
            *(u64*)((unsigned char*)KVS + ((size_t)b * NKSP + r) * 512 + kvpos(c8)) = pack8_fp8(f0, f1);
        }
        for (int i = gt; i < NB * NKSP * 8; i += NGT) {
            const int c8 = (i & 7) * 8, r = (i >> 3) % NKSP, b = (i >> 3) / NKSP;
            if (r >= PAST && r < NKS) continue;
            h16x8 h;
            if (r < PAST) { const float* src = p.cki + ((size_t)b * PAST + r) * 64 + c8;
#pragma unroll
                for (int j = 0; j < 8; ++j) h[j] = (h16)src[j]; }
            else {
#pragma unroll
                for (int j = 0; j < 8; ++j) h[j] = (h16)0.f; }
            *(h16x8*)(KIS + ((size_t)b * NKSP + r) * 64 + c8) = h;
        }
        for (int i = gt; i < 8 * 128 * 128; i += NGT) { const int j = i & 127, ii = (i >> 7) & 127; WSM[i] = ((j >> 6) <= (ii >> 6)) ? (h16)p.sgu_w[i] : (h16)0.f; }
    }
    SEAM(0);
    if (IN(1)) for (int rep_ = 0; rep_ < REP_P1; ++rep_) {
        pg8::Gemm g{XH, WIN, MT, NPJ, 1024, 1024}; pg8::StaticOrder S; S.init(MT, NPJ, G, bx);
        EpiProj E{PROJ, RSTD, p.out, (unsigned char*)KVS, KIS, (unsigned char*)(p.ws + WS_KVC), (h16*)(p.ws + WS_KIC)};
        pg8::gemm_phase<EpiProj>((LAS unsigned char*)lds, g, S, E);
    }
    SEAM(1);
    if (IN(2)) for (int rep_ = 0; rep_ < REP_P2; ++rep_) {
        for (int u = bx; u < 512 + NB; u += G) { const int lane = lane_id(); if (u < 512) sgu_chunk(p, lds, u, wave, lane); else sgu_sample(p, lds, u - 512, wave, lane); }
    }
    if (IN(3)) for (int rep_ = 0; rep_ < REP_P3; ++rep_) {
        for (int u = bx; u < 8192 + 16; u += G) {
            AUnit U;
            if (u < 8192) { const int i = u >> 8, gp = u & 255, b = gp & 7, s = gp >> 3; const int jt = s + 32 * i;
                U.qrow0 = b * SEQ + jt * 8; U.krow0 = b * SEQ; U.nk = ((jt * 8) / 64 + 1) * 64; U.kib = (const h16*)(p.ws + WS_KIC); U.kis = 64; U.kvb = (const unsigned char*)(p.ws + WS_KVC); U.kvs = 512; }
            else { const int v = u - 8192, b = v >> 1, hf = v & 1;
                U.qrow0 = MP + b * 16 + hf * 8; U.krow0 = b * NKSP; U.nk = NKS; U.kib = KIS; U.kis = 64; U.kvb = (const unsigned char*)KVS; U.kvs = 512; }
            attn_unit(p, lds, U, wave, lane_id(), tacc);
        }
    }
    SEAM(3);
    if (IN(4)) for (int rep_ = 0; rep_ < REP_P4; ++rep_) {
        { pg8::Gemm g{(const h16*)(p.ws + WS_AOUT), WPA, MT, 1024, 512, 512}; pg8::StaticOrder S; S.init(MT, 1024, G, bx); EpiGate<1> E{PROJ}; pg8::gemm_phase<EpiGate<1>>((LAS unsigned char*)lds, g, S, E); }
        { pg8::Gemm g{(const h16*)(p.ws + WS_BOUT), WPB, MT, 1024, 512, 512}; pg8::StaticOrder S; S.init(MT, 1024, G, bx); EpiGate<0> E{PROJ}; pg8::gemm_phase<EpiGate<0>>((LAS unsigned char*)lds, g, S, E); }
    }
    SEAM(4);
    if (IN(5)) for (int rep_ = 0; rep_ < REP_P5; ++rep_) {
        pg8::Gemm g{PROJ + C_M, WOUT, MT, 1024, 1024, NPJ}; pg8::StaticOrder S; S.init(MT, 1024, G, bx);
        EpiOut E{p.xp, p.xs, p.out, ROWSS};
        pg8::gemm_phase<EpiOut>((LAS unsigned char*)lds, g, S, E);
    }
    SEAM(5);
    if (IN(6)) {
        const int lane = lane_id();
        for (int m = gw; m < MROWS; m += NGW) {
            float* yr = (m < MP) ? p.out + O_YP + (size_t)m * DM : p.out + O_YS + (size_t)(m - MP) * DM;
            float ssum = (lane < 16) ? ROWSS[(size_t)m * 16 + lane] : 0.f; ssum = wave_sum(ssum);
            const float r = rsqrtf(ssum * (1.f / 1024.f) + 1e-6f);
            const int lane6 = lane;
            f32x4* y4 = (f32x4*)yr + lane6; const f32x4* g4 = (const f32x4*)p.final_g + lane6;
#pragma unroll
            for (int j = 0; j < 4; ++j) { f32x4 v = y4[64 * j]; const f32x4 gg = g4[64 * j]; v = v * r * gg; y4[64 * j] = v; }
        }
    }
    if (TSEL != 0 && bx == 0 && threadIdx.x == 0) { const unsigned long long t0 = rt_(); while (rt_() - t0 < tacc) __builtin_amdgcn_s_sleep(8); }
#undef IN
#undef SEAM
}

extern "C" void kernel_launch(void* const* d_in, const int* in_sizes, int n_in, void* d_out, int out_size, void* d_ws, size_t ws_size, hipStream_t stream) {
    static int grid_blocks = 0;
    if (grid_blocks == 0) {
        if (ws_size < WS_END) { fprintf(stderr, "kernel_launch: workspace too small: %zu < %zu\n", ws_size, (size_t)WS_END); grid_blocks = -1; return; }
        int dev = 0, cus = 0, per_cu = 0;
        hipGetDevice(&dev);
        hipDeviceGetAttribute(&cus, hipDeviceAttributeMultiprocessorCount, dev);
        hipFuncSetAttribute((const void*)mk_fwd, hipFuncAttributeMaxDynamicSharedMemorySize, LDS_BYTES);
        hipOccupancyMaxActiveBlocksPerMultiprocessor(&per_cu, (const void*)mk_fwd, 512, LDS_BYTES);
        if (per_cu < 1) { fprintf(stderr, "kernel_launch: occupancy query says %d blocks per CU\n", per_cu); per_cu = 1; }
        grid_blocks = cus * per_cu;
        (void)hipGetLastError();
    }
    if (grid_blocks < 0) return;
    Params p{};
    p.xp = (const float*)d_in[0]; p.xs = (const float*)d_in[1]; p.ck = (const float*)d_in[2]; p.cv = (const float*)d_in[3]; p.cki = (const float*)d_in[4];
    p.norm_g = (const float*)d_in[5]; p.w_in = (const float*)d_in[6]; p.ln_g = (const float*)d_in[7]; p.ln_b = (const float*)d_in[8];
    p.sgu_w = (const float*)d_in[9]; p.sgu_b = (const float*)d_in[10]; p.w_pa = (const float*)d_in[11]; p.w_pb = (const float*)d_in[12];
    p.w_out = (const float*)d_in[13]; p.final_g = (const float*)d_in[14];
    p.out = (float*)d_out; p.ws = (unsigned char*)d_ws; p.ph_lo = 0; p.ph_hi = 7;
    void* args[] = {&p};
    hipError_t e = hipLaunchCooperativeKernel((const void*)mk_fwd, dim3(grid_blocks), dim3(512), args, LDS_BYTES, stream);
    if (e != hipSuccess) fprintf(stderr, "cooperative launch failed: %s (grid %d)\n", hipGetErrorString(e), grid_blocks);
}
```

```cpp
#include <hip/hip_runtime.h>
#include <hip/hip_cooperative_groups.h>
#include <cstdio>
#include <cstdint>
namespace cg = cooperative_groups;
#define REP_P0 1
#define REP_P1 1
#define REP_P2 1
#define REP_P3 1
#define REP_IDX 1
#define REP_ATT 1
#define TSEL 0
#define LDS_BARRIER() do { asm volatile("s_waitcnt lgkmcnt(0)" ::: "memory"); __builtin_amdgcn_s_barrier(); asm volatile("" ::: "memory"); } while (0)
__device__ __forceinline__ unsigned long long rt_() { return __builtin_amdgcn_s_memrealtime(); }
#define TBEG(k) unsigned long long tb_##k = 0; if (TSEL == (k)) tb_##k = rt_();
#define TEND(k) if (TSEL == (k)) tacc += rt_() - tb_##k;
#define REP_P4 1
#define REP_P5 1

#define LAS __attribute__((address_space(3)))
typedef _Float16 h16;
typedef _Float16 h16x8 __attribute__((ext_vector_type(8)));
typedef _Float16 h16x4 __attribute__((ext_vector_type(4)));
typedef _Float16 h16x2 __attribute__((ext_vector_type(2)));
typedef float f32x2 __attribute__((ext_vector_type(2)));
typedef float f32x4 __attribute__((ext_vector_type(4)));
typedef float f32x16 __attribute__((ext_vector_type(16)));
typedef unsigned u32x4 __attribute__((ext_vector_type(4)));
typedef unsigned u32x2 __attribute__((ext_vector_type(2)));
typedef unsigned long long u64;

constexpr int DM = 1024, SEQ = 8192, NB = 8, MP = NB * SEQ;
constexpr int DSQ = 16, MS = NB * DSQ, PAST = 1024, NKS = PAST + DSQ, NKSP = 1056;
constexpr int MROWS = MP + MS;
constexpr int MT = MP + 256;
constexpr int INW = 5704, NPJ = 5888;
constexpr int C_U = 0, C_V = 512, C_ZA = 1024, C_Q = 1536, C_K = 2048, C_VV = 2304, C_ZB = 2560, C_QI = 3072, C_KI = 3584, C_WI = 3648, C_GA = 3840, C_GB = 4864;
constexpr size_t O_YP = 0, O_YS = 67108864, O_PK = 67239936, O_PV = 84017152, O_PKI = 100794368, O_SK = 104988672, O_SV = 105021440, O_SKI = 105054208, O_SSV = 105062400;
constexpr size_t WS_XH = 0;
constexpr size_t WS_PROJ = WS_XH + (size_t)MT * DM * 2;
constexpr size_t WS_WIN = WS_PROJ + (size_t)MT * NPJ * 2;
constexpr size_t WS_WPA = WS_WIN + (size_t)NPJ * DM * 2;
constexpr size_t WS_WPB = WS_WPA + (size_t)1024 * 512 * 2;
constexpr size_t WS_WOUT = WS_WPB + (size_t)1024 * 512 * 2;
constexpr size_t WS_WSM = WS_WOUT + (size_t)1024 * 1024 * 2;
constexpr size_t WS_KVS = WS_WSM + (size_t)8 * 128 * 128 * 2;
constexpr size_t WS_KIS = WS_KVS + (size_t)NB * NKSP * 512 * 2;
constexpr size_t WS_RSTD = WS_KIS + (size_t)NB * NKSP * 64 * 2;
constexpr size_t WS_ROWSS = WS_RSTD + (size_t)MT * 4;
constexpr size_t WS_KIC = WS_ROWSS + (size_t)MT * 16 * 4;
constexpr size_t WS_KVC = WS_KIC + (size_t)MP * 64 * 2;
constexpr size_t WS_END = WS_KVC + (size_t)MP * 512 * 2;
constexpr size_t WS_AOUT = WS_XH, WS_BOUT = WS_XH + (size_t)MT * 512 * 2;
constexpr int C_T = 0, C_M = 1024;
constexpr int LDS_BYTES = 155648;

__device__ __forceinline__ float sigmoidf_(float x) { return 1.f / (1.f + __expf(-x)); }
__device__ __forceinline__ float siluf_(float x) { return x / (1.f + __expf(-x)); }
__device__ __forceinline__ float geluf_(float x) { const float t = 1.5957691216057308f * (x + 0.044715f * x * x * x); return x / (1.f + __expf(-t)); }
__device__ __forceinline__ int lane_id() { int l; asm volatile("v_mbcnt_lo_u32_b32 %0, -1, 0\n\tv_mbcnt_hi_u32_b32 %0, -1, %0" : "=v"(l)); return l; }
#define DPPF_(v, ctrl) __builtin_bit_cast(float, __builtin_amdgcn_update_dpp(0, __builtin_bit_cast(int, (v)), (ctrl), 0xF, 0xF, true))
#define DPPU_(v, ctrl) ((unsigned)__builtin_amdgcn_update_dpp(0, (int)(v), (ctrl), 0xF, 0xF, true))
__device__ __forceinline__ float row16_sum(float v) { v += DPPF_(v, 0xB1); v += DPPF_(v, 0x4E); v += DPPF_(v, 0x141); v += DPPF_(v, 0x140); return v; }
__device__ __forceinline__ float row16_max(float v) { v = fmaxf(v, DPPF_(v, 0xB1)); v = fmaxf(v, DPPF_(v, 0x4E)); v = fmaxf(v, DPPF_(v, 0x141)); v = fmaxf(v, DPPF_(v, 0x140)); return v; }
__device__ __forceinline__ float x16_sum(float v) { const unsigned u = __builtin_bit_cast(unsigned, v); const auto r = __builtin_amdgcn_permlane16_swap(u, u, false, false); return __builtin_bit_cast(float, (unsigned)r[0]) + __builtin_bit_cast(float, (unsigned)r[1]); }
__device__ __forceinline__ float x32_sum(float v) { const unsigned u = __builtin_bit_cast(unsigned, v); const auto r = __builtin_amdgcn_permlane32_swap(u, u, false, false); return __builtin_bit_cast(float, (unsigned)r[0]) + __builtin_bit_cast(float, (unsigned)r[1]); }
__device__ __forceinline__ float wave_sum(float v) { return x32_sum(x16_sum(row16_sum(v))); }
__device__ __forceinline__ unsigned wave_min_u(unsigned v) { v = min(v, DPPU_(v, 0xB1)); v = min(v, DPPU_(v, 0x4E)); v = min(v, DPPU_(v, 0x141)); v = min(v, DPPU_(v, 0x140));
    { const auto r = __builtin_amdgcn_permlane16_swap(v, v, false, false); v = min((unsigned)r[0], (unsigned)r[1]); } { const auto r = __builtin_amdgcn_permlane32_swap(v, v, false, false); v = min((unsigned)r[0], (unsigned)r[1]); } return v; }
__device__ __forceinline__ unsigned wave_max_u(unsigned v) { v = max(v, DPPU_(v, 0xB1)); v = max(v, DPPU_(v, 0x4E)); v = max(v, DPPU_(v, 0x141)); v = max(v, DPPU_(v, 0x140));
    { const auto r = __builtin_amdgcn_permlane16_swap(v, v, false, false); v = max((unsigned)r[0], (unsigned)r[1]); } { const auto r = __builtin_amdgcn_permlane32_swap(v, v, false, false); v = max((unsigned)r[0], (unsigned)r[1]); } return v; }

namespace pg8 {
constexpr int BM = 256, BK = 64, HALF = 128, HTB = HALF * BK * 2, STAGE_BYTES = 8 * HTB, NXCD = 8, WGM = 8;
__host__ __device__ __forceinline__ int lds_byte(int r, int c) { const int st = (r >> 4) * 2 + (c >> 5), rr = r & 15, cc = c & 31, ob = rr * 64 + cc * 2; return st * 1024 + (ob ^ (((ob >> 9) & 1) << 5)); }
__host__ __device__ __forceinline__ void stage_rc(int b, int& R, int& C) { const int st = b / 1024, sb = b % 1024, swz = sb ^ (((sb >> 9) & 1) << 5); R = (st >> 1) * 16 + swz / 64; C = (st & 1) * 32 + (swz % 64) / 2; }
__host__ __device__ __forceinline__ int perm32(int rho) { const int n = rho >> 4, i = rho & 15; return 8 * (i >> 2) + 4 * n + (i & 3); }
struct Unit { int pm, pn; };
struct Gemm { const h16* A; const h16* Bt; int M, N, K, lda; };
struct StaticOrder {
    int nM, nN, nwg, G, c;
    __device__ void init(int M, int N, int G_, int c_) { nM = M / BM; nN = N / BM; nwg = nM * nN; G = G_; c = c_; }
    __device__ bool next(int i, Unit& u) const {
        const long L = (long)i * G + c; if (L >= nwg) return false;
        int wgid = (int)L; { const int q = nwg / NXCD, r = nwg % NXCD, xcd = wgid % NXCD, off = wgid / NXCD; wgid = (xcd < r ? xcd * (q + 1) : r * (q + 1) + (xcd - r) * q) + off; }
        const int nig = WGM * nN, gid = wgid / nig, fm = gid * WGM, gsz = (nM - fm) < WGM ? (nM - fm) : WGM;
        u.pm = fm + ((wgid % nig) % gsz); u.pn = (wgid % nig) / gsz; return true;
    }
};
template <class Epi>
__device__ __forceinline__ void gemm_phase(LAS unsigned char* lds, const Gemm g, const StaticOrder& S, const Epi& E) {
    const int tid = threadIdx.x, wid = __builtin_amdgcn_readfirstlane(tid >> 6), lane = tid & 63, wr = wid >> 2, wc = wid & 3, fr = lane & 15, fq = lane >> 4;
    const int K = g.K, nt = K / BK, lda = g.lda;
    unsigned voffA[2], voffB[2];
#pragma unroll
    for (int i = 0; i < 2; ++i) { int R, C; stage_rc(tid * 16 + i * 8192, R, C); const int Rb = (R & ~31) + perm32(R & 31);
        voffA[i] = (unsigned)(R * lda + C) * 2u; voffB[i] = (unsigned)(Rb * K + C) * 2u; }
    const size_t kstep = (size_t)(BK * 2);
    const size_t hstepA = (size_t)HALF * lda * 2, hstepB = (size_t)HALF * K * 2;
    const size_t tstepA = 2 * hstepA, tstepB = 2 * hstepB;
    const unsigned ldsw = (unsigned)wid * 1024u;
    const int aoff = lds_byte(wr * 64 + fr, fq * 8), boff = lds_byte(wc * 32 + fr, fq * 8);
#define PG8_SA(b, h) (((b) * 2 + (h)) * HTB)
#define PG8_SB(b, h) ((4 + (b) * 2 + (h)) * HTB)
#define PG8_STAGE(bufoff, gbase, voff) do { _Pragma("unroll") for (int _i = 0; _i < 2; ++_i) \
        __builtin_amdgcn_global_load_lds((const unsigned*)((const char*)(gbase) + (voff)[_i]), (LAS unsigned*)(lds + (bufoff) + ldsw + _i * 8192), 16, 0, 0); } while (0)
#define PG8_LDA(dst, b, h) do { _Pragma("unroll") for (int m = 0; m < 4; ++m) _Pragma("unroll") for (int k = 0; k < 2; ++k) dst[m][k] = *(const LAS h16x8*)(lds + PG8_SA(b, h) + aoff + m * 2048 + k * 1024); } while (0)
#define PG8_LDB(dst, b, h) do { _Pragma("unroll") for (int n = 0; n < 2; ++n) _Pragma("unroll") for (int k = 0; k < 2; ++k) dst[n][k] = *(const LAS h16x8*)(lds + PG8_SB(b, h) + boff + n * 2048 + k * 1024); } while (0)
#define PG8_MMA(ai, bj, At, Bt) do { __builtin_amdgcn_s_setprio(1); _Pragma("unroll") for (int m = 0; m < 4; ++m) _Pragma("unroll") for (int n = 0; n < 2; ++n) _Pragma("unroll") for (int k = 0; k < 2; ++k) \
        acc[ai][bj][m][n] = __builtin_amdgcn_mfma_f32_16x16x32_f16(Bt[n][k], At[m][k], acc[ai][bj][m][n], 0, 0, 0); __builtin_amdgcn_s_setprio(0); } while (0)
#define PG8_WAIT_V(n) asm volatile("s_waitcnt vmcnt(" #n ")" ::: "memory")
#define PG8_WAIT_L(n) asm volatile("s_waitcnt lgkmcnt(" #n ")" ::: "memory")
#define PG8_BAR __builtin_amdgcn_s_barrier()
#define PG8_SCHED __builtin_amdgcn_sched_barrier(0)
    Unit cur, nxt; int ui = 0;
    if (!S.next(0, cur)) return;
    f32x4 acc[2][2][4][2];
#pragma unroll
    for (int a = 0; a < 2; ++a)
#pragma unroll
        for (int b = 0; b < 2; ++b)
#pragma unroll
            for (int m = 0; m < 4; ++m)
#pragma unroll
                for (int n = 0; n < 2; ++n) acc[a][b][m][n] = (f32x4){0.f, 0.f, 0.f, 0.f};
    h16x8 At[4][2], B0[2][2], B1[2][2];
    const char* cA = (const char*)g.A + (size_t)cur.pm * tstepA; const char* cB = (const char*)g.Bt + (size_t)cur.pn * tstepB;
    PG8_STAGE(PG8_SB(0, 0), cB, voffB); PG8_STAGE(PG8_SB(0, 1), cB + hstepB, voffB); PG8_STAGE(PG8_SA(0, 0), cA, voffA); PG8_STAGE(PG8_SA(0, 1), cA + hstepA, voffA);
    if (wr == 1) PG8_BAR;
    PG8_WAIT_V(2); PG8_BAR;
    PG8_STAGE(PG8_SB(1, 0), cB + kstep, voffB); PG8_STAGE(PG8_SA(1, 0), cA + kstep, voffA); PG8_STAGE(PG8_SB(1, 1), cB + hstepB + kstep, voffB);
    PG8_WAIT_V(6); PG8_BAR;
    for (;;) {
        const bool has_next = S.next(ui + 1, nxt);
        const char* nA = has_next ? (const char*)g.A + (size_t)nxt.pm * tstepA : cA; const char* nB = has_next ? (const char*)g.Bt + (size_t)nxt.pn * tstepB : cB;
        for (int t = 0; t < nt; t += 2) {
            const bool last = (t == nt - 2);
            const char* a1 = cA + (size_t)(t + 1) * kstep;
            const char* a2 = last ? nA : cA + (size_t)(t + 2) * kstep; const char* b2 = last ? nB : cB + (size_t)(t + 2) * kstep;
            const char* a3 = a2 + kstep; const char* b3 = b2 + kstep;
            PG8_LDB(B0, 0, 0); PG8_LDB(B1, 0, 1); PG8_SCHED; PG8_LDA(At, 0, 0); PG8_STAGE(PG8_SA(1, 1), a1 + hstepA, voffA);
            PG8_WAIT_V(8); PG8_WAIT_L(0); PG8_BAR; PG8_MMA(0, 0, At, B0); PG8_MMA(0, 1, At, B1); PG8_BAR; PG8_SCHED;
            PG8_LDA(At, 0, 1); PG8_STAGE(PG8_SB(0, 0), b2, voffB); PG8_STAGE(PG8_SB(0, 1), b2 + hstepB, voffB); PG8_STAGE(PG8_SA(0, 0), a2, voffA);
            PG8_WAIT_V(8); PG8_WAIT_L(0); PG8_BAR; PG8_MMA(1, 0, At, B0); PG8_MMA(1, 1, At, B1); PG8_BAR; PG8_SCHED;
            PG8_LDB(B0, 1, 0); PG8_LDB(B1, 1, 1); PG8_SCHED; PG8_LDA(At, 1, 0); PG8_STAGE(PG8_SA(0, 1), a2 + hstepA, voffA);
            PG8_WAIT_V(8); PG8_WAIT_L(0); PG8_BAR; PG8_MMA(0, 0, At, B0); PG8_MMA(0, 1, At, B1); PG8_BAR; PG8_SCHED;
            PG8_LDA(At, 1, 1); PG8_STAGE(PG8_SB(1, 0), b3, voffB); PG8_STAGE(PG8_SB(1, 1), b3 + hstepB, voffB); PG8_STAGE(PG8_SA(1, 0), a3, voffA);
            PG8_WAIT_V(8); PG8_WAIT_L(0); PG8_BAR; PG8_MMA(1, 0, At, B0); PG8_MMA(1, 1, At, B1); PG8_BAR; PG8_SCHED;
        }
        if (wr == 0) PG8_BAR;
        E(acc, cur, wr, wc, fr, fq);
        if (!has_next) break;
#pragma unroll
        for (int a = 0; a < 2; ++a)
#pragma unroll
            for (int b = 0; b < 2; ++b)
#pragma unroll
                for (int m = 0; m < 4; ++m)
#pragma unroll
                    for (int n = 0; n < 2; ++n) acc[a][b][m][n] = (f32x4){0.f, 0.f, 0.f, 0.f};
        cur = nxt; cA = nA; cB = nB; ++ui;
        if (wr == 1) PG8_BAR;
    }
    PG8_WAIT_V(0);
    PG8_BAR;
#undef PG8_SA
#undef PG8_SB
#undef PG8_STAGE
#undef PG8_LDA
#undef PG8_LDB
#undef PG8_MMA
#undef PG8_WAIT_V
#undef PG8_WAIT_L
#undef PG8_BAR
#undef PG8_SCHED
}
}

__device__ __forceinline__ u64 pack8_fp8(const f32x4 a, const f32x4 b) {
    int w0 = __builtin_amdgcn_cvt_pk_fp8_f32(a[0], a[1], 0, false); w0 = __builtin_amdgcn_cvt_pk_fp8_f32(a[2], a[3], w0, true);
    int w1 = __builtin_amdgcn_cvt_pk_fp8_f32(b[0], b[1], 0, false); w1 = __builtin_amdgcn_cvt_pk_fp8_f32(b[2], b[3], w1, true);
    return (u64)(unsigned)w0 | ((u64)(unsigned)w1 << 32);
}
__device__ __forceinline__ h16x8 fp8x8_to_h16(const u64 v) {
    const int w0 = (int)(unsigned)v, w1 = (int)(unsigned)(v >> 32);
    const f32x2 a = __builtin_amdgcn_cvt_pk_f32_fp8(w0, false), b = __builtin_amdgcn_cvt_pk_f32_fp8(w0, true), c = __builtin_amdgcn_cvt_pk_f32_fp8(w1, false), d = __builtin_amdgcn_cvt_pk_f32_fp8(w1, true);
    h16x8 h; h[0] = (h16)a.x; h[1] = (h16)a.y; h[2] = (h16)b.x; h[3] = (h16)b.y; h[4] = (h16)c.x; h[5] = (h16)c.y; h[6] = (h16)d.x; h[7] = (h16)d.y;
    return h;
}
__device__ __forceinline__ int kvpos(int lc) { if (lc >= 256) return lc; const int j = lc >> 6, d = lc & 63; return j * 64 + ((d & 31) >> 3) * 16 + (d >> 5) * 8; }
__device__ __forceinline__ u32x4 pack8(const f32x4 a, const f32x4 b) {
    h16x8 h; h[0] = (h16)a[0]; h[1] = (h16)a[1]; h[2] = (h16)a[2]; h[3] = (h16)a[3]; h[4] = (h16)b[0]; h[5] = (h16)b[1]; h[6] = (h16)b[2]; h[7] = (h16)b[3];
    return __builtin_bit_cast(u32x4, h);
}

struct EpiProj {
    h16* PROJ; const float* rstd; float* dout; unsigned char* KVS; h16* KIS; unsigned char* KVC; h16* KIC;
    __device__ __forceinline__ void operator()(const f32x4 (&acc)[2][2][4][2], const pg8::Unit& u, int wr, int wc, int fr, int fq) const {
        const int row0 = u.pm * 256 + wr * 64 + fr, col0 = u.pn * 256 + wc * 32 + 8 * fq;
        const int pn = u.pn;
#pragma unroll
        for (int ai = 0; ai < 2; ++ai)
#pragma unroll
            for (int m = 0; m < 4; ++m) {
                const int row = row0 + ai * 128 + m * 16; const float rs = rstd[row];
#pragma unroll
                for (int bj = 0; bj < 2; ++bj) {
                    const int c = col0 + bj * 128;
                    const f32x4 v0 = acc[ai][bj][m][0] * rs, v1 = acc[ai][bj][m][1] * rs;
                    if (pn != 8 && pn != 9) *(u32x4*)(PROJ + (size_t)row * NPJ + c) = pack8(v0, v1);
                    if (pn == 8 || pn == 9 || (pn == 14 && c < C_KI + 64)) {
                        if (row < MP) {
                            float* o = (pn == 8) ? dout + O_PK + (size_t)row * 256 + (c - C_K) : (pn == 9) ? dout + O_PV + (size_t)row * 256 + (c - C_VV) : dout + O_PKI + (size_t)row * 64 + (c - C_KI);
                            *(f32x4*)o = v0; *(f32x4*)(o + 4) = v1;
                            if (pn == 14) *(u32x4*)(KIC + (size_t)row * 64 + (c - C_KI)) = pack8(v0, v1);
                            else *(u64*)(KVC + (size_t)row * 512 + kvpos(c - C_K)) = pack8_fp8(v0, v1);
                        } else if (row < MROWS) {
                            const int t = row - MP, b = t >> 4, s = t & 15; const size_t kr = (size_t)b * NKSP + PAST + s;
                            float* o = (pn == 8) ? dout + O_SK + (size_t)t * 256 + (c - C_K) : (pn == 9) ? dout + O_SV + (size_t)t * 256 + (c - C_VV) : dout + O_SKI + (size_t)t * 64 + (c - C_KI);
                            *(f32x4*)o = v0; *(f32x4*)(o + 4) = v1;
                            if (pn == 14) *(u32x4*)(KIS + kr * 64 + (c - C_KI)) = pack8(v0, v1);
                            else *(u64*)(KVS + kr * 512 + kvpos(c - C_K)) = pack8_fp8(v0, v1);
                        }
                    }
                }
            }
    }
};
template <int FIRST> struct EpiGate {
    h16* PROJ;
    __device__ __forceinline__ void operator()(const f32x4 (&acc)[2][2][4][2], const pg8::Unit& u, int wr, int wc, int fr, int fq) const {
        const int row0 = u.pm * 256 + wr * 64 + fr, col0 = u.pn * 256 + wc * 32 + 8 * fq;
#pragma unroll
        for (int ai = 0; ai < 2; ++ai)
#pragma unroll
            for (int m = 0; m < 4; ++m) {
                const int row = row0 + ai * 128 + m * 16;
#pragma unroll
                for (int bj = 0; bj < 2; ++bj) {
                    const int c = col0 + bj * 128;
                    h16* pm_ = PROJ + (size_t)row * NPJ + (FIRST ? C_T : C_M) + c;
                    const h16x8 gt = *(const h16x8*)(PROJ + (size_t)row * NPJ + (FIRST ? C_GA : C_GB) + c);
                    f32x4 v0, v1;
#pragma unroll
                    for (int j = 0; j < 4; ++j) { v0[j] = sigmoidf_((float)gt[j]) * acc[ai][bj][m][0][j]; v1[j] = sigmoidf_((float)gt[4 + j]) * acc[ai][bj][m][1][j]; }
                    if (!FIRST) { const h16x8 tp = *(const h16x8*)(PROJ + (size_t)row * NPJ + C_T + c);
#pragma unroll
                        for (int j = 0; j < 4; ++j) { v0[j] += (float)tp[j]; v1[j] += (float)tp[4 + j]; } }
                    *(u32x4*)pm_ = pack8(v0, v1);
                }
            }
    }
};
struct EpiOut {
    const float* xp; const float* xs; float* dout; float* rowss;
    __device__ __forceinline__ void operator()(const f32x4 (&acc)[2][2][4][2], const pg8::Unit& u, int wr, int wc, int fr, int fq) const {
        const int row0 = u.pm * 256 + wr * 64 + fr, col0 = u.pn * 256 + wc * 32 + 8 * fq;
#pragma unroll
        for (int ai = 0; ai < 2; ++ai)
#pragma unroll
            for (int m = 0; m < 4; ++m) {
                const int row = row0 + ai * 128 + m * 16;
                const bool ok = row < MROWS;
                const float* xr = (row < MP) ? xp + (size_t)row * DM : xs + (size_t)(row - MP) * DM;
                float* yr = (row < MP) ? dout + O_YP + (size_t)row * DM : dout + O_YS + (size_t)(row - MP) * DM;
                float ss = 0.f;
                if (ok) {
#pragma unroll
                    for (int bj = 0; bj < 2; ++bj) {
                        const int c = col0 + bj * 128;
                        const f32x4 x0 = *(const f32x4*)(xr + c), x1 = *(const f32x4*)(xr + c + 4);
                        const f32x4 v0 = x0 + acc[ai][bj][m][0], v1 = x1 + acc[ai][bj][m][1];
                        *(f32x4*)(yr + c) = v0; *(f32x4*)(yr + c + 4) = v1;
                        ss += v0[0] * v0[0] + v0[1] * v0[1] + v0[2] * v0[2] + v0[3] * v0[3] + v1[0] * v1[0] + v1[1] * v1[1] + v1[2] * v1[2] + v1[3] * v1[3];
                    }
                }
                ss = x32_sum(x16_sum(ss));
                if (ok && fq == 0) rowss[(size_t)row * 16 + u.pn * 4 + wc] = ss;
            }
    }
};

struct Params {
    const float *xp, *xs, *ck, *cv, *cki, *norm_g, *w_in, *ln_g, *ln_b, *sgu_w, *sgu_b, *w_pa, *w_pb, *w_out, *final_g;
    float* out; unsigned char* ws; int ph_lo, ph_hi;
};

__device__ __forceinline__ void p0_tr_item(const float* W, int K, int Nsrc, h16* WT, const float* gs, int mode, float* scr, int item, int nblk, int lane) {
    const int kb = item / nblk, nb = item % nblk, k0 = 64 * kb, n0 = 32 * nb;
    const int nn = n0 + (lane & 31);
    int src = nn; bool valid = true;
    if (mode == 1) { if (nn >= C_WI + 8 && nn < C_GA) valid = false; else if (nn >= C_GA) src = nn - (C_GA - (C_WI + 8)); }
#pragma unroll 8
    for (int i = 0; i < 32; ++i) { const int kk = 2 * i + (lane >> 5);
        float v = 0.f; if (valid) { v = W[(size_t)(k0 + kk) * Nsrc + src]; if (gs) v *= gs[k0 + kk]; }
        scr[kk * 33 + (lane & 31)] = v; }
    __builtin_amdgcn_s_waitcnt(0); asm volatile("" ::: "memory");
    const int c = lane & 7;
#pragma unroll
    for (int j = 0; j < 4; ++j) { const int n = (lane >> 3) + 8 * j; const float* s = scr + (8 * c) * 33 + n;
        h16x8 h;
#pragma unroll
        for (int q = 0; q < 8; ++q) h[q] = (h16)s[q * 33];
        *(h16x8*)(WT + (size_t)(n0 + n) * K + k0 + 8 * c) = h; }
    __builtin_amdgcn_s_waitcnt(0); asm volatile("" ::: "memory");
}

constexpr int VNT_LD = 136;
__device__ __forceinline__ void sgu_chunk(const Params& p, unsigned char* lds, int chunk, int wave, int lane) {
    h16* PROJ = (h16*)(p.ws + WS_PROJ);
    h16* vnT = (h16*)lds;
    h16* AOUT = (h16*)(p.ws + WS_AOUT);
    const h16* WSM = (const h16*)(p.ws + WS_WSM);
    {
        float lg[8], lb[8];
#pragma unroll
        for (int j = 0; j < 8; ++j) { lg[j] = p.ln_g[lane * 8 + j]; lb[j] = p.ln_b[lane * 8 + j]; }
        for (int tt = 0; tt < 16; ++tt) {
            const int tok = wave * 16 + tt; const size_t row = (size_t)chunk * 128 + tok;
            const h16x8 vv = *(const h16x8*)(PROJ + row * NPJ + C_V + lane * 8);
            float g[8]; float s = 0.f;
#pragma unroll
            for (int j = 0; j < 8; ++j) { g[j] = geluf_((float)vv[j]); s += g[j]; }
            const float mean = wave_sum(s) * (1.f / 512.f); float q = 0.f;
#pragma unroll
            for (int j = 0; j < 8; ++j) { g[j] -= mean; q += g[j] * g[j]; }
            const float rstd = rsqrtf(wave_sum(q) * (1.f / 512.f) + 1e-5f);
#pragma unroll
            for (int j = 0; j < 8; ++j) vnT[(lane * 8 + j) * VNT_LD + tok] = (h16)(g[j] * rstd * lg[j] + lb[j]);
        }
    }
    __syncthreads();
    {
        const int g = wave, fr = lane & 15, fq = lane >> 4;
        for (int it = 0; it < 8; ++it) {
            f32x4 acc[4];
#pragma unroll
            for (int dt = 0; dt < 4; ++dt) acc[dt] = (f32x4){0.f, 0.f, 0.f, 0.f};
            const int nks = (it < 4) ? 2 : 4;
            for (int ks = 0; ks < nks; ++ks) {
                const h16x8 b = *(const h16x8*)(WSM + ((size_t)g * 128 + it * 16 + fr) * 128 + ks * 32 + fq * 8);
#pragma unroll
                for (int dt = 0; dt < 4; ++dt) {
                    const h16x8 a = *(const h16x8*)(vnT + (g * 64 + dt * 16 + fr) * VNT_LD + ks * 32 + fq * 8);
                    acc[dt] = __builtin_amdgcn_mfma_f32_16x16x32_f16(a, b, acc[dt], 0, 0, 0);
                }
            }
            const int i = it * 16 + fr; const size_t row = (size_t)chunk * 128 + i;
            const float bias = p.sgu_b[g * 128 + i];
#pragma unroll
            for (int dt = 0; dt < 4; ++dt) {
                const int c = g * 64 + dt * 16 + fq * 4;
                const h16x4 uu = *(const h16x4*)(PROJ + row * NPJ + C_U + c); const h16x4 zz = *(const h16x4*)(PROJ + row * NPJ + C_ZA + c);
                h16x4 o;
#pragma unroll
                for (int r = 0; r < 4; ++r) o[r] = (h16)(geluf_((float)uu[r]) * (acc[dt][r] + bias) * siluf_((float)zz[r]));
                *(h16x4*)(AOUT + row * 512 + c) = o;
            }
        }
    }
    __syncthreads();
}
__device__ __forceinline__ void sgu_sample(const Params& p, unsigned char* lds, int b, int wave, int lane) {
    h16* PROJ = (h16*)(p.ws + WS_PROJ);
    float* vnS = (float*)lds;
    for (int tt = 0; tt < 2; ++tt) {
        const int t = wave * 2 + tt; const size_t row = (size_t)MP + b * 16 + t;
        const h16x8 vv = *(const h16x8*)(PROJ + row * NPJ + C_V + lane * 8);
        float g[8]; float s = 0.f;
#pragma unroll
        for (int j = 0; j < 8; ++j) { g[j] = geluf_((float)vv[j]); s += g[j]; }
        const float mean = wave_sum(s) * (1.f / 512.f); float q = 0.f;
#pragma unroll
        for (int j = 0; j < 8; ++j) { g[j] -= mean; q += g[j] * g[j]; }
        const float rstd = rsqrtf(wave_sum(q) * (1.f / 512.f) + 1e-5f);
#pragma unroll
        for (int j = 0; j < 8; ++j) { const int c = lane * 8 + j; const float v = g[j] * rstd * p.ln_g[c] + p.ln_b[c];
            vnS[t * 512 + c] = v; p.out[O_SSV + (size_t)(b * 16 + t) * 512 + c] = v; }
    }
    __syncthreads();
    {
        const int c = threadIdx.x, g = c >> 6;
        float vn[16];
#pragma unroll
        for (int j = 0; j < 16; ++j) vn[j] = vnS[j * 512 + c];
        for (int i = 0; i < 16; ++i) {
            float mixed = p.sgu_b[g * 128 + i];
#pragma unroll
            for (int j = 0; j < 16; ++j) mixed += p.sgu_w[((size_t)g * 128 + i) * 128 + j] * vn[j];
            const size_t row = (size_t)MP + b * 16 + i;
            const float u = (float)PROJ[row * NPJ + C_U + c], za = (float)PROJ[row * NPJ + C_ZA + c];
            ((h16*)(p.ws + WS_AOUT))[row * 512 + c] = (h16)(geluf_(u) * mixed * siluf_(za));
        }
    }
    __syncthreads();
}

constexpr int TK_C = 2048, TK_TRIG = TK_C - 512;
constexpr int L3_QA = 147456;
constexpr int L3_HIST = 131072, L3_CNT = L3_HIST + 8192, L3_THR = L3_CNT + 32, L3_SUM = L3_THR + 32;
__device__ __forceinline__ unsigned fkey(float f) { const unsigned u = __float_as_uint(f); return (u & 0x80000000u) ? ~u : (u | 0x80000000u); }
__device__ __forceinline__ float fkey_inv(unsigned k) { return __uint_as_float((k & 0x80000000u) ? (k ^ 0x80000000u) : ~k); }

template <bool ON_LO>
__device__ __forceinline__ unsigned radix_select(const u64* buf, unsigned* hist, int n, int lane, unsigned fhi, int k, int& ceq_out, int& krem_out) {
    unsigned prefix = 0, pmask = 0; int krem = k; int ceq = 0;
    for (int shift = 24; shift >= 0; shift -= 8) {
        *(u32x4*)(hist + 4 * lane) = (u32x4){0u, 0u, 0u, 0u};
        __builtin_amdgcn_s_waitcnt(0); asm volatile("" ::: "memory");
        for (int i = lane; i < n; i += 64) {
            const u64 e = buf[i]; const unsigned hi = (unsigned)(e >> 32), lo = (unsigned)e;
            const unsigned key = ON_LO ? lo : hi;
            const bool ok = (ON_LO ? (hi == fhi) : true) && ((key & pmask) == prefix);
            if (ok) atomicAdd(hist + ((key >> shift) & 255u), 1u);
        }
        __builtin_amdgcn_s_waitcnt(0); asm volatile("" ::: "memory");
        const u32x4 hv = *(const u32x4*)(hist + 4 * lane);
        const unsigned s = hv.x + hv.y + hv.z + hv.w;
        unsigned S = s;
#pragma unroll
        for (int o = 1; o < 64; o <<= 1) { const unsigned t = __shfl_down(S, o); if (lane + o < 64) S += t; }
        const bool is = (S >= (unsigned)krem) && (S - s < (unsigned)krem);
        const u64 bm = __ballot(is);
        const int L = bm ? (__ffsll((long long)bm) - 1) : 0;
        unsigned d = 0, cab = S - s, ce = 0;
        { unsigned c = S - s;
          if (c + hv.w >= (unsigned)krem) { d = 3; cab = c; ce = hv.w; }
          else { c += hv.w; if (c + hv.z >= (unsigned)krem) { d = 2; cab = c; ce = hv.z; }
          else { c += hv.z; if (c + hv.y >= (unsigned)krem) { d = 1; cab = c; ce = hv.y; }
          else { c += hv.y; d = 0; cab = c; ce = hv.x; } } } }
        { const int Ls_ = __builtin_amdgcn_readfirstlane(L); d = __builtin_amdgcn_readlane(d, Ls_); cab = __builtin_amdgcn_readlane(cab, Ls_); ce = __builtin_amdgcn_readlane(ce, Ls_); }
        const unsigned digit = 4u * (unsigned)L + d;
        krem -= (int)cab; ceq = (int)ce; prefix |= digit << shift; pmask |= 255u << shift;
    }
    ceq_out = ceq; krem_out = krem;
    return prefix;
}
__device__ __forceinline__ int tk_compact(u64* buf, unsigned* hist, int n, int lane_in, float& thr) {
    int lane = lane_in; asm volatile("" : "+v"(lane));
    unsigned ehi[32];
    const unsigned* b32 = (const unsigned*)buf;
#pragma unroll
    for (int j = 0; j < 32; ++j) { ehi[j] = 0u; if (64 * j < n) { const int ic = min(lane + 64 * j, n - 1); ehi[j] = b32[2 * ic + 1]; } }
    unsigned mn = 0xFFFFFFFFu, mx = 0u;
#pragma unroll
    for (int j = 0; j < 32; ++j) { if (64 * j < n) { mn = min(mn, ehi[j]); mx = max(mx, ehi[j]); } }
    mn = wave_min_u(mn); mx = wave_max_u(mx);
    const unsigned range = mx - mn; const int sh = range ? __clz(range) : 0;
#pragma unroll
    for (int j = 0; j < 32; ++j) { const unsigned nk = (ehi[j] - mn) << sh; ehi[j] = ((lane + 64 * j) < n) ? nk : 0u; }
    const unsigned ninv = (unsigned)(((n + 63) & ~63) - n);
    unsigned prefix = 0, pmask = 0; int krem = 256; bool done = false;
    for (int shift = 24; shift >= 0 && !done; shift -= 8) {
        *(u32x4*)(hist + 4 * lane) = (u32x4){0u, 0u, 0u, 0u};
        __builtin_amdgcn_s_waitcnt(0); asm volatile("" ::: "memory");
#pragma unroll
        for (int j = 0; j < 32; ++j) { if (64 * j < n) { if ((ehi[j] & pmask) == prefix) atomicAdd(hist + ((ehi[j] >> shift) & 255u), 1u); } }
        __builtin_amdgcn_s_waitcnt(0); asm volatile("" ::: "memory");
        u32x4 hv = *(const u32x4*)(hist + 4 * lane);
        if (lane == 0 && prefix == 0u) hv.x -= ninv;
        const unsigned s = hv.x + hv.y + hv.z + hv.w;
        unsigned S = s;
#pragma unroll
        for (int o = 1; o < 64; o <<= 1) { const unsigned t = __shfl_down(S, o); if (lane + o < 64) S += t; }
        const bool is = (S >= (unsigned)krem) && (S - s < (unsigned)krem);
        const u64 bm = __ballot(is);
        const int L = bm ? (__ffsll((long long)bm) - 1) : 0;
        unsigned d = 0, cab = S - s, ce = 0;
        { unsigned c = S - s;
          if (c + hv.w >= (unsigned)krem) { d = 3; cab = c; ce = hv.w; }
          else { c += hv.w; if (c + hv.z >= (unsigned)krem) { d = 2; cab = c; ce = hv.z; }
          else { c += hv.z; if (c + hv.y >= (unsigned)krem) { d = 1; cab = c; ce = hv.y; }
          else { c += hv.y; d = 0; cab = c; ce = hv.x; } } } }
        { const int Ls_ = __builtin_amdgcn_readfirstlane(L); d = __builtin_amdgcn_readlane(d, Ls_); cab = __builtin_amdgcn_readlane(cab, Ls_); ce = __builtin_amdgcn_readlane(ce, Ls_); }
        krem -= (int)cab; prefix |= (4u * (unsigned)L + d) << shift; pmask |= 255u << shift;
        if ((int)ce == krem) done = true;
    }
    unsigned tlo = 0u;
    const unsigned thi_abs = mn + ((prefix + ((1u << sh) - 1u)) >> sh);
    if (!done) { int c2, k2; tlo = radix_select<true>(buf, hist, n, lane, mn + (prefix >> sh), krem, c2, k2); }
    int outn = 0;
#pragma unroll
    for (int j = 0; j < 32; ++j) {
        if (64 * j < n) {
            const int i = lane + 64 * j; const int ic = min(i, n - 1);
            const unsigned elo_ = b32[2 * ic];
            const bool keep = (i < n) && ((ehi[j] > prefix) || ((ehi[j] & pmask) == prefix && (done || elo_ >= tlo)));
            const u64 bm = __ballot(keep);
            const int off = __builtin_amdgcn_mbcnt_hi((unsigned)(bm >> 32), __builtin_amdgcn_mbcnt_lo((unsigned)bm, 0u));
            if (keep) buf[outn + off] = ((u64)(mn + (ehi[j] >> sh)) << 32) | (u64)elo_;
            outn += __popcll(bm);
        }
    }
    __builtin_amdgcn_s_waitcnt(0); asm volatile("" ::: "memory");
    thr = fkey_inv(thi_abs - 1u);
    return outn;
}

struct AUnit { int qrow0, krow0, nk; const h16* kib; int kis; const unsigned char* kvb; int kvs; };

__device__ __forceinline__ void attn_unit(const Params& p, unsigned char* lds, const AUnit U, int wave, int lane, unsigned long long& tacc) {
    h16* PROJ = (h16*)(p.ws + WS_PROJ);
    u64* bufall = (u64*)lds;
    unsigned* hist = (unsigned*)(lds + L3_HIST) + wave * 256;
    unsigned* cnt = (unsigned*)(lds + L3_CNT);
    float* thrs = (float*)(lds + L3_THR);
    float* sums = (float*)(lds + L3_SUM) + wave * 8;
    int lane_r = lane; asm volatile("" : "+v"(lane_r));
    const int half = lane_r >> 5, l31 = lane_r & 31;
    f32x2 wq[2][2][4]; h16x8 qa[2][4];
    h16x8* qalds = (h16x8*)(lds + L3_QA);
#define LOADQA() do { _Pragma("unroll") for (int mt = 0; mt < 2; ++mt) _Pragma("unroll") for (int ks = 0; ks < 4; ++ks) qa[mt][ks] = qalds[(mt * 4 + ks) * 64 + lane_r]; } while (0)
#define LOADQ() do { _Pragma("unroll") for (int mt = 0; mt < 2; ++mt) _Pragma("unroll") for (int e = 0; e < 2; ++e) \
        { const h16x8 w8_ = *(const h16x8*)(PROJ + (size_t)(U.qrow0 + mt * 4 + 2 * half + e) * NPJ + C_WI); \
          _Pragma("unroll") for (int h = 0; h < 4; ++h) wq[mt][e][h] = (f32x2){(float)w8_[2 * h], (float)w8_[2 * h + 1]}; } } while (0)
    {
        int lane_s = lane; asm volatile("" : "+v"(lane_s)); const int l31 = lane_s & 31, half = lane_s >> 5;
        const int ql = 2 * ((l31 >> 2) & 1) + (l31 >> 4), hh = ((l31 >> 3) & 1) * 4 + (l31 & 3);
        const int mt_ = wave >> 2, ks_ = wave & 3;
        qalds[wave * 64 + lane_s] = *(const h16x8*)(PROJ + (size_t)(U.qrow0 + mt_ * 4 + ql) * NPJ + C_QI + hh * 64 + half * 8 + ks_ * 16);
    }
    __builtin_amdgcn_sched_barrier(0);
    LOADQ();
    __builtin_amdgcn_sched_barrier(0);
    for (int repi_ = 0; repi_ < REP_IDX; ++repi_) {
    __syncthreads();
    { const int t8 = lane_id(); if (wave == 0 && t8 < 8) { cnt[t8] = 0u; thrs[t8] = -__builtin_inff(); } }
    __syncthreads();
    const int nkt = (U.nk + 31) >> 5, rounds = (nkt + 15) >> 4;
    LOADQA();
    h16x8 bf[2][4], bn[2][4];
#define LOADB(dst, rdx) do { _Pragma("unroll") for (int rr = 0; rr < 2; ++rr) { const int kt_ = (rdx) * 16 + rr * 8 + wave; const int ktc_ = kt_ < nkt ? kt_ : nkt - 1; \
        const h16* kp_ = U.kib + (size_t)(U.krow0 + ktc_ * 32 + l31) * U.kis + half * 8; \
        _Pragma("unroll") for (int ks = 0; ks < 4; ++ks) dst[rr][ks] = *(const h16x8*)(kp_ + ks * 16); } } while (0)
    TBEG(1)
    LOADB(bf, 0);
#pragma unroll 1
    for (int rd = 0; rd < rounds; rd += 2) {
        LOADB(bn, rd + 1);
#pragma unroll
        for (int rr = 0; rr < 2; ++rr) {
            const int kt = (rd) * 16 + rr * 8 + wave;
            if (kt < nkt) {
                const int key = kt * 32 + l31; const bool kvalid = key < U.nk;
                f32x16 ccs[2];
#pragma unroll
                for (int r = 0; r < 16; ++r) { ccs[0][r] = 0.f; ccs[1][r] = 0.f; }
#pragma unroll
                for (int ks = 0; ks < 4; ++ks) { ccs[0] = __builtin_amdgcn_mfma_f32_32x32x16_f16(qa[0][ks], bf[rr][ks], ccs[0], 0, 0, 0); ccs[1] = __builtin_amdgcn_mfma_f32_32x32x16_f16(qa[1][ks], bf[rr][ks], ccs[1], 0, 0, 0); }
#pragma unroll
                for (int mt = 0; mt < 2; ++mt) {
                    const f32x16 cc = ccs[mt];
                    float sv[2]; bool ps[2];
                    const f32x2 thp = *(const f32x2*)(thrs + mt * 4 + 2 * half);
#pragma unroll
                    for (int e = 0; e < 2; ++e) {
                        f32x2 s2 = (f32x2){0.f, 0.f};
#pragma unroll
                        for (int h = 0; h < 4; ++h) {
                            const f32x2 r2 = (f32x2){__int_as_float(max(__float_as_int(cc[e * 8 + 2 * h]), 0)), __int_as_float(max(__float_as_int(cc[e * 8 + 2 * h + 1]), 0))};
                            s2 = __builtin_elementwise_fma(r2, wq[mt][e][h], s2);
                        }
                        const float s = s2.x + s2.y;
                        sv[e] = s; ps[e] = kvalid && (s > thp[e]);
                    }
                    const u64 bm0 = __ballot(ps[0]), bm1 = __ballot(ps[1]);
                    if (bm0 | bm1) {
                        const int ql = lane - mt * 4;
                        unsigned myc = 0u;
                        myc = (ql == 0) ? (unsigned)__popc((unsigned)bm0) : myc;
                        myc = (ql == 1) ? (unsigned)__popc((unsigned)bm1) : myc;
                        myc = (ql == 2) ? (unsigned)__popc((unsigned)(bm0 >> 32)) : myc;
                        myc = (ql == 3) ? (unsigned)__popc((unsigned)(bm1 >> 32)) : myc;
                        unsigned basev = 0u;
                        if ((unsigned)ql < 4u && myc) basev = atomicAdd(cnt + lane, myc);
                        const unsigned b00 = __builtin_amdgcn_readlane(basev, mt * 4), b01 = __builtin_amdgcn_readlane(basev, mt * 4 + 1);
                        const unsigned b10 = __builtin_amdgcn_readlane(basev, mt * 4 + 2), b11 = __builtin_amdgcn_readlane(basev, mt * 4 + 3);
                        const unsigned ltm = (1u << l31) - 1u;
                        if (ps[0]) { const unsigned hm = half ? (unsigned)(bm0 >> 32) : (unsigned)bm0; const unsigned pos = (half ? b10 : b00) + (unsigned)__popc(hm & ltm);
                            bufall[(size_t)(mt * 4 + 2 * half) * TK_C + pos] = ((u64)fkey(sv[0]) << 32) | (u64)(~(unsigned)key); }
                        if (ps[1]) { const unsigned hm = half ? (unsigned)(bm1 >> 32) : (unsigned)bm1; const unsigned pos = (half ? b11 : b01) + (unsigned)__popc(hm & ltm);
                            bufall[(size_t)(mt * 4 + 2 * half + 1) * TK_C + pos] = ((u64)fkey(sv[1]) << 32) | (u64)(~(unsigned)key); }
                    }
                }
            }
        }
        { TBEG(6)
        LDS_BARRIER();
        TEND(6) }
        bool need;
        { const u32x4 c0_ = *(const u32x4*)cnt, c1_ = *(const u32x4*)(cnt + 4); const unsigned m_ = max(max(max(c0_.x, c0_.y), max(c0_.z, c0_.w)), max(max(c1_.x, c1_.y), max(c1_.z, c1_.w))); need = m_ > (unsigned)TK_TRIG; }
        { TBEG(6)
        LDS_BARRIER();
        TEND(6) }
        if (need && (rd) + 1 < rounds) {
            TBEG(2)
            const int n = (int)cnt[wave];
            if (n > 256) { float t; const int nn = tk_compact(bufall + (size_t)wave * TK_C, hist, n, lane, t); if (lane == 0) { cnt[wave] = (unsigned)nn; thrs[wave] = t; } }
            __builtin_amdgcn_sched_barrier(0);
            LOADQ(); LOADQA(); LOADB(bn, rd + 1);
            LDS_BARRIER();
            TEND(2)
        }
        if (rd + 1 < rounds) {
        LOADB(bf, rd + 2);
#pragma unroll
        for (int rr = 0; rr < 2; ++rr) {
            const int kt = (rd + 1) * 16 + rr * 8 + wave;
            if (kt < nkt) {
                const int key = kt * 32 + l31; const bool kvalid = key < U.nk;
                f32x16 ccs[2];
#pragma unroll
                for (int r = 0; r < 16; ++r) { ccs[0][r] = 0.f; ccs[1][r] = 0.f; }
#pragma unroll
                for (int ks = 0; ks < 4; ++ks) { ccs[0] = __builtin_amdgcn_mfma_f32_32x32x16_f16(qa[0][ks], bn[rr][ks], ccs[0], 0, 0, 0); ccs[1] = __builtin_amdgcn_mfma_f32_32x32x16_f16(qa[1][ks], bn[rr][ks], ccs[1], 0, 0, 0); }
#pragma unroll
                for (int mt = 0; mt < 2; ++mt) {
                    const f32x16 cc = ccs[mt];
                    float sv[2]; bool ps[2];
                    const f32x2 thp = *(const f32x2*)(thrs + mt * 4 + 2 * half);
#pragma unroll
                    for (int e = 0; e < 2; ++e) {
                        f32x2 s2 = (f32x2){0.f, 0.f};
#pragma unroll
                        for (int h = 0; h < 4; ++h) {
                            const f32x2 r2 = (f32x2){__int_as_float(max(__float_as_int(cc[e * 8 + 2 * h]), 0)), __int_as_float(max(__float_as_int(cc[e * 8 + 2 * h + 1]), 0))};
                            s2 = __builtin_elementwise_fma(r2, wq[mt][e][h], s2);
                        }
                        const float s = s2.x + s2.y;
                        sv[e] = s; ps[e] = kvalid && (s > thp[e]);
                    }
                    const u64 bm0 = __ballot(ps[0]), bm1 = __ballot(ps[1]);
                    if (bm0 | bm1) {
                        const int ql = lane - mt * 4;
                        unsigned myc = 0u;
                        myc = (ql == 0) ? (unsigned)__popc((unsigned)bm0) : myc;
                        myc = (ql == 1) ? (unsigned)__popc((unsigned)bm1) : myc;
                        myc = (ql == 2) ? (unsigned)__popc((unsigned)(bm0 >> 32)) : myc;
                        myc = (ql == 3) ? (unsigned)__popc((unsigned)(bm1 >> 32)) : myc;
                        unsigned basev = 0u;
                        if ((unsigned)ql < 4u && myc) basev = atomicAdd(cnt + lane, myc);
                        const unsigned b00 = __builtin_amdgcn_readlane(basev, mt * 4), b01 = __builtin_amdgcn_readlane(basev, mt * 4 + 1);
                        const unsigned b10 = __builtin_amdgcn_readlane(basev, mt * 4 + 2), b11 = __builtin_amdgcn_readlane(basev, mt * 4 + 3);
                        const unsigned ltm = (1u << l31) - 1u;
                        if (ps[0]) { const unsigned hm = half ? (unsigned)(bm0 >> 32) : (unsigned)bm0; const unsigned pos = (half ? b10 : b00) + (unsigned)__popc(hm & ltm);
                            bufall[(size_t)(mt * 4 + 2 * half) * TK_C + pos] = ((u64)fkey(sv[0]) << 32) | (u64)(~(unsigned)key); }
                        if (ps[1]) { const unsigned hm = half ? (unsigned)(bm1 >> 32) : (unsigned)bm1; const unsigned pos = (half ? b11 : b01) + (unsigned)__popc(hm & ltm);
                            bufall[(size_t)(mt * 4 + 2 * half + 1) * TK_C + pos] = ((u64)fkey(sv[1]) << 32) | (u64)(~(unsigned)key); }
                    }
                }
            }
        }
        { TBEG(6)
        LDS_BARRIER();
        TEND(6) }
        bool need;
        { const u32x4 c0_ = *(const u32x4*)cnt, c1_ = *(const u32x4*)(cnt + 4); const unsigned m_ = max(max(max(c0_.x, c0_.y), max(c0_.z, c0_.w)), max(max(c1_.x, c1_.y), max(c1_.z, c1_.w))); need = m_ > (unsigned)TK_TRIG; }
        { TBEG(6)
        LDS_BARRIER();
        TEND(6) }
        if (need && (rd + 1) + 1 < rounds) {
            TBEG(2)
            const int n = (int)cnt[wave];
            if (n > 256) { float t; const int nn = tk_compact(bufall + (size_t)wave * TK_C, hist, n, lane, t); if (lane == 0) { cnt[wave] = (unsigned)nn; thrs[wave] = t; } }
            __builtin_amdgcn_sched_barrier(0);
            LOADQ(); LOADQA(); LOADB(bf, rd + 2);
            LDS_BARRIER();
            TEND(2)
        }
        }
    }
#undef LOADB
#undef LOADQ
#undef LOADQA
    TEND(1)
    }
    u64* buf = bufall + (size_t)wave * TK_C;
    TBEG(3)
    int n = (int)cnt[wave];
    if (n > 256) { float t; n = tk_compact(buf, hist, n, lane, t); }
    TEND(3)
    const int qrow = U.qrow0 + wave;
    int lane_o = lane; asm volatile("" : "+v"(lane_o));
    for (int repa_ = 0; repa_ < REP_ATT; ++repa_) {
    TBEG(4)
    float* P = (float*)((unsigned char*)buf + 4096);
    {
        const int fr = lane_o & 15, fq = lane_o >> 4;
        h16x8 qf[2];
#pragma unroll
        for (int ks = 0; ks < 2; ++ks) {
            if (fr < 8) qf[ks] = *(const h16x8*)(PROJ + (size_t)qrow * NPJ + C_Q + fr * 64 + ks * 32 + fq * 8);
            else {
#pragma unroll
                for (int j = 0; j < 8; ++j) qf[ks][j] = (h16)0.f; }
        }
        long q8[2];
#pragma unroll
        for (int ks = 0; ks < 2; ++ks) { f32x4 f0_, f1_;
#pragma unroll
            for (int j = 0; j < 4; ++j) { f0_[j] = (float)qf[ks][j]; f1_[j] = (float)qf[ks][4 + j]; }
            q8[ks] = (long)pack8_fp8(f0_, f1_); }
        h16x8 zero8;
#pragma unroll
        for (int j = 0; j < 8; ++j) zero8[j] = (h16)0.f;
        u32x4 ka[8], kb[8];
#define ISSUEK4(dst, g) do { _Pragma("unroll") for (int tt = 0; tt < 2; ++tt) { const int s_ = ((g) * 2 + tt) * 16 + fr; const unsigned idx_ = (s_ < n) ? ~(unsigned)buf[s_] : 0u; \
        const unsigned char* kr_ = U.kvb + (size_t)(U.krow0 + (int)idx_) * 512 + fq * 16; \
        _Pragma("unroll") for (int j = 0; j < 4; ++j) dst[tt * 4 + j] = *(const u32x4*)(kr_ + j * 64); } } while (0)
#define COMPK4(src, g) do { _Pragma("unroll") for (int tt = 0; tt < 2; ++tt) { f32x4 c_ = (f32x4){0.f, 0.f, 0.f, 0.f}; \
        _Pragma("unroll") for (int j = 0; j < 4; ++j) { const u32x4 w_ = src[tt * 4 + j]; \
            const long a0_ = ((fr >> 1) == j) ? q8[0] : 0l, a1_ = ((fr >> 1) == j) ? q8[1] : 0l; \
            c_ = __builtin_amdgcn_mfma_f32_16x16x32_fp8_fp8(a0_, (long)((u64)w_.x | ((u64)w_.y << 32)), c_, 0, 0, 0); \
            c_ = __builtin_amdgcn_mfma_f32_16x16x32_fp8_fp8(a1_, (long)((u64)w_.z | ((u64)w_.w << 32)), c_, 0, 0, 0); } \
        const int s_ = ((g) * 2 + tt) * 16 + fr; const bool v_ = s_ < n; \
        _Pragma("unroll") for (int r = 0; r < 4; ++r) c_[r] = v_ ? c_[r] * 0.125f : -1e30f; \
        if (fq < 2) *(f32x4*)(P + s_ * 8 + fq * 4) = c_; } } while (0)
        ISSUEK4(ka, 0);
#pragma unroll 1
        for (int g = 0; g < 8; g += 2) {
            ISSUEK4(kb, g + 1);
            COMPK4(ka, g);
            ISSUEK4(ka, g + 2);
            COMPK4(kb, g + 1);
        }
#undef ISSUEK4
#undef COMPK4
        __builtin_amdgcn_s_waitcnt(0); asm volatile("" ::: "memory");
        f32x4 acc[16];
#pragma unroll
        for (int t = 0; t < 16; ++t) acc[t] = *(const f32x4*)(P + (t * 16 + fr) * 8 + (fq & 1) * 4);
        float mx[4] = {-1e30f, -1e30f, -1e30f, -1e30f};
#pragma unroll
        for (int t = 0; t < 16; ++t) { const bool v = (t * 16 + fr) < n;
#pragma unroll
            for (int r = 0; r < 4; ++r) { mx[r] = fmaxf(mx[r], acc[t][r]); } }
#pragma unroll
        for (int r = 0; r < 4; ++r) mx[r] = row16_max(mx[r]);
        float sm[4] = {0.f, 0.f, 0.f, 0.f};
#pragma unroll
        for (int t = 0; t < 16; ++t) { const bool v = (t * 16 + fr) < n;
#pragma unroll
            for (int r = 0; r < 4; ++r) { const float e = v ? __expf(acc[t][r] - mx[r]) : 0.f; acc[t][r] = e; sm[r] += e; } }
#pragma unroll
        for (int r = 0; r < 4; ++r) sm[r] = row16_sum(sm[r]);
        __builtin_amdgcn_s_waitcnt(0); asm volatile("" ::: "memory");
        if (fq < 2) {
#pragma unroll
            for (int t = 0; t < 16; ++t) *(f32x4*)(P + (t * 16 + fr) * 8 + fq * 4) = acc[t];
            if (fr == 0) {
#pragma unroll
                for (int r = 0; r < 4; ++r) sums[fq * 4 + r] = sm[r]; }
        }
        __builtin_amdgcn_s_waitcnt(0); asm volatile("" ::: "memory");
    }
    TEND(4)
    TBEG(5)
    {
        const int sg = lane_o >> 4, part = lane_o & 15, kv = part >> 2, d0 = (part & 3) * 16;
        f32x2 o0[8], o1[8];
#pragma unroll
        for (int j = 0; j < 8; ++j) { o0[j] = (f32x2){0.f, 0.f}; o1[j] = (f32x2){0.f, 0.f}; }
        u32x4 va[8], vb[8];
        const unsigned char* vbase = U.kvb + 256 + kv * 64 + d0;
#define ISSUEV16(dst, gi) do { _Pragma("unroll") for (int ii = 0; ii < 8; ++ii) { const int s_ = 4 * ((gi) * 8 + ii) + sg; const unsigned idx_ = (s_ < n) ? ~(unsigned)buf[s_] : 0u; \
        dst[ii] = *(const u32x4*)(vbase + (size_t)(U.krow0 + (int)idx_) * 512); } } while (0)
#define COMPV16(src, gi) do { _Pragma("unroll") for (int ii = 0; ii < 8; ++ii) { const int s_ = 4 * ((gi) * 8 + ii) + sg; const f32x2 pp = *(const f32x2*)(P + (s_ & 255) * 8 + 2 * kv); const f32x2 px_ = (f32x2){pp.x, pp.x}, py_ = (f32x2){pp.y, pp.y}; const u32x4 w_ = src[ii]; \
        _Pragma("unroll") for (int q_ = 0; q_ < 4; ++q_) { const int ww_ = (int)w_[q_]; \
            const f32x2 xa_ = __builtin_amdgcn_cvt_pk_f32_fp8(ww_, false), xb_ = __builtin_amdgcn_cvt_pk_f32_fp8(ww_, true); \
            o0[q_ * 2] = __builtin_elementwise_fma(xa_, px_, o0[q_ * 2]); o0[q_ * 2 + 1] = __builtin_elementwise_fma(xb_, px_, o0[q_ * 2 + 1]); \
            o1[q_ * 2] = __builtin_elementwise_fma(xa_, py_, o1[q_ * 2]); o1[q_ * 2 + 1] = __builtin_elementwise_fma(xb_, py_, o1[q_ * 2 + 1]); } } } while (0)
        ISSUEV16(va, 0);
#pragma unroll 1
        for (int gi = 0; gi < 8; gi += 2) {
            ISSUEV16(vb, gi + 1);
            COMPV16(va, gi);
            ISSUEV16(va, gi + 2);
            COMPV16(vb, gi + 1);
        }
#undef ISSUEV16
#undef COMPV16
#pragma unroll
        for (int j = 0; j < 8; ++j) { o0[j].x = x32_sum(x16_sum(o0[j].x)); o0[j].y = x32_sum(x16_sum(o0[j].y)); o1[j].x = x32_sum(x16_sum(o1[j].x)); o1[j].y = x32_sum(x16_sum(o1[j].y)); }
        if (sg == 0) {
            const float i0 = 1.f / sums[2 * kv], i1 = 1.f / sums[2 * kv + 1];
            const h16* pz = PROJ + (size_t)qrow * NPJ + C_ZB + (2 * kv) * 64 + d0;
            h16* po = (h16*)(p.ws + WS_BOUT) + (size_t)qrow * 512 + (2 * kv) * 64 + d0;
#pragma unroll
            for (int hh = 0; hh < 2; ++hh) {
                const h16x8 za = *(const h16x8*)(pz + hh * 64), zb = *(const h16x8*)(pz + hh * 64 + 8);
                h16x8 ra, rb;
#pragma unroll
                for (int j = 0; j < 8; ++j) { const float oa = hh ? o1[j >> 1][j & 1] : o0[j >> 1][j & 1], ob = hh ? o1[4 + (j >> 1)][j & 1] : o0[4 + (j >> 1)][j & 1]; const float ii = hh ? i1 : i0;
                    ra[j] = (h16)(oa * ii * siluf_((float)za[j])); rb[j] = (h16)(ob * ii * siluf_((float)zb[j])); }
                *(h16x8*)(po + hh * 64) = ra; *(h16x8*)(po + hh * 64 + 8) = rb;
            }
        }
    }
    TEND(5)
    }
    __syncthreads();
}

__global__ void __launch_bounds__(512, 2) mk_fwd(Params p) {
    __builtin_assume(__builtin_amdgcn_workitem_id_y() == 0); __builtin_assume(__builtin_amdgcn_workitem_id_z() == 0);
    extern __shared__ __attribute__((aligned(16))) unsigned char lds[];
    cg::grid_group grid = cg::this_grid();
    const int wave = __builtin_amdgcn_readfirstlane((int)threadIdx.x >> 6);
    const int G = gridDim.x, bx = blockIdx.x;
    const int gw = bx * 8 + wave, NGW = G * 8;
    const int lo = p.ph_lo, hi = p.ph_hi;
    unsigned long long tacc = 0;
#define IN(k) (lo <= (k) && (k) < hi)
#define SEAM(k) do { if (IN(k) && IN((k) + 1)) grid.sync(); } while (0)
    h16* XH = (h16*)(p.ws + WS_XH); h16* PROJ = (h16*)(p.ws + WS_PROJ);
    h16* WIN = (h16*)(p.ws + WS_WIN); h16* WPA = (h16*)(p.ws + WS_WPA); h16* WPB = (h16*)(p.ws + WS_WPB); h16* WOUT = (h16*)(p.ws + WS_WOUT);
    h16* WSM = (h16*)(p.ws + WS_WSM); h16* KVS = (h16*)(p.ws + WS_KVS); h16* KIS = (h16*)(p.ws + WS_KIS);
    float* RSTD = (float*)(p.ws + WS_RSTD); float* ROWSS = (float*)(p.ws + WS_ROWSS);

    if (IN(0)) for (int rep_ = 0; rep_ < REP_P0; ++rep_) {
        const int lane = lane_id(), tid = wave * 64 + lane;
        float* scr = (float*)(lds + wave * 16384);
        constexpr int I_IN = 16 * (NPJ / 32), I_PA = 8 * 32, I_PB = 8 * 32, I_OUT = 16 * 32;
        for (int it = gw; it < I_IN + I_PA + I_PB + I_OUT; it += NGW) {
            int r = it;
            if (r < I_IN) { p0_tr_item(p.w_in, 1024, INW, WIN, p.norm_g, 1, scr, r, NPJ / 32, lane); continue; } r -= I_IN;
            if (r < I_PA) { p0_tr_item(p.w_pa, 512, 1024, WPA, nullptr, 0, scr, r, 32, lane); continue; } r -= I_PA;
            if (r < I_PB) { p0_tr_item(p.w_pb, 512, 1024, WPB, nullptr, 0, scr, r, 32, lane); continue; } r -= I_PB;
            p0_tr_item(p.w_out, 1024, 1024, WOUT, nullptr, 0, scr, r, 32, lane);
        }
        for (int m = gw; m < MT; m += NGW) {
            u64* o8 = (u64*)(XH + (size_t)m * DM) + lane;
            if (m < MROWS) {
                const float* xr = (m < MP) ? p.xp + (size_t)m * DM : p.xs + (size_t)(m - MP) * DM;
                const f32x4* x4 = (const f32x4*)xr + lane;
                f32x4 v[4]; float s = 0.f;
#pragma unroll
                for (int j = 0; j < 4; ++j) { v[j] = x4[64 * j]; s += (v[j].x * v[j].x + v[j].y * v[j].y) + (v[j].z * v[j].z + v[j].w * v[j].w); }
                s = wave_sum(s);
                if (lane == 0) RSTD[m] = rsqrtf(s * (1.f / 1024.f) + 1e-6f);
#pragma unroll
                for (int j = 0; j < 4; ++j) { h16x4 h; h[0] = (h16)v[j].x; h[1] = (h16)v[j].y; h[2] = (h16)v[j].z; h[3] = (h16)v[j].w; o8[64 * j] = __builtin_bit_cast(u64, h); }
            } else {
                if (lane == 0) RSTD[m] = 0.f;
#pragma unroll
                for (int j = 0; j < 4; ++j) o8[64 * j] = 0ull;
            }
        }
        const int gt = bx * 512 + tid, NGT = G * 512;
        for (int i = gt; i < NB * NKSP * 64; i += NGT) {
            const int c8 = (i & 63) * 8, r = (i >> 6) % NKSP, b = (i >> 6) / NKSP;
            if (r >= PAST && r < NKS) continue;
            f32x4 f0 = (f32x4){0.f, 0.f, 0.f, 0.f}, f1 = f0;
            if (r < PAST) { const float* src = (c8 < 256) ? p.ck + ((size_t)b * PAST + r) * 256 + c8 : p.cv + ((size_t)b * PAST + r) * 256 + (c8 - 256);
                f0 = *(const f32x4*)src; f1 = *(const f32x4*)(src + 4); }
            *(u64*)((unsigned char*)KVS + ((size_t)b * NKSP + r) * 512 + kvpos(c8)) = pack8_fp8(f0, f1);
        }
        for (int i = gt; i < NB * NKSP * 8; i += NGT) {
            const int c8 = (i & 7) * 8, r = (i >> 3) % NKSP, b = (i >> 3) / NKSP;
            if (r >= PAST && r < NKS) continue;
            h16x8 h;
            if (r < PAST) { const float* src = p.cki + ((size_t)b * PAST + r) * 64 + c8;
#pragma unroll
                for (int j = 0; j < 8; ++j) h[j] = (h16)src[j]; }
            else {
#pragma unroll
                for (int j = 0; j < 8; ++j) h[j] = (h16)0.f; }
            *(h16x8*)(KIS + ((size_t)b * NKSP + r) * 64 + c8) = h;
        }
        for (int i = gt; i < 8 * 128 * 128; i += NGT) { const int j = i & 127, ii = (i >> 7) & 127; WSM[i] = ((j >> 6) <= (ii >> 6)) ? (h16)p.sgu_w[i] : (h16)0.f; }
    }
    SEAM(0);
    if (IN(1)) for (int rep_ = 0; rep_ < REP_P1; ++rep_) {
        pg8::Gemm g{XH, WIN, MT, NPJ, 1024, 1024}; pg8::StaticOrder S; S.init(MT, NPJ, G, bx);
        EpiProj E{PROJ, RSTD, p.out, (unsigned char*)KVS, KIS, (unsigned char*)(p.ws + WS_KVC), (h16*)(p.ws + WS_KIC)};
        pg8::gemm_phase<EpiProj>((LAS unsigned char*)lds, g, S, E);
    }
    SEAM(1);
    if (IN(2)) for (int rep_ = 0; rep_ < REP_P2; ++rep_) {
        for (int u = bx; u < 512 + NB; u += G) { const int lane = lane_id(); if (u < 512) sgu_chunk(p, lds, u, wave, lane); else sgu_sample(p, lds, u - 512, wave, lane); }
    }
    if (IN(3)) for (int rep_ = 0; rep_ < REP_P3; ++rep_) {
        for (int u = bx; u < 8192 + 16; u += G) {
            AUnit U;
            if (u < 8192) { const int i = u >> 8, gp = u & 255, b = gp & 7, s = gp >> 3; const int jt = s + 32 * i;
                U.qrow0 = b * SEQ + jt * 8; U.krow0 = b * SEQ; U.nk = ((jt * 8) / 64 + 1) * 64; U.kib = (const h16*)(p.ws + WS_KIC); U.kis = 64; U.kvb = (const unsigned char*)(p.ws + WS_KVC); U.kvs = 512; }
            else { const int v = u - 8192, b = v >> 1, hf = v & 1;
                U.qrow0 = MP + b * 16 + hf * 8; U.krow0 = b * NKSP; U.nk = NKS; U.kib = KIS; U.kis = 64; U.kvb = (const unsigned char*)KVS; U.kvs = 512; }
            attn_unit(p, lds, U, wave, lane_id(), tacc);
        }
    }
    SEAM(3);
    if (IN(4)) for (int rep_ = 0; rep_ < REP_P4; ++rep_) {
        { pg8::Gemm g{(const h16*)(p.ws + WS_AOUT), WPA, MT, 1024, 512, 512}; pg8::StaticOrder S; S.init(MT, 1024, G, bx); EpiGate<1> E{PROJ}; pg8::gemm_phase<EpiGate<1>>((LAS unsigned char*)lds, g, S, E); }
        { pg8::Gemm g{(const h16*)(p.ws + WS_BOUT), WPB, MT, 1024, 512, 512}; pg8::StaticOrder S; S.init(MT, 1024, G, bx); EpiGate<0> E{PROJ}; pg8::gemm_phase<EpiGate<0>>((LAS unsigned char*)lds, g, S, E); }
    }
    SEAM(4);
    if (IN(5)) for (int rep_ = 0; rep_ < REP_P5; ++rep_) {
        pg8::Gemm g{PROJ + C_M, WOUT, MT, 1024, 1024, NPJ}; pg8::StaticOrder S; S.init(MT, 1024, G, bx);
        EpiOut E{p.xp, p.xs, p.out, ROWSS};
        pg8::gemm_phase<EpiOut>((LAS unsigned char*)lds, g, S, E);
    }
    SEAM(5);
    if (IN(6)) {
        const int lane = lane_id();
        for (int m = gw; m < MROWS; m += NGW) {
            float* yr = (m < MP) ? p.out + O_YP + (size_t)m * DM : p.out + O_YS + (size_t)(m - MP) * DM;
            float ssum = (lane < 16) ? ROWSS[(size_t)m * 16 + lane] : 0.f; ssum = wave_sum(ssum);
            const float r = rsqrtf(ssum * (1.f / 1024.f) + 1e-6f);
            const int lane6 = lane;
            f32x4* y4 = (f32x4*)yr + lane6; const f32x4* g4 = (const f32x4*)p.final_g + lane6;
#pragma unroll
            for (int j = 0; j < 4; ++j) { f32x4 v = y4[64 * j]; const f32x4 gg = g4[64 * j]; v = v * r * gg; y4[64 * j] = v; }
        }
    }
    if (TSEL != 0 && bx == 0 && threadIdx.x == 0) { const unsigned long long t0 = rt_(); while (rt_() - t0 < tacc) __builtin_amdgcn_s_sleep(8); }
#undef IN
#undef SEAM
}

extern "C" void kernel_launch(void* const* d_in, const int* in_sizes, int n_in, void* d_out, int out_size, void* d_ws, size_t ws_size, hipStream_t stream) {
    static int grid_blocks = 0;
    if (grid_blocks == 0) {
        if (ws_size < WS_END) { fprintf(stderr, "kernel_launch: workspace too small: %zu < %zu\n", ws_size, (size_t)WS_END); grid_blocks = -1; return; }
        int dev = 0, cus = 0, per_cu = 0;
        hipGetDevice(&dev);
        hipDeviceGetAttribute(&cus, hipDeviceAttributeMultiprocessorCount, dev);
        hipFuncSetAttribute((const void*)mk_fwd, hipFuncAttributeMaxDynamicSharedMemorySize, LDS_BYTES);
        hipOccupancyMaxActiveBlocksPerMultiprocessor(&per_cu, (const void*)mk_fwd, 512, LDS_BYTES);
        if (per_cu < 1) { fprintf(stderr, "kernel_launch: occupancy query says %d blocks per CU\n", per_cu); per_cu = 1; }
        grid_blocks = cus * per_cu;
        (void)hipGetLastError();
    }
    if (grid_blocks < 0) return;
    Params p{};
    p.xp = (const float*)d_in[0]; p.xs = (const float*)d_in[1]; p.ck = (const float*)d_in[2]; p.cv = (const float*)d_in[3]; p.cki = (const float*)d_in[4];
    p.norm_g = (const float*)d_in[5]; p.w_in = (const float*)d_in[6]; p.ln_g = (const float*)d_in[7]; p.ln_b = (const float*)d_in[8];
    p.sgu_w = (const float*)d_in[9]; p.sgu_b = (const float*)d_in[10]; p.w_pa = (const float*)d_in[11]; p.w_pb = (const float*)d_in[12];
    p.w_out = (const float*)d_in[13]; p.final_g = (const float*)d_in[14];
    p.out = (float*)d_out; p.ws = (unsigned char*)d_ws; p.ph_lo = 0; p.ph_hi = 7;
    void* args[] = {&p};
    hipError_t e = hipLaunchCooperativeKernel((const void*)mk_fwd, dim3(grid_blocks), dim3(512), args, LDS_BYTES, stream);
    if (e != hipSuccess) fprintf(stderr, "cooperative launch failed: %s (grid %d)\n", hipGetErrorString(e), grid_blocks);
}
```

```cpp
#include <hip/hip_runtime.h>
#include <hip/hip_cooperative_groups.h>
#include <cstdio>
#include <cstdint>
namespace cg = cooperative_groups;
#define REP_P0 1
#define REP_P1 1
#define REP_P2 1
#define REP_P3 1
#define REP_IDX 1
#define REP_ATT 1
#define TSEL 0
#define LDS_BARRIER() do { asm volatile("s_waitcnt lgkmcnt(0)" ::: "memory"); __builtin_amdgcn_s_barrier(); asm volatile("" ::: "memory"); } while (0)
__device__ __forceinline__ unsigned long long rt_() { return __builtin_amdgcn_s_memrealtime(); }
#define TBEG(k) unsigned long long tb_##k = 0; if (TSEL == (k)) tb_##k = rt_();
#define TEND(k) if (TSEL == (k)) tacc += rt_() - tb_##k;
#define REP_P4 1
#define REP_P5 1

#define LAS __attribute__((address_space(3)))
typedef _Float16 h16;
typedef _Float16 h16x8 __attribute__((ext_vector_type(8)));
typedef _Float16 h16x4 __attribute__((ext_vector_type(4)));
typedef _Float16 h16x2 __attribute__((ext_vector_type(2)));
typedef float f32x2 __attribute__((ext_vector_type(2)));
typedef float f32x4 __attribute__((ext_vector_type(4)));
typedef float f32x16 __attribute__((ext_vector_type(16)));
typedef unsigned u32x4 __attribute__((ext_vector_type(4)));
typedef unsigned u32x2 __attribute__((ext_vector_type(2)));
typedef unsigned long long u64;

constexpr int DM = 1024, SEQ = 8192, NB = 8, MP = NB * SEQ;
constexpr int DSQ = 16, MS = NB * DSQ, PAST = 1024, NKS = PAST + DSQ, NKSP = 1056;
constexpr int MROWS = MP + MS;
constexpr int MT = MP + 256;
constexpr int INW = 5704, NPJ = 5888;
constexpr int C_U = 0, C_V = 512, C_ZA = 1024, C_Q = 1536, C_K = 2048, C_VV = 2304, C_ZB = 2560, C_QI = 3072, C_KI = 3584, C_WI = 3648, C_GA = 3840, C_GB = 4864;
constexpr size_t O_YP = 0, O_YS = 67108864, O_PK = 67239936, O_PV = 84017152, O_PKI = 100794368, O_SK = 104988672, O_SV = 105021440, O_SKI = 105054208, O_SSV = 105062400;
constexpr size_t WS_XH = 0;
constexpr size_t WS_PROJ = WS_XH + (size_t)MT * DM * 2;
constexpr size_t WS_WIN = WS_PROJ + (size_t)MT * NPJ * 2;
constexpr size_t WS_WPA = WS_WIN + (size_t)NPJ * DM * 2;
constexpr size_t WS_WPB = WS_WPA + (size_t)1024 * 512 * 2;
constexpr size_t WS_WOUT = WS_WPB + (size_t)1024 * 512 * 2;
constexpr size_t WS_WSM = WS_WOUT + (size_t)1024 * 1024 * 2;
constexpr size_t WS_KVS = WS_WSM + (size_t)8 * 128 * 128 * 2;
constexpr size_t WS_KIS = WS_KVS + (size_t)NB * NKSP * 512 * 2;
constexpr size_t WS_RSTD = WS_KIS + (size_t)NB * NKSP * 64 * 2;
constexpr size_t WS_ROWSS = WS_RSTD + (size_t)MT * 4;
constexpr size_t WS_KIC = WS_ROWSS + (size_t)MT * 16 * 4;
constexpr size_t WS_KVC = WS_KIC + (size_t)MP * 64 * 2;
constexpr size_t WS_END = WS_KVC + (size_t)MP * 512 * 2;
constexpr size_t WS_AOUT = WS_XH, WS_BOUT = WS_XH + (size_t)MT * 512 * 2;
constexpr int C_T = 0, C_M = 1024;
constexpr int LDS_BYTES = 155648;

__device__ __forceinline__ float sigmoidf_(float x) { return __builtin_amdgcn_rcpf(1.f + __expf(-x)); }
__device__ __forceinline__ float siluf_(float x) { return x * __builtin_amdgcn_rcpf(1.f + __expf(-x)); }
__device__ __forceinline__ float geluf_(float x) { const float t = 1.5957691216057308f * (x + 0.044715f * x * x * x); return x * __builtin_amdgcn_rcpf(1.f + __expf(-t)); }
__device__ __forceinline__ int lane_id() { int l; asm volatile("v_mbcnt_lo_u32_b32 %0, -1, 0\n\tv_mbcnt_hi_u32_b32 %0, -1, %0" : "=v"(l)); return l; }
#define DPPF_(v, ctrl) __builtin_bit_cast(float, __builtin_amdgcn_update_dpp(0, __builtin_bit_cast(int, (v)), (ctrl), 0xF, 0xF, true))
#define DPPU_(v, ctrl) ((unsigned)__builtin_amdgcn_update_dpp(0, (int)(v), (ctrl), 0xF, 0xF, true))
__device__ __forceinline__ float row16_sum(float v) { v += DPPF_(v, 0xB1); v += DPPF_(v, 0x4E); v += DPPF_(v, 0x141); v += DPPF_(v, 0x140); return v; }
__device__ __forceinline__ float row16_max(float v) { v = fmaxf(v, DPPF_(v, 0xB1)); v = fmaxf(v, DPPF_(v, 0x4E)); v = fmaxf(v, DPPF_(v, 0x141)); v = fmaxf(v, DPPF_(v, 0x140)); return v; }
__device__ __forceinline__ float x16_sum(float v) { const unsigned u = __builtin_bit_cast(unsigned, v); const auto r = __builtin_amdgcn_permlane16_swap(u, u, false, false); return __builtin_bit_cast(float, (unsigned)r[0]) + __builtin_bit_cast(float, (unsigned)r[1]); }
__device__ __forceinline__ float x32_sum(float v) { const unsigned u = __builtin_bit_cast(unsigned, v); const auto r = __builtin_amdgcn_permlane32_swap(u, u, false, false); return __builtin_bit_cast(float, (unsigned)r[0]) + __builtin_bit_cast(float, (unsigned)r[1]); }
__device__ __forceinline__ float wave_sum(float v) { return x32_sum(x16_sum(row16_sum(v))); }
__device__ __forceinline__ unsigned wave_min_u(unsigned v) { v = min(v, DPPU_(v, 0xB1)); v = min(v, DPPU_(v, 0x4E)); v = min(v, DPPU_(v, 0x141)); v = min(v, DPPU_(v, 0x140));
    { const auto r = __builtin_amdgcn_permlane16_swap(v, v, false, false); v = min((unsigned)r[0], (unsigned)r[1]); } { const auto r = __builtin_amdgcn_permlane32_swap(v, v, false, false); v = min((unsigned)r[0], (unsigned)r[1]); } return v; }
__device__ __forceinline__ unsigned wave_max_u(unsigned v) { v = max(v, DPPU_(v, 0xB1)); v = max(v, DPPU_(v, 0x4E)); v = max(v, DPPU_(v, 0x141)); v = max(v, DPPU_(v, 0x140));
    { const auto r = __builtin_amdgcn_permlane16_swap(v, v, false, false); v = max((unsigned)r[0], (unsigned)r[1]); } { const auto r = __builtin_amdgcn_permlane32_swap(v, v, false, false); v = max((unsigned)r[0], (unsigned)r[1]); } return v; }

namespace pg8 {
constexpr int BM = 256, BK = 64, HALF = 128, HTB = HALF * BK * 2, STAGE_BYTES = 8 * HTB, NXCD = 8, WGM = 8;
__host__ __device__ __forceinline__ int lds_byte(int r, int c) { const int st = (r >> 4) * 2 + (c >> 5), rr = r & 15, cc = c & 31, ob = rr * 64 + cc * 2; return st * 1024 + (ob ^ (((ob >> 9) & 1) << 5)); }
__host__ __device__ __forceinline__ void stage_rc(int b, int& R, int& C) { const int st = b / 1024, sb = b % 1024, swz = sb ^ (((sb >> 9) & 1) << 5); R = (st >> 1) * 16 + swz / 64; C = (st & 1) * 32 + (swz % 64) / 2; }
__host__ __device__ __forceinline__ int perm32(int rho) { const int n = rho >> 4, i = rho & 15; return 8 * (i >> 2) + 4 * n + (i & 3); }
struct Unit { int pm, pn; };
struct Gemm { const h16* A; const h16* Bt; int M, N, K, lda; };
struct StaticOrder {
    int nM, nN, nwg, G, c;
    __device__ void init(int M, int N, int G_, int c_) { nM = M / BM; nN = N / BM; nwg = nM * nN; G = G_; c = c_; }
    __device__ bool next(int i, Unit& u) const {
        const long L = (long)i * G + c; if (L >= nwg) return false;
        int wgid = (int)L; { const int q = nwg / NXCD, r = nwg % NXCD, xcd = wgid % NXCD, off = wgid / NXCD; wgid = (xcd < r ? xcd * (q + 1) : r * (q + 1) + (xcd - r) * q) + off; }
        const int nig = WGM * nN, gid = wgid / nig, fm = gid * WGM, gsz = (nM - fm) < WGM ? (nM - fm) : WGM;
        u.pm = fm + ((wgid % nig) % gsz); u.pn = (wgid % nig) / gsz; return true;
    }
};
template <class Epi>
__device__ __forceinline__ void gemm_phase(LAS unsigned char* lds, const Gemm g, const StaticOrder& S, const Epi& E) {
    const int tid = threadIdx.x, wid = __builtin_amdgcn_readfirstlane(tid >> 6), lane = tid & 63, wr = wid >> 2, wc = wid & 3, fr = lane & 15, fq = lane >> 4;
    const int K = g.K, nt = K / BK, lda = g.lda;
    unsigned voffA[2], voffB[2];
#pragma unroll
    for (int i = 0; i < 2; ++i) { int R, C; stage_rc(tid * 16 + i * 8192, R, C); const int Rb = (R & ~31) + perm32(R & 31);
        voffA[i] = (unsigned)(R * lda + C) * 2u; voffB[i] = (unsigned)(Rb * K + C) * 2u; }
    const size_t kstep = (size_t)(BK * 2);
    const size_t hstepA = (size_t)HALF * lda * 2, hstepB = (size_t)HALF * K * 2;
    const size_t tstepA = 2 * hstepA, tstepB = 2 * hstepB;
    const unsigned ldsw = (unsigned)wid * 1024u;
    const int aoff = lds_byte(wr * 64 + fr, fq * 8), boff = lds_byte(wc * 32 + fr, fq * 8);
#define PG8_SA(b, h) (((b) * 2 + (h)) * HTB)
#define PG8_SB(b, h) ((4 + (b) * 2 + (h)) * HTB)
#define PG8_STAGE(bufoff, gbase, voff) do { _Pragma("unroll") for (int _i = 0; _i < 2; ++_i) \
        __builtin_amdgcn_global_load_lds((const unsigned*)((const char*)(gbase) + (voff)[_i]), (LAS unsigned*)(lds + (bufoff) + ldsw + _i * 8192), 16, 0, 0); } while (0)
#define PG8_LDA(dst, b, h) do { _Pragma("unroll") for (int m = 0; m < 4; ++m) _Pragma("unroll") for (int k = 0; k < 2; ++k) dst[m][k] = *(const LAS h16x8*)(lds + PG8_SA(b, h) + aoff + m * 2048 + k * 1024); } while (0)
#define PG8_LDB(dst, b, h) do { _Pragma("unroll") for (int n = 0; n < 2; ++n) _Pragma("unroll") for (int k = 0; k < 2; ++k) dst[n][k] = *(const LAS h16x8*)(lds + PG8_SB(b, h) + boff + n * 2048 + k * 1024); } while (0)
#define PG8_MMA(ai, bj, At, Bt) do { __builtin_amdgcn_s_setprio(1); _Pragma("unroll") for (int m = 0; m < 4; ++m) _Pragma("unroll") for (int n = 0; n < 2; ++n) _Pragma("unroll") for (int k = 0; k < 2; ++k) \
        acc[ai][bj][m][n] = __builtin_amdgcn_mfma_f32_16x16x32_f16(Bt[n][k], At[m][k], acc[ai][bj][m][n], 0, 0, 0); __builtin_amdgcn_s_setprio(0); } while (0)
#define PG8_WAIT_V(n) asm volatile("s_waitcnt vmcnt(" #n ")" ::: "memory")
#define PG8_WAIT_L(n) asm volatile("s_waitcnt lgkmcnt(" #n ")" ::: "memory")
#define PG8_BAR __builtin_amdgcn_s_barrier()
#define PG8_SCHED __builtin_amdgcn_sched_barrier(0)
    Unit cur, nxt; int ui = 0;
    if (!S.next(0, cur)) return;
    f32x4 acc[2][2][4][2];
#pragma unroll
    for (int a = 0; a < 2; ++a)
#pragma unroll
        for (int b = 0; b < 2; ++b)
#pragma unroll
            for (int m = 0; m < 4; ++m)
#pragma unroll
                for (int n = 0; n < 2; ++n) acc[a][b][m][n] = (f32x4){0.f, 0.f, 0.f, 0.f};
    h16x8 At[4][2], B0[2][2], B1[2][2];
    const char* cA = (const char*)g.A + (size_t)cur.pm * tstepA; const char* cB = (const char*)g.Bt + (size_t)cur.pn * tstepB;
    PG8_STAGE(PG8_SB(0, 0), cB, voffB); PG8_STAGE(PG8_SB(0, 1), cB + hstepB, voffB); PG8_STAGE(PG8_SA(0, 0), cA, voffA); PG8_STAGE(PG8_SA(0, 1), cA + hstepA, voffA);
    if (wr == 1) PG8_BAR;
    PG8_WAIT_V(2); PG8_BAR;
    PG8_STAGE(PG8_SB(1, 0), cB + kstep, voffB); PG8_STAGE(PG8_SA(1, 0), cA + kstep, voffA); PG8_STAGE(PG8_SB(1, 1), cB + hstepB + kstep, voffB);
    PG8_WAIT_V(6); PG8_BAR;
    for (;;) {
        const bool has_next = S.next(ui + 1, nxt);
        const char* nA = has_next ? (const char*)g.A + (size_t)nxt.pm * tstepA : cA; const char* nB = has_next ? (const char*)g.Bt + (size_t)nxt.pn * tstepB : cB;
        for (int t = 0; t < nt; t += 2) {
            const bool last = (t == nt - 2);
            const char* a1 = cA + (size_t)(t + 1) * kstep;
            const char* a2 = last ? nA : cA + (size_t)(t + 2) * kstep; const char* b2 = last ? nB : cB + (size_t)(t + 2) * kstep;
            const char* a3 = a2 + kstep; const char* b3 = b2 + kstep;
            PG8_LDB(B0, 0, 0); PG8_LDB(B1, 0, 1); PG8_SCHED; PG8_LDA(At, 0, 0); PG8_STAGE(PG8_SA(1, 1), a1 + hstepA, voffA);
            PG8_WAIT_V(8); PG8_WAIT_L(0); PG8_BAR; PG8_MMA(0, 0, At, B0); PG8_MMA(0, 1, At, B1); PG8_BAR; PG8_SCHED;
            PG8_LDA(At, 0, 1); PG8_STAGE(PG8_SB(0, 0), b2, voffB); PG8_STAGE(PG8_SB(0, 1), b2 + hstepB, voffB); PG8_STAGE(PG8_SA(0, 0), a2, voffA);
            PG8_WAIT_V(8); PG8_WAIT_L(0); PG8_BAR; PG8_MMA(1, 0, At, B0); PG8_MMA(1, 1, At, B1); PG8_BAR; PG8_SCHED;
            PG8_LDB(B0, 1, 0); PG8_LDB(B1, 1, 1); PG8_SCHED; PG8_LDA(At, 1, 0); PG8_STAGE(PG8_SA(0, 1), a2 + hstepA, voffA);
            PG8_WAIT_V(8); PG8_WAIT_L(0); PG8_BAR; PG8_MMA(0, 0, At, B0); PG8_MMA(0, 1, At, B1); PG8_BAR; PG8_SCHED;
            PG8_LDA(At, 1, 1); PG8_STAGE(PG8_SB(1, 0), b3, voffB); PG8_STAGE(PG8_SB(1, 1), b3 + hstepB, voffB); PG8_STAGE(PG8_SA(1, 0), a3, voffA);
            PG8_WAIT_V(8); PG8_WAIT_L(0); PG8_BAR; PG8_MMA(1, 0, At, B0); PG8_MMA(1, 1, At, B1); PG8_BAR; PG8_SCHED;
        }
        if (wr == 0) PG8_BAR;
        E(acc, cur, wr, wc, fr, fq);
        if (!has_next) break;
#pragma unroll
        for (int a = 0; a < 2; ++a)
#pragma unroll
            for (int b = 0; b < 2; ++b)
#pragma unroll
                for (int m = 0; m < 4; ++m)
#pragma unroll
                    for (int n = 0; n < 2; ++n) acc[a][b][m][n] = (f32x4){0.f, 0.f, 0.f, 0.f};
        cur = nxt; cA = nA; cB = nB; ++ui;
        if (wr == 1) PG8_BAR;
    }
    PG8_WAIT_V(0);
    PG8_BAR;
#undef PG8_SA
#undef PG8_SB
#undef PG8_STAGE
#undef PG8_LDA
#undef PG8_LDB
#undef PG8_MMA
#undef PG8_WAIT_V
#undef PG8_WAIT_L
#undef PG8_BAR
#undef PG8_SCHED
}
}

__device__ __forceinline__ u64 pack8_fp8(const f32x4 a, const f32x4 b) {
    int w0 = __builtin_amdgcn_cvt_pk_fp8_f32(a[0], a[1], 0, false); w0 = __builtin_amdgcn_cvt_pk_fp8_f32(a[2], a[3], w0, true);
    int w1 = __builtin_amdgcn_cvt_pk_fp8_f32(b[0], b[1], 0, false); w1 = __builtin_amdgcn_cvt_pk_fp8_f32(b[2], b[3], w1, true);
    return (u64)(unsigned)w0 | ((u64)(unsigned)w1 << 32);
}
__device__ __forceinline__ h16x8 fp8x8_to_h16(const u64 v) {
    const int w0 = (int)(unsigned)v, w1 = (int)(unsigned)(v >> 32);
    const f32x2 a = __builtin_amdgcn_cvt_pk_f32_fp8(w0, false), b = __builtin_amdgcn_cvt_pk_f32_fp8(w0, true), c = __builtin_amdgcn_cvt_pk_f32_fp8(w1, false), d = __builtin_amdgcn_cvt_pk_f32_fp8(w1, true);
    h16x8 h; h[0] = (h16)a.x; h[1] = (h16)a.y; h[2] = (h16)b.x; h[3] = (h16)b.y; h[4] = (h16)c.x; h[5] = (h16)c.y; h[6] = (h16)d.x; h[7] = (h16)d.y;
    return h;
}
__device__ __forceinline__ int kvpos(int lc) { if (lc >= 256) return lc; const int j = lc >> 6, d = lc & 63; return j * 64 + ((d & 31) >> 3) * 16 + (d >> 5) * 8; }
__device__ __forceinline__ u32x4 pack8(const f32x4 a, const f32x4 b) {
    h16x8 h; h[0] = (h16)a[0]; h[1] = (h16)a[1]; h[2] = (h16)a[2]; h[3] = (h16)a[3]; h[4] = (h16)b[0]; h[5] = (h16)b[1]; h[6] = (h16)b[2]; h[7] = (h16)b[3];
    return __builtin_bit_cast(u32x4, h);
}

struct EpiProj {
    h16* PROJ; const float* rstd; float* dout; unsigned char* KVS; h16* KIS; unsigned char* KVC; h16* KIC;
    __device__ __forceinline__ void operator()(const f32x4 (&acc)[2][2][4][2], const pg8::Unit& u, int wr, int wc, int fr, int fq) const {
        const int row0 = u.pm * 256 + wr * 64 + fr, col0 = u.pn * 256 + wc * 32 + 8 * fq;
        const int pn = u.pn;
#pragma unroll
        for (int ai = 0; ai < 2; ++ai)
#pragma unroll
            for (int m = 0; m < 4; ++m) {
                const int row = row0 + ai * 128 + m * 16; const float rs = rstd[row];
#pragma unroll
                for (int bj = 0; bj < 2; ++bj) {
                    const int c = col0 + bj * 128;
                    const f32x4 v0 = acc[ai][bj][m][0] * rs, v1 = acc[ai][bj][m][1] * rs;
                    if (pn != 8 && pn != 9) *(u32x4*)(PROJ + (size_t)row * NPJ + c) = pack8(v0, v1);
                    if (pn == 8 || pn == 9 || (pn == 14 && c < C_KI + 64)) {
                        if (row < MP) {
                            float* o = (pn == 8) ? dout + O_PK + (size_t)row * 256 + (c - C_K) : (pn == 9) ? dout + O_PV + (size_t)row * 256 + (c - C_VV) : dout + O_PKI + (size_t)row * 64 + (c - C_KI);
                            *(f32x4*)o = v0; *(f32x4*)(o + 4) = v1;
                            if (pn == 14) *(u32x4*)(KIC + (size_t)row * 64 + (c - C_KI)) = pack8(v0, v1);
                            else *(u64*)(KVC + (size_t)row * 512 + kvpos(c - C_K)) = pack8_fp8(v0, v1);
                        } else if (row < MROWS) {
                            const int t = row - MP, b = t >> 4, s = t & 15; const size_t kr = (size_t)b * NKSP + PAST + s;
                            float* o = (pn == 8) ? dout + O_SK + (size_t)t * 256 + (c - C_K) : (pn == 9) ? dout + O_SV + (size_t)t * 256 + (c - C_VV) : dout + O_SKI + (size_t)t * 64 + (c - C_KI);
                            *(f32x4*)o = v0; *(f32x4*)(o + 4) = v1;
                            if (pn == 14) *(u32x4*)(KIS + kr * 64 + (c - C_KI)) = pack8(v0, v1);
                            else *(u64*)(KVS + kr * 512 + kvpos(c - C_K)) = pack8_fp8(v0, v1);
                        }
                    }
                }
            }
    }
};
template <int FIRST> struct EpiGate {
    h16* PROJ;
    __device__ __forceinline__ void operator()(const f32x4 (&acc)[2][2][4][2], const pg8::Unit& u, int wr, int wc, int fr, int fq) const {
        const int row0 = u.pm * 256 + wr * 64 + fr, col0 = u.pn * 256 + wc * 32 + 8 * fq;
#pragma unroll
        for (int ai = 0; ai < 2; ++ai)
#pragma unroll
            for (int m = 0; m < 4; ++m) {
                const int row = row0 + ai * 128 + m * 16;
#pragma unroll
                for (int bj = 0; bj < 2; ++bj) {
                    const int c = col0 + bj * 128;
                    h16* pm_ = PROJ + (size_t)row * NPJ + (FIRST ? C_T : C_M) + c;
                    const h16x8 gt = *(const h16x8*)(PROJ + (size_t)row * NPJ + (FIRST ? C_GA : C_GB) + c);
                    f32x4 v0, v1;
#pragma unroll
                    for (int j = 0; j < 4; ++j) { v0[j] = sigmoidf_((float)gt[j]) * acc[ai][bj][m][0][j]; v1[j] = sigmoidf_((float)gt[4 + j]) * acc[ai][bj][m][1][j]; }
                    if (!FIRST) { const h16x8 tp = *(const h16x8*)(PROJ + (size_t)row * NPJ + C_T + c);
#pragma unroll
                        for (int j = 0; j < 4; ++j) { v0[j] += (float)tp[j]; v1[j] += (float)tp[4 + j]; } }
                    *(u32x4*)pm_ = pack8(v0, v1);
                }
            }
    }
};
struct EpiOut {
    const float* xp; const float* xs; float* dout; float* rowss;
    __device__ __forceinline__ void operator()(const f32x4 (&acc)[2][2][4][2], const pg8::Unit& u, int wr, int wc, int fr, int fq) const {
        const int row0 = u.pm * 256 + wr * 64 + fr, col0 = u.pn * 256 + wc * 32 + 8 * fq;
#pragma unroll
        for (int ai = 0; ai < 2; ++ai)
#pragma unroll
            for (int m = 0; m < 4; ++m) {
                const int row = row0 + ai * 128 + m * 16;
                const bool ok = row < MROWS;
                const float* xr = (row < MP) ? xp + (size_t)row * DM : xs + (size_t)(row - MP) * DM;
                float* yr = (row < MP) ? dout + O_YP + (size_t)row * DM : dout + O_YS + (size_t)(row - MP) * DM;
                float ss = 0.f;
                if (ok) {
#pragma unroll
                    for (int bj = 0; bj < 2; ++bj) {
                        const int c = col0 + bj * 128;
                        const f32x4 x0 = *(const f32x4*)(xr + c), x1 = *(const f32x4*)(xr + c + 4);
                        const f32x4 v0 = x0 + acc[ai][bj][m][0], v1 = x1 + acc[ai][bj][m][1];
                        *(f32x4*)(yr + c) = v0; *(f32x4*)(yr + c + 4) = v1;
                        ss += v0[0] * v0[0] + v0[1] * v0[1] + v0[2] * v0[2] + v0[3] * v0[3] + v1[0] * v1[0] + v1[1] * v1[1] + v1[2] * v1[2] + v1[3] * v1[3];
                    }
                }
                ss = x32_sum(x16_sum(ss));
                if (ok && fq == 0) rowss[(size_t)row * 16 + u.pn * 4 + wc] = ss;
            }
    }
};

struct Params {
    const float *xp, *xs, *ck, *cv, *cki, *norm_g, *w_in, *ln_g, *ln_b, *sgu_w, *sgu_b, *w_pa, *w_pb, *w_out, *final_g;
    float* out; unsigned char* ws; int ph_lo, ph_hi;
};

__device__ __forceinline__ void p0_tr_item(const float* W, int K, int Nsrc, h16* WT, const float* gs, int mode, float* scr, int item, int nblk, int lane) {
    const int kb = item / nblk, nb = item % nblk, k0 = 64 * kb, n0 = 32 * nb;
    const int nn = n0 + (lane & 31);
    int src = nn; bool valid = true;
    if (mode == 1) { if (nn >= C_WI + 8 && nn < C_GA) valid = false; else if (nn >= C_GA) src = nn - (C_GA - (C_WI + 8)); }
#pragma unroll 8
    for (int i = 0; i < 32; ++i) { const int kk = 2 * i + (lane >> 5);
        float v = 0.f; if (valid) { v = W[(size_t)(k0 + kk) * Nsrc + src]; if (gs) v *= gs[k0 + kk]; }
        scr[kk * 33 + (lane & 31)] = v; }
    __builtin_amdgcn_s_waitcnt(0); asm volatile("" ::: "memory");
    const int c = lane & 7;
#pragma unroll
    for (int j = 0; j < 4; ++j) { const int n = (lane >> 3) + 8 * j; const float* s = scr + (8 * c) * 33 + n;
        h16x8 h;
#pragma unroll
        for (int q = 0; q < 8; ++q) h[q] = (h16)s[q * 33];
        *(h16x8*)(WT + (size_t)(n0 + n) * K + k0 + 8 * c) = h; }
    __builtin_amdgcn_s_waitcnt(0); asm volatile("" ::: "memory");
}

constexpr int VNT_LD = 136;
__device__ __forceinline__ void sgu_chunk(const Params& p, unsigned char* lds, int chunk, int wave, int lane) {
    h16* PROJ = (h16*)(p.ws + WS_PROJ);
    h16* vnT = (h16*)lds;
    h16* AOUT = (h16*)(p.ws + WS_AOUT);
    const h16* WSM = (const h16*)(p.ws + WS_WSM);
    {
        float lg[8], lb[8];
#pragma unroll
        for (int j = 0; j < 8; ++j) { lg[j] = p.ln_g[lane * 8 + j]; lb[j] = p.ln_b[lane * 8 + j]; }
        for (int tt = 0; tt < 16; ++tt) {
            const int tok = wave * 16 + tt; const size_t row = (size_t)chunk * 128 + tok;
            const h16x8 vv = *(const h16x8*)(PROJ + row * NPJ + C_V + lane * 8);
            float g[8]; float s = 0.f;
#pragma unroll
            for (int j = 0; j < 8; ++j) { g[j] = geluf_((float)vv[j]); s += g[j]; }
            const float mean = wave_sum(s) * (1.f / 512.f); float q = 0.f;
#pragma unroll
            for (int j = 0; j < 8; ++j) { g[j] -= mean; q += g[j] * g[j]; }
            const float rstd = rsqrtf(wave_sum(q) * (1.f / 512.f) + 1e-5f);
#pragma unroll
            for (int j = 0; j < 8; ++j) vnT[(lane * 8 + j) * VNT_LD + tok] = (h16)(g[j] * rstd * lg[j] + lb[j]);
        }
    }
    __syncthreads();
    {
        const int g = wave, fr = lane & 15, fq = lane >> 4;
        for (int it = 0; it < 8; ++it) {
            f32x4 acc[4];
#pragma unroll
            for (int dt = 0; dt < 4; ++dt) acc[dt] = (f32x4){0.f, 0.f, 0.f, 0.f};
            const int nks = (it < 4) ? 2 : 4;
            for (int ks = 0; ks < nks; ++ks) {
                const h16x8 b = *(const h16x8*)(WSM + ((size_t)g * 128 + it * 16 + fr) * 128 + ks * 32 + fq * 8);
#pragma unroll
                for (int dt = 0; dt < 4; ++dt) {
                    const h16x8 a = *(const h16x8*)(vnT + (g * 64 + dt * 16 + fr) * VNT_LD + ks * 32 + fq * 8);
                    acc[dt] = __builtin_amdgcn_mfma_f32_16x16x32_f16(a, b, acc[dt], 0, 0, 0);
                }
            }
            const int i = it * 16 + fr; const size_t row = (size_t)chunk * 128 + i;
            const float bias = p.sgu_b[g * 128 + i];
#pragma unroll
            for (int dt = 0; dt < 4; ++dt) {
                const int c = g * 64 + dt * 16 + fq * 4;
                const h16x4 uu = *(const h16x4*)(PROJ + row * NPJ + C_U + c); const h16x4 zz = *(const h16x4*)(PROJ + row * NPJ + C_ZA + c);
                h16x4 o;
#pragma unroll
                for (int r = 0; r < 4; ++r) o[r] = (h16)(geluf_((float)uu[r]) * (acc[dt][r] + bias) * siluf_((float)zz[r]));
                *(h16x4*)(AOUT + row * 512 + c) = o;
            }
        }
    }
    __syncthreads();
}
__device__ __forceinline__ void sgu_sample(const Params& p, unsigned char* lds, int b, int wave, int lane) {
    h16* PROJ = (h16*)(p.ws + WS_PROJ);
    float* vnS = (float*)lds;
    for (int tt = 0; tt < 2; ++tt) {
        const int t = wave * 2 + tt; const size_t row = (size_t)MP + b * 16 + t;
        const h16x8 vv = *(const h16x8*)(PROJ + row * NPJ + C_V + lane * 8);
        float g[8]; float s = 0.f;
#pragma unroll
        for (int j = 0; j < 8; ++j) { g[j] = geluf_((float)vv[j]); s += g[j]; }
        const float mean = wave_sum(s) * (1.f / 512.f); float q = 0.f;
#pragma unroll
        for (int j = 0; j < 8; ++j) { g[j] -= mean; q += g[j] * g[j]; }
        const float rstd = rsqrtf(wave_sum(q) * (1.f / 512.f) + 1e-5f);
#pragma unroll
        for (int j = 0; j < 8; ++j) { const int c = lane * 8 + j; const float v = g[j] * rstd * p.ln_g[c] + p.ln_b[c];
            vnS[t * 512 + c] = v; p.out[O_SSV + (size_t)(b * 16 + t) * 512 + c] = v; }
    }
    __syncthreads();
    {
        const int c = threadIdx.x, g = c >> 6;
        float vn[16];
#pragma unroll
        for (int j = 0; j < 16; ++j) vn[j] = vnS[j * 512 + c];
        for (int i = 0; i < 16; ++i) {
            float mixed = p.sgu_b[g * 128 + i];
#pragma unroll
            for (int j = 0; j < 16; ++j) mixed += p.sgu_w[((size_t)g * 128 + i) * 128 + j] * vn[j];
            const size_t row = (size_t)MP + b * 16 + i;
            const float u = (float)PROJ[row * NPJ + C_U + c], za = (float)PROJ[row * NPJ + C_ZA + c];
            ((h16*)(p.ws + WS_AOUT))[row * 512 + c] = (h16)(geluf_(u) * mixed * siluf_(za));
        }
    }
    __syncthreads();
}

constexpr int TK_C = 2048, TK_TRIG = TK_C - 512;
constexpr int L3_QA = 147456;
constexpr int L3_HIST = 131072, L3_CNT = L3_HIST + 8192, L3_THR = L3_CNT + 32, L3_SUM = L3_THR + 32;
__device__ __forceinline__ unsigned fkey(float f) { const unsigned u = __float_as_uint(f); return (u & 0x80000000u) ? ~u : (u | 0x80000000u); }
__device__ __forceinline__ float fkey_inv(unsigned k) { return __uint_as_float((k & 0x80000000u) ? (k ^ 0x80000000u) : ~k); }

template <bool ON_LO>
__device__ __forceinline__ unsigned radix_select(const u64* buf, unsigned* hist, int n, int lane, unsigned fhi, int k, int& ceq_out, int& krem_out) {
    unsigned prefix = 0, pmask = 0; int krem = k; int ceq = 0;
    for (int shift = 24; shift >= 0; shift -= 8) {
        *(u32x4*)(hist + 4 * lane) = (u32x4){0u, 0u, 0u, 0u};
        __builtin_amdgcn_s_waitcnt(0); asm volatile("" ::: "memory");
        for (int i = lane; i < n; i += 64) {
            const u64 e = buf[i]; const unsigned hi = (unsigned)(e >> 32), lo = (unsigned)e;
            const unsigned key = ON_LO ? lo : hi;
            const bool ok = (ON_LO ? (hi == fhi) : true) && ((key & pmask) == prefix);
            if (ok) atomicAdd(hist + ((key >> shift) & 255u), 1u);
        }
        __builtin_amdgcn_s_waitcnt(0); asm volatile("" ::: "memory");
        const u32x4 hv = *(const u32x4*)(hist + 4 * lane);
        const unsigned s = hv.x + hv.y + hv.z + hv.w;
        unsigned S = s;
#pragma unroll
        for (int o = 1; o < 64; o <<= 1) { const unsigned t = __shfl_down(S, o); if (lane + o < 64) S += t; }
        const bool is = (S >= (unsigned)krem) && (S - s < (unsigned)krem);
        const u64 bm = __ballot(is);
        const int L = bm ? (__ffsll((long long)bm) - 1) : 0;
        unsigned d = 0, cab = S - s, ce = 0;
        { unsigned c = S - s;
          if (c + hv.w >= (unsigned)krem) { d = 3; cab = c; ce = hv.w; }
          else { c += hv.w; if (c + hv.z >= (unsigned)krem) { d = 2; cab = c; ce = hv.z; }
          else { c += hv.z; if (c + hv.y >= (unsigned)krem) { d = 1; cab = c; ce = hv.y; }
          else { c += hv.y; d = 0; cab = c; ce = hv.x; } } } }
        { const int Ls_ = __builtin_amdgcn_readfirstlane(L); d = __builtin_amdgcn_readlane(d, Ls_); cab = __builtin_amdgcn_readlane(cab, Ls_); ce = __builtin_amdgcn_readlane(ce, Ls_); }
        const unsigned digit = 4u * (unsigned)L + d;
        krem -= (int)cab; ceq = (int)ce; prefix |= digit << shift; pmask |= 255u << shift;
    }
    ceq_out = ceq; krem_out = krem;
    return prefix;
}
__device__ __forceinline__ int tk_compact(u64* buf, unsigned* hist, int n, int lane_in, float& thr) {
    int lane = lane_in; asm volatile("" : "+v"(lane));
    unsigned ehi[32];
    const unsigned* b32 = (const unsigned*)buf;
#pragma unroll
    for (int j = 0; j < 32; ++j) { ehi[j] = 0u; if (64 * j < n) { const int ic = min(lane + 64 * j, n - 1); ehi[j] = b32[2 * ic + 1]; } }
    unsigned mn = 0xFFFFFFFFu, mx = 0u;
#pragma unroll
    for (int j = 0; j < 32; ++j) { if (64 * j < n) { mn = min(mn, ehi[j]); mx = max(mx, ehi[j]); } }
    mn = wave_min_u(mn); mx = wave_max_u(mx);
    const unsigned range = mx - mn; const int sh = range ? __clz(range) : 0;
#pragma unroll
    for (int j = 0; j < 32; ++j) { const unsigned nk = (ehi[j] - mn) << sh; ehi[j] = ((lane + 64 * j) < n) ? nk : 0u; }
    const unsigned ninv = (unsigned)(((n + 63) & ~63) - n);
    unsigned prefix = 0, pmask = 0; int krem = 256; bool done = false;
    for (int shift = 24; shift >= 0 && !done; shift -= 8) {
        *(u32x4*)(hist + 4 * lane) = (u32x4){0u, 0u, 0u, 0u};
        __builtin_amdgcn_s_waitcnt(0); asm volatile("" ::: "memory");
#pragma unroll
        for (int j = 0; j < 32; ++j) { if (64 * j < n) { if ((ehi[j] & pmask) == prefix) atomicAdd(hist + ((ehi[j] >> shift) & 255u), 1u); } }
        __builtin_amdgcn_s_waitcnt(0); asm volatile("" ::: "memory");
        u32x4 hv = *(const u32x4*)(hist + 4 * lane);
        if (lane == 0 && prefix == 0u) hv.x -= ninv;
        const unsigned s = hv.x + hv.y + hv.z + hv.w;
        unsigned S = s;
#pragma unroll
        for (int o = 1; o < 64; o <<= 1) { const unsigned t = __shfl_down(S, o); if (lane + o < 64) S += t; }
        const bool is = (S >= (unsigned)krem) && (S - s < (unsigned)krem);
        const u64 bm = __ballot(is);
        const int L = bm ? (__ffsll((long long)bm) - 1) : 0;
        unsigned d = 0, cab = S - s, ce = 0;
        { unsigned c = S - s;
          if (c + hv.w >= (unsigned)krem) { d = 3; cab = c; ce = hv.w; }
          else { c += hv.w; if (c + hv.z >= (unsigned)krem) { d = 2; cab = c; ce = hv.z; }
          else { c += hv.z; if (c + hv.y >= (unsigned)krem) { d = 1; cab = c; ce = hv.y; }
          else { c += hv.y; d = 0; cab = c; ce = hv.x; } } } }
        { const int Ls_ = __builtin_amdgcn_readfirstlane(L); d = __builtin_amdgcn_readlane(d, Ls_); cab = __builtin_amdgcn_readlane(cab, Ls_); ce = __builtin_amdgcn_readlane(ce, Ls_); }
        krem -= (int)cab; prefix |= (4u * (unsigned)L + d) << shift; pmask |= 255u << shift;
        if ((int)ce == krem) done = true;
    }
    unsigned tlo = 0u;
    const unsigned thi_abs = mn + ((prefix + ((1u << sh) - 1u)) >> sh);
    if (!done) { int c2, k2; tlo = radix_select<true>(buf, hist, n, lane, mn + (prefix >> sh), krem, c2, k2); }
    int outn = 0;
#pragma unroll
    for (int j = 0; j < 32; ++j) {
        if (64 * j < n) {
            const int i = lane + 64 * j; const int ic = min(i, n - 1);
            const unsigned elo_ = b32[2 * ic];
            const bool keep = (i < n) && ((ehi[j] > prefix) || ((ehi[j] & pmask) == prefix && (done || elo_ >= tlo)));
            const u64 bm = __ballot(keep);
            const int off = __builtin_amdgcn_mbcnt_hi((unsigned)(bm >> 32), __builtin_amdgcn_mbcnt_lo((unsigned)bm, 0u));
            if (keep) buf[outn + off] = ((u64)(mn + (ehi[j] >> sh)) << 32) | (u64)elo_;
            outn += __popcll(bm);
        }
    }
    __builtin_amdgcn_s_waitcnt(0); asm volatile("" ::: "memory");
    thr = fkey_inv(thi_abs - 1u);
    return outn;
}

struct AUnit { int qrow0, krow0, nk; const h16* kib; int kis; const unsigned char* kvb; int kvs; };

__device__ __forceinline__ void attn_unit(const Params& p, unsigned char* lds, const AUnit U, int wave, int lane, unsigned long long& tacc) {
    h16* PROJ = (h16*)(p.ws + WS_PROJ);
    u64* bufall = (u64*)lds;
    unsigned* hist = (unsigned*)(lds + L3_HIST) + wave * 256;
    unsigned* cnt = (unsigned*)(lds + L3_CNT);
    float* thrs = (float*)(lds + L3_THR);
    float* sums = (float*)(lds + L3_SUM) + wave * 8;
    int lane_r = lane; asm volatile("" : "+v"(lane_r));
    const int half = lane_r >> 5, l31 = lane_r & 31;
    f32x2 wq[2][2][4]; h16x8 qa[2][4];
    h16x8* qalds = (h16x8*)(lds + L3_QA);
#define LOADQA() do { _Pragma("unroll") for (int mt = 0; mt < 2; ++mt) _Pragma("unroll") for (int ks = 0; ks < 4; ++ks) qa[mt][ks] = qalds[(mt * 4 + ks) * 64 + lane_r]; } while (0)
#define LOADQ() do { _Pragma("unroll") for (int mt = 0; mt < 2; ++mt) _Pragma("unroll") for (int e = 0; e < 2; ++e) \
        { const h16x8 w8_ = *(const h16x8*)(PROJ + (size_t)(U.qrow0 + mt * 4 + 2 * half + e) * NPJ + C_WI); \
          _Pragma("unroll") for (int h = 0; h < 4; ++h) wq[mt][e][h] = (f32x2){(float)w8_[2 * h], (float)w8_[2 * h + 1]}; } } while (0)
    {
        int lane_s = lane; asm volatile("" : "+v"(lane_s)); const int l31 = lane_s & 31, half = lane_s >> 5;
        const int ql = 2 * ((l31 >> 2) & 1) + (l31 >> 4), hh = ((l31 >> 3) & 1) * 4 + (l31 & 3);
        const int mt_ = wave >> 2, ks_ = wave & 3;
        qalds[wave * 64 + lane_s] = *(const h16x8*)(PROJ + (size_t)(U.qrow0 + mt_ * 4 + ql) * NPJ + C_QI + hh * 64 + half * 8 + ks_ * 16);
    }
    __builtin_amdgcn_sched_barrier(0);
    LOADQ();
    __builtin_amdgcn_sched_barrier(0);
    for (int repi_ = 0; repi_ < REP_IDX; ++repi_) {
    __syncthreads();
    { const int t8 = lane_id(); if (wave == 0 && t8 < 8) { cnt[t8] = 0u; thrs[t8] = -__builtin_inff(); } }
    __syncthreads();
    const int nkt = (U.nk + 31) >> 5, rounds = (nkt + 15) >> 4;
    LOADQA();
    h16x8 bf[2][4], bn[2][4];
#define LOADB(dst, rdx) do { _Pragma("unroll") for (int rr = 0; rr < 2; ++rr) { const int kt_ = (rdx) * 16 + rr * 8 + wave; const int ktc_ = kt_ < nkt ? kt_ : nkt - 1; \
        const h16* kp_ = U.kib + (size_t)(U.krow0 + ktc_ * 32 + l31) * U.kis + half * 8; \
        _Pragma("unroll") for (int ks = 0; ks < 4; ++ks) dst[rr][ks] = *(const h16x8*)(kp_ + ks * 16); } } while (0)
    TBEG(1)
    LOADB(bf, 0);
#pragma unroll 1
    for (int rd = 0; rd < rounds; rd += 2) {
        LOADB(bn, rd + 1);
#pragma unroll
        for (int rr = 0; rr < 2; ++rr) {
            const int kt = (rd) * 16 + rr * 8 + wave;
            if (kt < nkt) {
                const int key = kt * 32 + l31; const bool kvalid = key < U.nk;
                f32x16 ccs[2];
#pragma unroll
                for (int r = 0; r < 16; ++r) { ccs[0][r] = 0.f; ccs[1][r] = 0.f; }
#pragma unroll
                for (int ks = 0; ks < 4; ++ks) { ccs[0] = __builtin_amdgcn_mfma_f32_32x32x16_f16(qa[0][ks], bf[rr][ks], ccs[0], 0, 0, 0); ccs[1] = __builtin_amdgcn_mfma_f32_32x32x16_f16(qa[1][ks], bf[rr][ks], ccs[1], 0, 0, 0); }
#pragma unroll
                for (int mt = 0; mt < 2; ++mt) {
                    const f32x16 cc = ccs[mt];
                    float sv[2]; bool ps[2];
                    const f32x2 thp = *(const f32x2*)(thrs + mt * 4 + 2 * half);
#pragma unroll
                    for (int e = 0; e < 2; ++e) {
                        f32x2 s2 = (f32x2){0.f, 0.f};
#pragma unroll
                        for (int h = 0; h < 4; ++h) {
                            const f32x2 r2 = (f32x2){__int_as_float(max(__float_as_int(cc[e * 8 + 2 * h]), 0)), __int_as_float(max(__float_as_int(cc[e * 8 + 2 * h + 1]), 0))};
                            s2 = __builtin_elementwise_fma(r2, wq[mt][e][h], s2);
                        }
                        const float s = s2.x + s2.y;
                        sv[e] = s; ps[e] = kvalid && (s > thp[e]);
                    }
                    const u64 bm0 = __ballot(ps[0]), bm1 = __ballot(ps[1]);
                    if (bm0 | bm1) {
                        const int ql = lane - mt * 4;
                        unsigned myc = 0u;
                        myc = (ql == 0) ? (unsigned)__popc((unsigned)bm0) : myc;
                        myc = (ql == 1) ? (unsigned)__popc((unsigned)bm1) : myc;
                        myc = (ql == 2) ? (unsigned)__popc((unsigned)(bm0 >> 32)) : myc;
                        myc = (ql == 3) ? (unsigned)__popc((unsigned)(bm1 >> 32)) : myc;
                        unsigned basev = 0u;
                        if ((unsigned)ql < 4u && myc) basev = atomicAdd(cnt + lane, myc);
                        const unsigned b00 = __builtin_amdgcn_readlane(basev, mt * 4), b01 = __builtin_amdgcn_readlane(basev, mt * 4 + 1);
                        const unsigned b10 = __builtin_amdgcn_readlane(basev, mt * 4 + 2), b11 = __builtin_amdgcn_readlane(basev, mt * 4 + 3);
                        const unsigned ltm = (1u << l31) - 1u;
                        if (ps[0]) { const unsigned hm = half ? (unsigned)(bm0 >> 32) : (unsigned)bm0; const unsigned pos = (half ? b10 : b00) + (unsigned)__popc(hm & ltm);
                            bufall[(size_t)(mt * 4 + 2 * half) * TK_C + pos] = ((u64)fkey(sv[0]) << 32) | (u64)(~(unsigned)key); }
                        if (ps[1]) { const unsigned hm = half ? (unsigned)(bm1 >> 32) : (unsigned)bm1; const unsigned pos = (half ? b11 : b01) + (unsigned)__popc(hm & ltm);
                            bufall[(size_t)(mt * 4 + 2 * half + 1) * TK_C + pos] = ((u64)fkey(sv[1]) << 32) | (u64)(~(unsigned)key); }
                    }
                }
            }
        }
        { TBEG(6)
        LDS_BARRIER();
        TEND(6) }
        bool need;
        { const u32x4 c0_ = *(const u32x4*)cnt, c1_ = *(const u32x4*)(cnt + 4); const unsigned m_ = max(max(max(c0_.x, c0_.y), max(c0_.z, c0_.w)), max(max(c1_.x, c1_.y), max(c1_.z, c1_.w))); need = m_ > (unsigned)TK_TRIG; }
        { TBEG(6)
        LDS_BARRIER();
        TEND(6) }
        if (need && (rd) + 1 < rounds) {
            TBEG(2)
            const int n = (int)cnt[wave];
            if (n > 256) { float t; const int nn = tk_compact(bufall + (size_t)wave * TK_C, hist, n, lane, t); if (lane == 0) { cnt[wave] = (unsigned)nn; thrs[wave] = t; } }
            __builtin_amdgcn_sched_barrier(0);
            LOADQ(); LOADQA(); LOADB(bn, rd + 1);
            LDS_BARRIER();
            TEND(2)
        }
        if (rd + 1 < rounds) {
        LOADB(bf, rd + 2);
#pragma unroll
        for (int rr = 0; rr < 2; ++rr) {
            const int kt = (rd + 1) * 16 + rr * 8 + wave;
            if (kt < nkt) {
                const int key = kt * 32 + l31; const bool kvalid = key < U.nk;
                f32x16 ccs[2];
#pragma unroll
                for (int r = 0; r < 16; ++r) { ccs[0][r] = 0.f; ccs[1][r] = 0.f; }
#pragma unroll
                for (int ks = 0; ks < 4; ++ks) { ccs[0] = __builtin_amdgcn_mfma_f32_32x32x16_f16(qa[0][ks], bn[rr][ks], ccs[0], 0, 0, 0); ccs[1] = __builtin_amdgcn_mfma_f32_32x32x16_f16(qa[1][ks], bn[rr][ks], ccs[1], 0, 0, 0); }
#pragma unroll
                for (int mt = 0; mt < 2; ++mt) {
                    const f32x16 cc = ccs[mt];
                    float sv[2]; bool ps[2];
                    const f32x2 thp = *(const f32x2*)(thrs + mt * 4 + 2 * half);
#pragma unroll
                    for (int e = 0; e < 2; ++e) {
                        f32x2 s2 = (f32x2){0.f, 0.f};
#pragma unroll
                        for (int h = 0; h < 4; ++h) {
                            const f32x2 r2 = (f32x2){__int_as_float(max(__float_as_int(cc[e * 8 + 2 * h]), 0)), __int_as_float(max(__float_as_int(cc[e * 8 + 2 * h + 1]), 0))};
                            s2 = __builtin_elementwise_fma(r2, wq[mt][e][h], s2);
                        }
                        const float s = s2.x + s2.y;
                        sv[e] = s; ps[e] = kvalid && (s > thp[e]);
                    }
                    const u64 bm0 = __ballot(ps[0]), bm1 = __ballot(ps[1]);
                    if (bm0 | bm1) {
                        const int ql = lane - mt * 4;
                        unsigned myc = 0u;
                        myc = (ql == 0) ? (unsigned)__popc((unsigned)bm0) : myc;
                        myc = (ql == 1) ? (unsigned)__popc((unsigned)bm1) : myc;
                        myc = (ql == 2) ? (unsigned)__popc((unsigned)(bm0 >> 32)) : myc;
                        myc = (ql == 3) ? (unsigned)__popc((unsigned)(bm1 >> 32)) : myc;
                        unsigned basev = 0u;
                        if ((unsigned)ql < 4u && myc) basev = atomicAdd(cnt + lane, myc);
                        const unsigned b00 = __builtin_amdgcn_readlane(basev, mt * 4), b01 = __builtin_amdgcn_readlane(basev, mt * 4 + 1);
                        const unsigned b10 = __builtin_amdgcn_readlane(basev, mt * 4 + 2), b11 = __builtin_amdgcn_readlane(basev, mt * 4 + 3);
                        const unsigned ltm = (1u << l31) - 1u;
                        if (ps[0]) { const unsigned hm = half ? (unsigned)(bm0 >> 32) : (unsigned)bm0; const unsigned pos = (half ? b10 : b00) + (unsigned)__popc(hm & ltm);
                            bufall[(size_t)(mt * 4 + 2 * half) * TK_C + pos] = ((u64)fkey(sv[0]) << 32) | (u64)(~(unsigned)key); }
                        if (ps[1]) { const unsigned hm = half ? (unsigned)(bm1 >> 32) : (unsigned)bm1; const unsigned pos = (half ? b11 : b01) + (unsigned)__popc(hm & ltm);
                            bufall[(size_t)(mt * 4 + 2 * half + 1) * TK_C + pos] = ((u64)fkey(sv[1]) << 32) | (u64)(~(unsigned)key); }
                    }
                }
            }
        }
        { TBEG(6)
        LDS_BARRIER();
        TEND(6) }
        bool need;
        { const u32x4 c0_ = *(const u32x4*)cnt, c1_ = *(const u32x4*)(cnt + 4); const unsigned m_ = max(max(max(c0_.x, c0_.y), max(c0_.z, c0_.w)), max(max(c1_.x, c1_.y), max(c1_.z, c1_.w))); need = m_ > (unsigned)TK_TRIG; }
        { TBEG(6)
        LDS_BARRIER();
        TEND(6) }
        if (need && (rd + 1) + 1 < rounds) {
            TBEG(2)
            const int n = (int)cnt[wave];
            if (n > 256) { float t; const int nn = tk_compact(bufall + (size_t)wave * TK_C, hist, n, lane, t); if (lane == 0) { cnt[wave] = (unsigned)nn; thrs[wave] = t; } }
            __builtin_amdgcn_sched_barrier(0);
            LOADQ(); LOADQA(); LOADB(bf, rd + 2);
            LDS_BARRIER();
            TEND(2)
        }
        }
    }
#undef LOADB
#undef LOADQ
#undef LOADQA
    TEND(1)
    }
    u64* buf = bufall + (size_t)wave * TK_C;
    TBEG(3)
    int n = (int)cnt[wave];
    if (n > 256) { float t; n = tk_compact(buf, hist, n, lane, t); }
    TEND(3)
    const int qrow = U.qrow0 + wave;
    int lane_o = lane; asm volatile("" : "+v"(lane_o));
    for (int repa_ = 0; repa_ < REP_ATT; ++repa_) {
    TBEG(4)
    float* P = (float*)((unsigned char*)buf + 4096);
    {
        const int fr = lane_o & 15, fq = lane_o >> 4;
        h16x8 qf[2];
#pragma unroll
        for (int ks = 0; ks < 2; ++ks) {
            if (fr < 8) qf[ks] = *(const h16x8*)(PROJ + (size_t)qrow * NPJ + C_Q + fr * 64 + ks * 32 + fq * 8);
            else {
#pragma unroll
                for (int j = 0; j < 8; ++j) qf[ks][j] = (h16)0.f; }
        }
        long q8[2];
#pragma unroll
        for (int ks = 0; ks < 2; ++ks) { f32x4 f0_, f1_;
#pragma unroll
            for (int j = 0; j < 4; ++j) { f0_[j] = (float)qf[ks][j]; f1_[j] = (float)qf[ks][4 + j]; }
            q8[ks] = (long)pack8_fp8(f0_, f1_); }
        h16x8 zero8;
#pragma unroll
        for (int j = 0; j < 8; ++j) zero8[j] = (h16)0.f;
        u32x4 ka[8], kb[8];
#define ISSUEK4(dst, g) do { _Pragma("unroll") for (int tt = 0; tt < 2; ++tt) { const int s_ = ((g) * 2 + tt) * 16 + fr; const unsigned idx_ = (s_ < n) ? ~(unsigned)buf[s_] : 0u; \
        const unsigned char* kr_ = U.kvb + (size_t)(U.krow0 + (int)idx_) * 512 + fq * 16; \
        _Pragma("unroll") for (int j = 0; j < 4; ++j) dst[tt * 4 + j] = *(const u32x4*)(kr_ + j * 64); } } while (0)
#define COMPK4(src, g) do { _Pragma("unroll") for (int tt = 0; tt < 2; ++tt) { f32x4 c_ = (f32x4){0.f, 0.f, 0.f, 0.f}; \
        _Pragma("unroll") for (int j = 0; j < 4; ++j) { const u32x4 w_ = src[tt * 4 + j]; \
            const long a0_ = ((fr >> 1) == j) ? q8[0] : 0l, a1_ = ((fr >> 1) == j) ? q8[1] : 0l; \
            c_ = __builtin_amdgcn_mfma_f32_16x16x32_fp8_fp8(a0_, (long)((u64)w_.x | ((u64)w_.y << 32)), c_, 0, 0, 0); \
            c_ = __builtin_amdgcn_mfma_f32_16x16x32_fp8_fp8(a1_, (long)((u64)w_.z | ((u64)w_.w << 32)), c_, 0, 0, 0); } \
        const int s_ = ((g) * 2 + tt) * 16 + fr; const bool v_ = s_ < n; \
        _Pragma("unroll") for (int r = 0; r < 4; ++r) c_[r] = v_ ? c_[r] * 0.125f : -1e30f; \
        if (fq < 2) *(f32x4*)(P + s_ * 8 + fq * 4) = c_; } } while (0)
        ISSUEK4(ka, 0);
#pragma unroll 1
        for (int g = 0; g < 8; g += 2) {
            ISSUEK4(kb, g + 1);
            COMPK4(ka, g);
            ISSUEK4(ka, g + 2);
            COMPK4(kb, g + 1);
        }
#undef ISSUEK4
#undef COMPK4
        __builtin_amdgcn_s_waitcnt(0); asm volatile("" ::: "memory");
        f32x4 acc[16];
#pragma unroll
        for (int t = 0; t < 16; ++t) acc[t] = *(const f32x4*)(P + (t * 16 + fr) * 8 + (fq & 1) * 4);
        float mx[4] = {-1e30f, -1e30f, -1e30f, -1e30f};
#pragma unroll
        for (int t = 0; t < 16; ++t) { const bool v = (t * 16 + fr) < n;
#pragma unroll
            for (int r = 0; r < 4; ++r) { mx[r] = fmaxf(mx[r], acc[t][r]); } }
#pragma unroll
        for (int r = 0; r < 4; ++r) mx[r] = row16_max(mx[r]);
        float sm[4] = {0.f, 0.f, 0.f, 0.f};
#pragma unroll
        for (int t = 0; t < 16; ++t) { const bool v = (t * 16 + fr) < n;
#pragma unroll
            for (int r = 0; r < 4; ++r) { const float e = v ? __expf(acc[t][r] - mx[r]) : 0.f; acc[t][r] = e; sm[r] += e; } }
#pragma unroll
        for (int r = 0; r < 4; ++r) sm[r] = row16_sum(sm[r]);
        __builtin_amdgcn_s_waitcnt(0); asm volatile("" ::: "memory");
        if (fq < 2) {
#pragma unroll
            for (int t = 0; t < 16; ++t) *(f32x4*)(P + (t * 16 + fr) * 8 + fq * 4) = acc[t];
            if (fr == 0) {
#pragma unroll
                for (int r = 0; r < 4; ++r) sums[fq * 4 + r] = sm[r]; }
        }
        __builtin_amdgcn_s_waitcnt(0); asm volatile("" ::: "memory");
    }
    TEND(4)
    TBEG(5)
    {
        const int sg = lane_o >> 4, part = lane_o & 15, kv = part >> 2, d0 = (part & 3) * 16;
        f32x2 o0[8], o1[8];
#pragma unroll
        for (int j = 0; j < 8; ++j) { o0[j] = (f32x2){0.f, 0.f}; o1[j] = (f32x2){0.f, 0.f}; }
        u32x4 va[8], vb[8];
        const unsigned char* vbase = U.kvb + 256 + kv * 64 + d0;
#define ISSUEV16(dst, gi) do { _Pragma("unroll") for (int ii = 0; ii < 8; ++ii) { const int s_ = 4 * ((gi) * 8 + ii) + sg; const unsigned idx_ = (s_ < n) ? ~(unsigned)buf[s_] : 0u; \
        dst[ii] = *(const u32x4*)(vbase + (size_t)(U.krow0 + (int)idx_) * 512); } } while (0)
#define COMPV16(src, gi) do { _Pragma("unroll") for (int ii = 0; ii < 8; ++ii) { const int s_ = 4 * ((gi) * 8 + ii) + sg; const f32x2 pp = *(const f32x2*)(P + (s_ & 255) * 8 + 2 * kv); const f32x2 px_ = (f32x2){pp.x, pp.x}, py_ = (f32x2){pp.y, pp.y}; const u32x4 w_ = src[ii]; \
        _Pragma("unroll") for (int q_ = 0; q_ < 4; ++q_) { const int ww_ = (int)w_[q_]; \
            const f32x2 xa_ = __builtin_amdgcn_cvt_pk_f32_fp8(ww_, false), xb_ = __builtin_amdgcn_cvt_pk_f32_fp8(ww_, true); \
            o0[q_ * 2] = __builtin_elementwise_fma(xa_, px_, o0[q_ * 2]); o0[q_ * 2 + 1] = __builtin_elementwise_fma(xb_, px_, o0[q_ * 2 + 1]); \
            o1[q_ * 2] = __builtin_elementwise_fma(xa_, py_, o1[q_ * 2]); o1[q_ * 2 + 1] = __builtin_elementwise_fma(xb_, py_, o1[q_ * 2 + 1]); } } } while (0)
        ISSUEV16(va, 0);
#pragma unroll 1
        for (int gi = 0; gi < 8; gi += 2) {
            ISSUEV16(vb, gi + 1);
            COMPV16(va, gi);
            ISSUEV16(va, gi + 2);
            COMPV16(vb, gi + 1);
        }
#undef ISSUEV16
#undef COMPV16
#pragma unroll
        for (int j = 0; j < 8; ++j) { o0[j].x = x32_sum(x16_sum(o0[j].x)); o0[j].y = x32_sum(x16_sum(o0[j].y)); o1[j].x = x32_sum(x16_sum(o1[j].x)); o1[j].y = x32_sum(x16_sum(o1[j].y)); }
        if (sg == 0) {
            const float i0 = 1.f / sums[2 * kv], i1 = 1.f / sums[2 * kv + 1];
            const h16* pz = PROJ + (size_t)qrow * NPJ + C_ZB + (2 * kv) * 64 + d0;
            h16* po = (h16*)(p.ws + WS_BOUT) + (size_t)qrow * 512 + (2 * kv) * 64 + d0;
#pragma unroll
            for (int hh = 0; hh < 2; ++hh) {
                const h16x8 za = *(const h16x8*)(pz + hh * 64), zb = *(const h16x8*)(pz + hh * 64 + 8);
                h16x8 ra, rb;
#pragma unroll
                for (int j = 0; j < 8; ++j) { const float oa = hh ? o1[j >> 1][j & 1] : o0[j >> 1][j & 1], ob = hh ? o1[4 + (j >> 1)][j & 1] : o0[4 + (j >> 1)][j & 1]; const float ii = hh ? i1 : i0;
                    ra[j] = (h16)(oa * ii * siluf_((float)za[j])); rb[j] = (h16)(ob * ii * siluf_((float)zb[j])); }
                *(h16x8*)(po + hh * 64) = ra; *(h16x8*)(po + hh * 64 + 8) = rb;
            }
        }
    }
    TEND(5)
    }
    __syncthreads();
}

__global__ void __launch_bounds__(512, 2) mk_fwd(Params p) {
    __builtin_assume(__builtin_amdgcn_workitem_id_y() == 0); __builtin_assume(__builtin_amdgcn_workitem_id_z() == 0);
    extern __shared__ __attribute__((aligned(16))) unsigned char lds[];
    cg::grid_group grid = cg::this_grid();
    const int wave = __builtin_amdgcn_readfirstlane((int)threadIdx.x >> 6);
    const int G = gridDim.x, bx = blockIdx.x;
    const int gw = bx * 8 + wave, NGW = G * 8;
    const int lo = p.ph_lo, hi = p.ph_hi;
    unsigned long long tacc = 0;
#define IN(k) (lo <= (k) && (k) < hi)
#define SEAM(k) do { if (IN(k) && IN((k) + 1)) grid.sync(); } while (0)
    h16* XH = (h16*)(p.ws + WS_XH); h16* PROJ = (h16*)(p.ws + WS_PROJ);
    h16* WIN = (h16*)(p.ws + WS_WIN); h16* WPA = (h16*)(p.ws + WS_WPA); h16* WPB = (h16*)(p.ws + WS_WPB); h16* WOUT = (h16*)(p.ws + WS_WOUT);
    h16* WSM = (h16*)(p.ws + WS_WSM); h16* KVS = (h16*)(p.ws + WS_KVS); h16* KIS = (h16*)(p.ws + WS_KIS);
    float* RSTD = (float*)(p.ws + WS_RSTD); float* ROWSS = (float*)(p.ws + WS_ROWSS);

    if (IN(0)) for (int rep_ = 0; rep_ < REP_P0; ++rep_) {
        const int lane = lane_id(), tid = wave * 64 + lane;
        float* scr = (float*)(lds + wave * 16384);
        constexpr int I_IN = 16 * (NPJ / 32), I_PA = 8 * 32, I_PB = 8 * 32, I_OUT = 16 * 32;
        for (int it = gw; it < I_IN + I_PA + I_PB + I_OUT; it += NGW) {
            int r = it;
            if (r < I_IN) { p0_tr_item(p.w_in, 1024, INW, WIN, p.norm_g, 1, scr, r, NPJ / 32, lane); continue; } r -= I_IN;
            if (r < I_PA) { p0_tr_item(p.w_pa, 512, 1024, WPA, nullptr, 0, scr, r, 32, lane); continue; } r -= I_PA;
            if (r < I_PB) { p0_tr_item(p.w_pb, 512, 1024, WPB, nullptr, 0, scr, r, 32, lane); continue; } r -= I_PB;
            p0_tr_item(p.w_out, 1024, 1024, WOUT, nullptr, 0, scr, r, 32, lane);
        }
        for (int m = gw; m < MT; m += NGW) {
            u64* o8 = (u64*)(XH + (size_t)m * DM) + lane;
            if (m < MROWS) {
                const float* xr = (m < MP) ? p.xp + (size_t)m * DM : p.xs + (size_t)(m - MP) * DM;
                const f32x4* x4 = (const f32x4*)xr + lane;
                f32x4 v[4]; float s = 0.f;
#pragma unroll
                for (int j = 0; j < 4; ++j) { v[j] = x4[64 * j]; s += (v[j].x * v[j].x + v[j].y * v[j].y) + (v[j].z * v[j].z + v[j].w * v[j].w); }
                s = wave_sum(s);
                if (lane == 0) RSTD[m] = rsqrtf(s * (1.f / 1024.f) + 1e-6f);
#pragma unroll
                for (int j = 0; j < 4; ++j) { h16x4 h; h[0] = (h16)v[j].x; h[1] = (h16)v[j].y; h[2] = (h16)v[j].z; h[3] = (h16)v[j].w; o8[64 * j] = __builtin_bit_cast(u64, h); }
            } else {
                if (lane == 0) RSTD[m] = 0.f;
#pragma unroll
                for (int j = 0; j < 4; ++j) o8[64 * j] = 0ull;
            }
        }
        const int gt = bx * 512 + tid, NGT = G * 512;
        for (int i = gt; i < NB * NKSP * 64; i += NGT) {
            const int c8 = (i & 63) * 8, r = (i >> 6) % NKSP, b = (i >> 6) / NKSP;
            if (r >= PAST && r < NKS) continue;
            f32x4 f0 = (f32x4){0.f, 0.f, 0.f, 0.f}, f1 = f0;
            if (r < PAST) { const float* src = (c8 < 256) ? p.ck + ((size_t)b * PAST + r) * 256 + c8 : p.cv + ((size_t)b * PAST + r) * 256 + (c8 - 256);
                f0 = *(const f32x4*)src; f1 = *(const f32x4*)(src + 4); }
            *(u64*)((unsigned char*)KVS + ((size_t)b * NKSP + r) * 512 + kvpos(c8)) = pack8_fp8(f0, f1);
        }
        for (int i = gt; i < NB * NKSP * 8; i += NGT) {
            const int c8 = (i & 7) * 8, r = (i >> 3) % NKSP, b = (i >> 3) / NKSP;
            if (r >= PAST && r < NKS) continue;
            h16x8 h;
            if (r < PAST) { const float* src = p.cki + ((size_t)b * PAST + r) * 64 + c8;
#pragma unroll
                for (int j = 0; j < 8; ++j) h[j] = (h16)src[j]; }
            else {
#pragma unroll
                for (int j = 0; j < 8; ++j) h[j] = (h16)0.f; }
            *(h16x8*)(KIS + ((size_t)b * NKSP + r) * 64 + c8) = h;
        }
        for (int i = gt; i < 8 * 128 * 128; i += NGT) { const int j = i & 127, ii = (i >> 7) & 127; WSM[i] = ((j >> 6) <= (ii >> 6)) ? (h16)p.sgu_w[i] : (h16)0.f; }
    }
    SEAM(0);
    if (IN(1)) for (int rep_ = 0; rep_ < REP_P1; ++rep_) {
        pg8::Gemm g{XH, WIN, MT, NPJ, 1024, 1024}; pg8::StaticOrder S; S.init(MT, NPJ, G, bx);
        EpiProj E{PROJ, RSTD, p.out, (unsigned char*)KVS, KIS, (unsigned char*)(p.ws + WS_KVC), (h16*)(p.ws + WS_KIC)};
        pg8::gemm_phase<EpiProj>((LAS unsigned char*)lds, g, S, E);
    }
    SEAM(1);
    if (IN(2)) for (int rep_ = 0; rep_ < REP_P2; ++rep_) {
        for (int u = bx; u < 512 + NB; u += G) { const int lane = lane_id(); if (u < 512) sgu_chunk(p, lds, u, wave, lane); else sgu_sample(p, lds, u - 512, wave, lane); }
    }
    if (IN(3)) for (int rep_ = 0; rep_ < REP_P3; ++rep_) {
        for (int u = bx; u < 8192 + 16; u += G) {
            AUnit U;
            if (u < 8192) { const int i = u >> 8, gp = u & 255, b = gp & 7, s = gp >> 3; const int jt = s + 32 * i;
                U.qrow0 = b * SEQ + jt * 8; U.krow0 = b * SEQ; U.nk = ((jt * 8) / 64 + 1) * 64; U.kib = (const h16*)(p.ws + WS_KIC); U.kis = 64; U.kvb = (const unsigned char*)(p.ws + WS_KVC); U.kvs = 512; }
            else { const int v = u - 8192, b = v >> 1, hf = v & 1;
                U.qrow0 = MP + b * 16 + hf * 8; U.krow0 = b * NKSP; U.nk = NKS; U.kib = KIS; U.kis = 64; U.kvb = (const unsigned char*)KVS; U.kvs = 512; }
            attn_unit(p, lds, U, wave, lane_id(), tacc);
        }
    }
    SEAM(3);
    if (IN(4)) for (int rep_ = 0; rep_ < REP_P4; ++rep_) {
        { pg8::Gemm g{(const h16*)(p.ws + WS_AOUT), WPA, MT, 1024, 512, 512}; pg8::StaticOrder S; S.init(MT, 1024, G, bx); EpiGate<1> E{PROJ}; pg8::gemm_phase<EpiGate<1>>((LAS unsigned char*)lds, g, S, E); }
        { pg8::Gemm g{(const h16*)(p.ws + WS_BOUT), WPB, MT, 1024, 512, 512}; pg8::StaticOrder S; S.init(MT, 1024, G, bx); EpiGate<0> E{PROJ}; pg8::gemm_phase<EpiGate<0>>((LAS unsigned char*)lds, g, S, E); }
    }
    SEAM(4);
    if (IN(5)) for (int rep_ = 0; rep_ < REP_P5; ++rep_) {
        pg8::Gemm g{PROJ + C_M, WOUT, MT, 1024, 1024, NPJ}; pg8::StaticOrder S; S.init(MT, 1024, G, bx);
        EpiOut E{p.xp, p.xs, p.out, ROWSS};
        pg8::gemm_phase<EpiOut>((LAS unsigned char*)lds, g, S, E);
    }
    SEAM(5);
    if (IN(6)) {
        const int lane = lane_id();
        for (int m = gw; m < MROWS; m += NGW) {
            float* yr = (m < MP) ? p.out + O_YP + (size_t)m * DM : p.out + O_YS + (size_t)(m - MP) * DM;
            float ssum = (lane < 16) ? ROWSS[(size_t)m * 16 + lane] : 0.f; ssum = wave_sum(ssum);
            const float r = rsqrtf(ssum * (1.f / 1024.f) + 1e-6f);
            const int lane6 = lane;
            f32x4* y4 = (f32x4*)yr + lane6; const f32x4* g4 = (const f32x4*)p.final_g + lane6;
#pragma unroll
            for (int j = 0; j < 4; ++j) { f32x4 v = y4[64 * j]; const f32x4 gg = g4[64 * j]; v = v * r * gg; y4[64 * j] = v; }
        }
    }
    if (TSEL != 0 && bx == 0 && threadIdx.x == 0) { const unsigned long long t0 = rt_(); while (rt_() - t0 < tacc) __builtin_amdgcn_s_sleep(8); }
#undef IN
#undef SEAM
}

extern "C" void kernel_launch(void* const* d_in, const int* in_sizes, int n_in, void* d_out, int out_size, void* d_ws, size_t ws_size, hipStream_t stream) {
    static int grid_blocks = 0;
    if (grid_blocks == 0) {
        if (ws_size < WS_END) { fprintf(stderr, "kernel_launch: workspace too small: %zu < %zu\n", ws_size, (size_t)WS_END); grid_blocks = -1; return; }
        int dev = 0, cus = 0, per_cu = 0;
        hipGetDevice(&dev);
        hipDeviceGetAttribute(&cus, hipDeviceAttributeMultiprocessorCount, dev);
        hipFuncSetAttribute((const void*)mk_fwd, hipFuncAttributeMaxDynamicSharedMemorySize, LDS_BYTES);
        hipOccupancyMaxActiveBlocksPerMultiprocessor(&per_cu, (const void*)mk_fwd, 512, LDS_BYTES);
        if (per_cu < 1) { fprintf(stderr, "kernel_launch: occupancy query says %d blocks per CU\n", per_cu); per_cu = 1; }
        grid_blocks = cus * per_cu;
        (void)hipGetLastError();
    }
    if (grid_blocks < 0) return;
    Params p{};
    p.xp = (const float*)d_in[0]; p.xs = (const float*)d_in[1]; p.ck = (const float*)d_in[2]; p.cv = (const float*)d_in[3]; p.cki = (const float*)d_in[4];
    p.norm_g = (const float*)d_in[5]; p.w_in = (const float*)d_in[6]; p.ln_g = (const float*)d_in[7]; p.ln_b = (const float*)d_in[8];
    p.sgu_w = (const float*)d_in[9]; p.sgu_b = (const float*)d_in[10]; p.w_pa = (const float*)d_in[11]; p.w_pb = (const float*)d_in[12];
    p.w_out = (const float*)d_in[13]; p.final_g = (const float*)d_in[14];
    p.out = (float*)d_out; p.ws = (unsigned char*)d_ws; p.ph_lo = 0; p.ph_hi = 7;
    void* args[] = {&p};
    hipError_t e = hipLaunchCooperativeKernel((const void*)mk_fwd, dim3(grid_blocks), dim3(512), args, LDS_BYTES, stream);
    if (e != hipSuccess) fprintf(stderr, "cooperative launch failed: %s (grid %d)\n", hipGetErrorString(e), grid_blocks);
}
```

```cpp
#include <hip/hip_runtime.h>
#include <hip/hip_cooperative_groups.h>
#include <cstdio>
#include <cstdint>
namespace cg = cooperative_groups;
#define REP_P0 1
#define REP_P1 1
#define REP_P2 1
#define REP_P3 1
#define REP_IDX 1
#define REP_ATT 1
#define TSEL 0
#define LDS_BARRIER() do { asm volatile("s_waitcnt lgkmcnt(0)" ::: "memory"); __builtin_amdgcn_s_barrier(); asm volatile("" ::: "memory"); } while (0)
__device__ __forceinline__ unsigned long long rt_() { return __builtin_amdgcn_s_memrealtime(); }
#define TBEG(k) unsigned long long tb_##k = 0; if (TSEL == (k)) tb_##k = rt_();
#define TEND(k) if (TSEL == (k)) tacc += rt_() - tb_##k;
#define REP_P4 1
#define REP_P5 1

#define LAS __attribute__((address_space(3)))
typedef _Float16 h16;
typedef _Float16 h16x8 __attribute__((ext_vector_type(8)));
typedef _Float16 h16x4 __attribute__((ext_vector_type(4)));
typedef _Float16 h16x2 __attribute__((ext_vector_type(2)));
typedef float f32x2 __attribute__((ext_vector_type(2)));
typedef float f32x4 __attribute__((ext_vector_type(4)));
typedef float f32x16 __attribute__((ext_vector_type(16)));
typedef unsigned u32x4 __attribute__((ext_vector_type(4)));
typedef unsigned u32x2 __attribute__((ext_vector_type(2)));
typedef unsigned long long u64;

constexpr int DM = 1024, SEQ = 8192, NB = 8, MP = NB * SEQ;
constexpr int DSQ = 16, MS = NB * DSQ, PAST = 1024, NKS = PAST + DSQ, NKSP = 1056;
constexpr int MROWS = MP + MS;
constexpr int MT = MP + 256;
constexpr int INW = 5704, NPJ = 5888;
constexpr int C_U = 0, C_V = 512, C_ZA = 1024, C_Q = 1536, C_K = 2048, C_VV = 2304, C_ZB = 2560, C_QI = 3072, C_KI = 3584, C_WI = 3648, C_GA = 3840, C_GB = 4864;
constexpr size_t O_YP = 0, O_YS = 67108864, O_PK = 67239936, O_PV = 84017152, O_PKI = 100794368, O_SK = 104988672, O_SV = 105021440, O_SKI = 105054208, O_SSV = 105062400;
constexpr size_t WS_XH = 0;
constexpr size_t WS_PROJ = WS_XH + (size_t)MT * DM * 2;
constexpr size_t WS_WIN = WS_PROJ + (size_t)MT * NPJ * 2;
constexpr size_t WS_WPA = WS_WIN + (size_t)NPJ * DM * 2;
constexpr size_t WS_WPB = WS_WPA + (size_t)1024 * 512 * 2;
constexpr size_t WS_WOUT = WS_WPB + (size_t)1024 * 512 * 2;
constexpr size_t WS_WSM = WS_WOUT + (size_t)1024 * 1024 * 2;
constexpr size_t WS_KVS = WS_WSM + (size_t)8 * 128 * 128 * 2;
constexpr size_t WS_KIS = WS_KVS + (size_t)NB * NKSP * 512 * 2;
constexpr size_t WS_RSTD = WS_KIS + (size_t)NB * NKSP * 64 * 2;
constexpr size_t WS_ROWSS = WS_RSTD + (size_t)MT * 4;
constexpr size_t WS_KIC = WS_ROWSS + (size_t)MT * 16 * 4;
constexpr size_t WS_KVC = WS_KIC + (size_t)MP * 64 * 2;
constexpr size_t WS_END = WS_KVC + (size_t)MP * 512 * 2;
constexpr size_t WS_AOUT = WS_XH, WS_BOUT = WS_XH + (size_t)MT * 512 * 2;
constexpr int C_T = 0, C_M = 1024;
constexpr int LDS_BYTES = 155648;

__device__ __forceinline__ float sigmoidf_(float x) { return __builtin_amdgcn_rcpf(1.f + __expf(-x)); }
__device__ __forceinline__ float siluf_(float x) { return x * __builtin_amdgcn_rcpf(1.f + __expf(-x)); }
__device__ __forceinline__ float geluf_(float x) { const float t = 1.5957691216057308f * (x + 0.044715f * x * x * x); return x * __builtin_amdgcn_rcpf(1.f + __expf(-t)); }
__device__ __forceinline__ int lane_id() { int l; asm volatile("v_mbcnt_lo_u32_b32 %0, -1, 0\n\tv_mbcnt_hi_u32_b32 %0, -1, %0" : "=v"(l)); return l; }
#define DPPF_(v, ctrl) __builtin_bit_cast(float, __builtin_amdgcn_update_dpp(0, __builtin_bit_cast(int, (v)), (ctrl), 0xF, 0xF, true))
#define DPPU_(v, ctrl) ((unsigned)__builtin_amdgcn_update_dpp(0, (int)(v), (ctrl), 0xF, 0xF, true))
__device__ __forceinline__ float row16_sum(float v) { v += DPPF_(v, 0xB1); v += DPPF_(v, 0x4E); v += DPPF_(v, 0x141); v += DPPF_(v, 0x140); return v; }
__device__ __forceinline__ float row16_max(float v) { v = fmaxf(v, DPPF_(v, 0xB1)); v = fmaxf(v, DPPF_(v, 0x4E)); v = fmaxf(v, DPPF_(v, 0x141)); v = fmaxf(v, DPPF_(v, 0x140)); return v; }
__device__ __forceinline__ float x16_sum(float v) { const unsigned u = __builtin_bit_cast(unsigned, v); const auto r = __builtin_amdgcn_permlane16_swap(u, u, false, false); return __builtin_bit_cast(float, (unsigned)r[0]) + __builtin_bit_cast(float, (unsigned)r[1]); }
__device__ __forceinline__ float x32_sum(float v) { const unsigned u = __builtin_bit_cast(unsigned, v); const auto r = __builtin_amdgcn_permlane32_swap(u, u, false, false); return __builtin_bit_cast(float, (unsigned)r[0]) + __builtin_bit_cast(float, (unsigned)r[1]); }
__device__ __forceinline__ float wave_sum(float v) { return x32_sum(x16_sum(row16_sum(v))); }
__device__ __forceinline__ unsigned wave_suffix_incl(unsigned s) {
    unsigned P = s;
    P += (unsigned)__builtin_amdgcn_update_dpp(0, (int)P, 0x111, 0xF, 0xF, false);
    P += (unsigned)__builtin_amdgcn_update_dpp(0, (int)P, 0x112, 0xF, 0xF, false);
    P += (unsigned)__builtin_amdgcn_update_dpp(0, (int)P, 0x114, 0xF, 0xF, false);
    P += (unsigned)__builtin_amdgcn_update_dpp(0, (int)P, 0x118, 0xF, 0xF, false);
    P += (unsigned)__builtin_amdgcn_update_dpp(0, (int)P, 0x142, 0xA, 0xF, false);
    P += (unsigned)__builtin_amdgcn_update_dpp(0, (int)P, 0x143, 0xC, 0xF, false);
    const unsigned total = (unsigned)__builtin_amdgcn_readlane((int)P, 63);
    return total - P + s;
}
__device__ __forceinline__ unsigned wave_min_u(unsigned v) { v = min(v, DPPU_(v, 0xB1)); v = min(v, DPPU_(v, 0x4E)); v = min(v, DPPU_(v, 0x141)); v = min(v, DPPU_(v, 0x140));
    { const auto r = __builtin_amdgcn_permlane16_swap(v, v, false, false); v = min((unsigned)r[0], (unsigned)r[1]); } { const auto r = __builtin_amdgcn_permlane32_swap(v, v, false, false); v = min((unsigned)r[0], (unsigned)r[1]); } return v; }
__device__ __forceinline__ unsigned wave_max_u(unsigned v) { v = max(v, DPPU_(v, 0xB1)); v = max(v, DPPU_(v, 0x4E)); v = max(v, DPPU_(v, 0x141)); v = max(v, DPPU_(v, 0x140));
    { const auto r = __builtin_amdgcn_permlane16_swap(v, v, false, false); v = max((unsigned)r[0], (unsigned)r[1]); } { const auto r = __builtin_amdgcn_permlane32_swap(v, v, false, false); v = max((unsigned)r[0], (unsigned)r[1]); } return v; }

namespace pg8 {
constexpr int BM = 256, BK = 64, HALF = 128, HTB = HALF * BK * 2, STAGE_BYTES = 8 * HTB, NXCD = 8, WGM = 8;
__host__ __device__ __forceinline__ int lds_byte(int r, int c) { const int st = (r >> 4) * 2 + (c >> 5), rr = r & 15, cc = c & 31, ob = rr * 64 + cc * 2; return st * 1024 + (ob ^ (((ob >> 9) & 1) << 5)); }
__host__ __device__ __forceinline__ void stage_rc(int b, int& R, int& C) { const int st = b / 1024, sb = b % 1024, swz = sb ^ (((sb >> 9) & 1) << 5); R = (st >> 1) * 16 + swz / 64; C = (st & 1) * 32 + (swz % 64) / 2; }
__host__ __device__ __forceinline__ int perm32(int rho) { const int n = rho >> 4, i = rho & 15; return 8 * (i >> 2) + 4 * n + (i & 3); }
struct Unit { int pm, pn; };
struct Gemm { const h16* A; const h16* Bt; int M, N, K, lda; };
struct StaticOrder {
    int nM, nN, nwg, G, c;
    __device__ void init(int M, int N, int G_, int c_) { nM = M / BM; nN = N / BM; nwg = nM * nN; G = G_; c = c_; }
    __device__ bool next(int i, Unit& u) const {
        const long L = (long)i * G + c; if (L >= nwg) return false;
        int wgid = (int)L; { const int q = nwg / NXCD, r = nwg % NXCD, xcd = wgid % NXCD, off = wgid / NXCD; wgid = (xcd < r ? xcd * (q + 1) : r * (q + 1) + (xcd - r) * q) + off; }
        const int nig = WGM * nN, gid = wgid / nig, fm = gid * WGM, gsz = (nM - fm) < WGM ? (nM - fm) : WGM;
        u.pm = fm + ((wgid % nig) % gsz); u.pn = (wgid % nig) / gsz; return true;
    }
};
template <class Epi>
__device__ __forceinline__ void gemm_phase(LAS unsigned char* lds, const Gemm g, const StaticOrder& S, const Epi& E) {
    const int tid = threadIdx.x, wid = __builtin_amdgcn_readfirstlane(tid >> 6), lane = tid & 63, wr = wid >> 2, wc = wid & 3, fr = lane & 15, fq = lane >> 4;
    const int K = g.K, nt = K / BK, lda = g.lda;
    unsigned voffA[2], voffB[2];
#pragma unroll
    for (int i = 0; i < 2; ++i) { int R, C; stage_rc(tid * 16 + i * 8192, R, C); const int Rb = (R & ~31) + perm32(R & 31);
        voffA[i] = (unsigned)(R * lda + C) * 2u; voffB[i] = (unsigned)(Rb * K + C) * 2u; }
    const size_t kstep = (size_t)(BK * 2);
    const size_t hstepA = (size_t)HALF * lda * 2, hstepB = (size_t)HALF * K * 2;
    const size_t tstepA = 2 * hstepA, tstepB = 2 * hstepB;
    const unsigned ldsw = (unsigned)wid * 1024u;
    const int aoff = lds_byte(wr * 64 + fr, fq * 8), boff = lds_byte(wc * 32 + fr, fq * 8);
#define PG8_SA(b, h) (((b) * 2 + (h)) * HTB)
#define PG8_SB(b, h) ((4 + (b) * 2 + (h)) * HTB)
#define PG8_STAGE(bufoff, gbase, voff) do { _Pragma("unroll") for (int _i = 0; _i < 2; ++_i) \
        __builtin_amdgcn_global_load_lds((const unsigned*)((const char*)(gbase) + (voff)[_i]), (LAS unsigned*)(lds + (bufoff) + ldsw + _i * 8192), 16, 0, 0); } while (0)
#define PG8_LDA(dst, b, h) do { _Pragma("unroll") for (int m = 0; m < 4; ++m) _Pragma("unroll") for (int k = 0; k < 2; ++k) dst[m][k] = *(const LAS h16x8*)(lds + PG8_SA(b, h) + aoff + m * 2048 + k * 1024); } while (0)
#define PG8_LDB(dst, b, h) do { _Pragma("unroll") for (int n = 0; n < 2; ++n) _Pragma("unroll") for (int k = 0; k < 2; ++k) dst[n][k] = *(const LAS h16x8*)(lds + PG8_SB(b, h) + boff + n * 2048 + k * 1024); } while (0)
#define PG8_MMA(ai, bj, At, Bt) do { __builtin_amdgcn_s_setprio(1); _Pragma("unroll") for (int m = 0; m < 4; ++m) _Pragma("unroll") for (int n = 0; n < 2; ++n) _Pragma("unroll") for (int k = 0; k < 2; ++k) \
        acc[ai][bj][m][n] = __builtin_amdgcn_mfma_f32_16x16x32_f16(Bt[n][k], At[m][k], acc[ai][bj][m][n], 0, 0, 0); __builtin_amdgcn_s_setprio(0); } while (0)
#define PG8_WAIT_V(n) asm volatile("s_waitcnt vmcnt(" #n ")" ::: "memory")
#define PG8_WAIT_L(n) asm volatile("s_waitcnt lgkmcnt(" #n ")" ::: "memory")
#define PG8_BAR __builtin_amdgcn_s_barrier()
#define PG8_SCHED __builtin_amdgcn_sched_barrier(0)
    Unit cur, nxt; int ui = 0;
    if (!S.next(0, cur)) return;
    f32x4 acc[2][2][4][2];
#pragma unroll
    for (int a = 0; a < 2; ++a)
#pragma unroll
        for (int b = 0; b < 2; ++b)
#pragma unroll
            for (int m = 0; m < 4; ++m)
#pragma unroll
                for (int n = 0; n < 2; ++n) acc[a][b][m][n] = (f32x4){0.f, 0.f, 0.f, 0.f};
    h16x8 At[4][2], B0[2][2], B1[2][2];
    const char* cA = (const char*)g.A + (size_t)cur.pm * tstepA; const char* cB = (const char*)g.Bt + (size_t)cur.pn * tstepB;
    PG8_STAGE(PG8_SB(0, 0), cB, voffB); PG8_STAGE(PG8_SB(0, 1), cB + hstepB, voffB); PG8_STAGE(PG8_SA(0, 0), cA, voffA); PG8_STAGE(PG8_SA(0, 1), cA + hstepA, voffA);
    if (wr == 1) PG8_BAR;
    PG8_WAIT_V(2); PG8_BAR;
    PG8_STAGE(PG8_SB(1, 0), cB + kstep, voffB); PG8_STAGE(PG8_SA(1, 0), cA + kstep, voffA); PG8_STAGE(PG8_SB(1, 1), cB + hstepB + kstep, voffB);
    PG8_WAIT_V(6); PG8_BAR;
    for (;;) {
        const bool has_next = S.next(ui + 1, nxt);
        const char* nA = has_next ? (const char*)g.A + (size_t)nxt.pm * tstepA : cA; const char* nB = has_next ? (const char*)g.Bt + (size_t)nxt.pn * tstepB : cB;
        for (int t = 0; t < nt; t += 2) {
            const bool last = (t == nt - 2);
            const char* a1 = cA + (size_t)(t + 1) * kstep;
            const char* a2 = last ? nA : cA + (size_t)(t + 2) * kstep; const char* b2 = last ? nB : cB + (size_t)(t + 2) * kstep;
            const char* a3 = a2 + kstep; const char* b3 = b2 + kstep;
            PG8_LDB(B0, 0, 0); PG8_LDB(B1, 0, 1); PG8_SCHED; PG8_LDA(At, 0, 0); PG8_STAGE(PG8_SA(1, 1), a1 + hstepA, voffA);
            PG8_WAIT_V(8); PG8_WAIT_L(0); PG8_BAR; PG8_MMA(0, 0, At, B0); PG8_MMA(0, 1, At, B1); PG8_BAR; PG8_SCHED;
            PG8_LDA(At, 0, 1); PG8_STAGE(PG8_SB(0, 0), b2, voffB); PG8_STAGE(PG8_SB(0, 1), b2 + hstepB, voffB); PG8_STAGE(PG8_SA(0, 0), a2, voffA);
            PG8_WAIT_V(8); PG8_WAIT_L(0); PG8_BAR; PG8_MMA(1, 0, At, B0); PG8_MMA(1, 1, At, B1); PG8_BAR; PG8_SCHED;
            PG8_LDB(B0, 1, 0); PG8_LDB(B1, 1, 1); PG8_SCHED; PG8_LDA(At, 1, 0); PG8_STAGE(PG8_SA(0, 1), a2 + hstepA, voffA);
            PG8_WAIT_V(8); PG8_WAIT_L(0); PG8_BAR; PG8_MMA(0, 0, At, B0); PG8_MMA(0, 1, At, B1); PG8_BAR; PG8_SCHED;
            PG8_LDA(At, 1, 1); PG8_STAGE(PG8_SB(1, 0), b3, voffB); PG8_STAGE(PG8_SB(1, 1), b3 + hstepB, voffB); PG8_STAGE(PG8_SA(1, 0), a3, voffA);
            PG8_WAIT_V(8); PG8_WAIT_L(0); PG8_BAR; PG8_MMA(1, 0, At, B0); PG8_MMA(1, 1, At, B1); PG8_BAR; PG8_SCHED;
        }
        if (wr == 0) PG8_BAR;
        E(acc, cur, wr, wc, fr, fq);
        if (!has_next) break;
#pragma unroll
        for (int a = 0; a < 2; ++a)
#pragma unroll
            for (int b = 0; b < 2; ++b)
#pragma unroll
                for (int m = 0; m < 4; ++m)
#pragma unroll
                    for (int n = 0; n < 2; ++n) acc[a][b][m][n] = (f32x4){0.f, 0.f, 0.f, 0.f};
        cur = nxt; cA = nA; cB = nB; ++ui;
        if (wr == 1) PG8_BAR;
    }
    PG8_WAIT_V(0);
    PG8_BAR;
#undef PG8_SA
#undef PG8_SB
#undef PG8_STAGE
#undef PG8_LDA
#undef PG8_LDB
#undef PG8_MMA
#undef PG8_WAIT_V
#undef PG8_WAIT_L
#undef PG8_BAR
#undef PG8_SCHED
}
}

__device__ __forceinline__ u64 pack8_fp8(const f32x4 a, const f32x4 b) {
    int w0 = __builtin_amdgcn_cvt_pk_fp8_f32(a[0], a[1], 0, false); w0 = __builtin_amdgcn_cvt_pk_fp8_f32(a[2], a[3], w0, true);
    int w1 = __builtin_amdgcn_cvt_pk_fp8_f32(b[0], b[1], 0, false); w1 = __builtin_amdgcn_cvt_pk_fp8_f32(b[2], b[3], w1, true);
    return (u64)(unsigned)w0 | ((u64)(unsigned)w1 << 32);
}
__device__ __forceinline__ h16x8 fp8x8_to_h16(const u64 v) {
    const int w0 = (int)(unsigned)v, w1 = (int)(unsigned)(v >> 32);
    const f32x2 a = __builtin_amdgcn_cvt_pk_f32_fp8(w0, false), b = __builtin_amdgcn_cvt_pk_f32_fp8(w0, true), c = __builtin_amdgcn_cvt_pk_f32_fp8(w1, false), d = __builtin_amdgcn_cvt_pk_f32_fp8(w1, true);
    h16x8 h; h[0] = (h16)a.x; h[1] = (h16)a.y; h[2] = (h16)b.x; h[3] = (h16)b.y; h[4] = (h16)c.x; h[5] = (h16)c.y; h[6] = (h16)d.x; h[7] = (h16)d.y;
    return h;
}
__device__ __forceinline__ int kvpos(int lc) { if (lc >= 256) return lc; const int j = lc >> 6, d = lc & 63; return j * 64 + ((d & 31) >> 3) * 16 + (d >> 5) * 8; }
__device__ __forceinline__ u32x4 pack8(const f32x4 a, const f32x4 b) {
    h16x8 h; h[0] = (h16)a[0]; h[1] = (h16)a[1]; h[2] = (h16)a[2]; h[3] = (h16)a[3]; h[4] = (h16)b[0]; h[5] = (h16)b[1]; h[6] = (h16)b[2]; h[7] = (h16)b[3];
    return __builtin_bit_cast(u32x4, h);
}

struct EpiProj {
    h16* PROJ; const float* rstd; float* dout; unsigned char* KVS; h16* KIS; unsigned char* KVC; h16* KIC;
    __device__ __forceinline__ void operator()(const f32x4 (&acc)[2][2][4][2], const pg8::Unit& u, int wr, int wc, int fr, int fq) const {
        const int row0 = u.pm * 256 + wr * 64 + fr, col0 = u.pn * 256 + wc * 32 + 8 * fq;
        const int pn = u.pn;
#pragma unroll
        for (int ai = 0; ai < 2; ++ai)
#pragma unroll
            for (int m = 0; m < 4; ++m) {
                const int row = row0 + ai * 128 + m * 16; const float rs = rstd[row];
#pragma unroll
                for (int bj = 0; bj < 2; ++bj) {
                    const int c = col0 + bj * 128;
                    const f32x4 v0 = acc[ai][bj][m][0] * rs, v1 = acc[ai][bj][m][1] * rs;
                    if (pn != 8 && pn != 9) *(u32x4*)(PROJ + (size_t)row * NPJ + c) = pack8(v0, v1);
                    if (pn == 8 || pn == 9 || (pn == 14 && c < C_KI + 64)) {
                        if (row < MP) {
                            float* o = (pn == 8) ? dout + O_PK + (size_t)row * 256 + (c - C_K) : (pn == 9) ? dout + O_PV + (size_t)row * 256 + (c - C_VV) : dout + O_PKI + (size_t)row * 64 + (c - C_KI);
                            *(f32x4*)o = v0; *(f32x4*)(o + 4) = v1;
                            if (pn == 14) *(u32x4*)(KIC + (size_t)row * 64 + (c - C_KI)) = pack8(v0, v1);
                            else *(u64*)(KVC + (size_t)row * 512 + kvpos(c - C_K)) = pack8_fp8(v0, v1);
                        } else if (row < MROWS) {
                            const int t = row - MP, b = t >> 4, s = t & 15; const size_t kr = (size_t)b * NKSP + PAST + s;
                            float* o = (pn == 8) ? dout + O_SK + (size_t)t * 256 + (c - C_K) : (pn == 9) ? dout + O_SV + (size_t)t * 256 + (c - C_VV) : dout + O_SKI + (size_t)t * 64 + (c - C_KI);
                            *(f32x4*)o = v0; *(f32x4*)(o + 4) = v1;
                            if (pn == 14) *(u32x4*)(KIS + kr * 64 + (c - C_KI)) = pack8(v0, v1);
                            else *(u64*)(KVS + kr * 512 + kvpos(c - C_K)) = pack8_fp8(v0, v1);
                        }
                    }
                }
            }
    }
};
template <int FIRST> struct EpiGate {
    h16* PROJ;
    __device__ __forceinline__ void operator()(const f32x4 (&acc)[2][2][4][2], const pg8::Unit& u, int wr, int wc, int fr, int fq) const {
        const int row0 = u.pm * 256 + wr * 64 + fr, col0 = u.pn * 256 + wc * 32 + 8 * fq;
#pragma unroll
        for (int ai = 0; ai < 2; ++ai)
#pragma unroll
            for (int m = 0; m < 4; ++m) {
                const int row = row0 + ai * 128 + m * 16;
#pragma unroll
                for (int bj = 0; bj < 2; ++bj) {
                    const int c = col0 + bj * 128;
                    h16* pm_ = PROJ + (size_t)row * NPJ + (FIRST ? C_T : C_M) + c;
                    const h16x8 gt = *(const h16x8*)(PROJ + (size_t)row * NPJ + (FIRST ? C_GA : C_GB) + c);
                    f32x4 v0, v1;
#pragma unroll
                    for (int j = 0; j < 4; ++j) { v0[j] = sigmoidf_((float)gt[j]) * acc[ai][bj][m][0][j]; v1[j] = sigmoidf_((float)gt[4 + j]) * acc[ai][bj][m][1][j]; }
                    if (!FIRST) { const h16x8 tp = *(const h16x8*)(PROJ + (size_t)row * NPJ + C_T + c);
#pragma unroll
                        for (int j = 0; j < 4; ++j) { v0[j] += (float)tp[j]; v1[j] += (float)tp[4 + j]; } }
                    *(u32x4*)pm_ = pack8(v0, v1);
                }
            }
    }
};
struct EpiOut {
    const float* xp; const float* xs; float* dout; float* rowss;
    __device__ __forceinline__ void operator()(const f32x4 (&acc)[2][2][4][2], const pg8::Unit& u, int wr, int wc, int fr, int fq) const {
        const int row0 = u.pm * 256 + wr * 64 + fr, col0 = u.pn * 256 + wc * 32 + 8 * fq;
#pragma unroll
        for (int ai = 0; ai < 2; ++ai)
#pragma unroll
            for (int m = 0; m < 4; ++m) {
                const int row = row0 + ai * 128 + m * 16;
                const bool ok = row < MROWS;
                const float* xr = (row < MP) ? xp + (size_t)row * DM : xs + (size_t)(row - MP) * DM;
                float* yr = (row < MP) ? dout + O_YP + (size_t)row * DM : dout + O_YS + (size_t)(row - MP) * DM;
                float ss = 0.f;
                if (ok) {
#pragma unroll
                    for (int bj = 0; bj < 2; ++bj) {
                        const int c = col0 + bj * 128;
                        const f32x4 x0 = *(const f32x4*)(xr + c), x1 = *(const f32x4*)(xr + c + 4);
                        const f32x4 v0 = x0 + acc[ai][bj][m][0], v1 = x1 + acc[ai][bj][m][1];
                        *(f32x4*)(yr + c) = v0; *(f32x4*)(yr + c + 4) = v1;
                        ss += v0[0] * v0[0] + v0[1] * v0[1] + v0[2] * v0[2] + v0[3] * v0[3] + v1[0] * v1[0] + v1[1] * v1[1] + v1[2] * v1[2] + v1[3] * v1[3];
                    }
                }
                ss = x32_sum(x16_sum(ss));
                if (ok && fq == 0) rowss[(size_t)row * 16 + u.pn * 4 + wc] = ss;
            }
    }
};

struct Params {
    const float *xp, *xs, *ck, *cv, *cki, *norm_g, *w_in, *ln_g, *ln_b, *sgu_w, *sgu_b, *w_pa, *w_pb, *w_out, *final_g;
    float* out; unsigned char* ws; int ph_lo, ph_hi;
};

__device__ __forceinline__ void p0_tr_item(const float* W, int K, int Nsrc, h16* WT, const float* gs, int mode, float* scr, int item, int nblk, int lane) {
    const int kb = item / nblk, nb = item % nblk, k0 = 64 * kb, n0 = 32 * nb;
    const int nn = n0 + (lane & 31);
    int src = nn; bool valid = true;
    if (mode == 1) { if (nn >= C_WI + 8 && nn < C_GA) valid = false; else if (nn >= C_GA) src = nn - (C_GA - (C_WI + 8)); }
#pragma unroll 8
    for (int i = 0; i < 32; ++i) { const int kk = 2 * i + (lane >> 5);
        float v = 0.f; if (valid) { v = W[(size_t)(k0 + kk) * Nsrc + src]; if (gs) v *= gs[k0 + kk]; }
        scr[kk * 33 + (lane & 31)] = v; }
    __builtin_amdgcn_s_waitcnt(0); asm volatile("" ::: "memory");
    const int c = lane & 7;
#pragma unroll
    for (int j = 0; j < 4; ++j) { const int n = (lane >> 3) + 8 * j; const float* s = scr + (8 * c) * 33 + n;
        h16x8 h;
#pragma unroll
        for (int q = 0; q < 8; ++q) h[q] = (h16)s[q * 33];
        *(h16x8*)(WT + (size_t)(n0 + n) * K + k0 + 8 * c) = h; }
    __builtin_amdgcn_s_waitcnt(0); asm volatile("" ::: "memory");
}

constexpr int VNT_LD = 136;
__device__ __forceinline__ void sgu_chunk(const Params& p, unsigned char* lds, int chunk, int wave, int lane) {
    h16* PROJ = (h16*)(p.ws + WS_PROJ);
    h16* vnT = (h16*)lds;
    h16* AOUT = (h16*)(p.ws + WS_AOUT);
    const h16* WSM = (const h16*)(p.ws + WS_WSM);
    {
        float lg[8], lb[8];
#pragma unroll
        for (int j = 0; j < 8; ++j) { lg[j] = p.ln_g[lane * 8 + j]; lb[j] = p.ln_b[lane * 8 + j]; }
        for (int tt = 0; tt < 16; ++tt) {
            const int tok = wave * 16 + tt; const size_t row = (size_t)chunk * 128 + tok;
            const h16x8 vv = *(const h16x8*)(PROJ + row * NPJ + C_V + lane * 8);
            float g[8]; float s = 0.f;
#pragma unroll
            for (int j = 0; j < 8; ++j) { g[j] = geluf_((float)vv[j]); s += g[j]; }
            const float mean = wave_sum(s) * (1.f / 512.f); float q = 0.f;
#pragma unroll
            for (int j = 0; j < 8; ++j) { g[j] -= mean; q += g[j] * g[j]; }
            const float rstd = rsqrtf(wave_sum(q) * (1.f / 512.f) + 1e-5f);
#pragma unroll
            for (int j = 0; j < 8; ++j) vnT[(lane * 8 + j) * VNT_LD + tok] = (h16)(g[j] * rstd * lg[j] + lb[j]);
        }
    }
    __syncthreads();
    {
        const int g = wave, fr = lane & 15, fq = lane >> 4;
        for (int it = 0; it < 8; ++it) {
            f32x4 acc[4];
#pragma unroll
            for (int dt = 0; dt < 4; ++dt) acc[dt] = (f32x4){0.f, 0.f, 0.f, 0.f};
            const int nks = (it < 4) ? 2 : 4;
            for (int ks = 0; ks < nks; ++ks) {
                const h16x8 b = *(const h16x8*)(WSM + ((size_t)g * 128 + it * 16 + fr) * 128 + ks * 32 + fq * 8);
#pragma unroll
                for (int dt = 0; dt < 4; ++dt) {
                    const h16x8 a = *(const h16x8*)(vnT + (g * 64 + dt * 16 + fr) * VNT_LD + ks * 32 + fq * 8);
                    acc[dt] = __builtin_amdgcn_mfma_f32_16x16x32_f16(a, b, acc[dt], 0, 0, 0);
                }
            }
            const int i = it * 16 + fr; const size_t row = (size_t)chunk * 128 + i;
            const float bias = p.sgu_b[g * 128 + i];
#pragma unroll
            for (int dt = 0; dt < 4; ++dt) {
                const int c = g * 64 + dt * 16 + fq * 4;
                const h16x4 uu = *(const h16x4*)(PROJ + row * NPJ + C_U + c); const h16x4 zz = *(const h16x4*)(PROJ + row * NPJ + C_ZA + c);
                h16x4 o;
#pragma unroll
                for (int r = 0; r < 4; ++r) o[r] = (h16)(geluf_((float)uu[r]) * (acc[dt][r] + bias) * siluf_((float)zz[r]));
                *(h16x4*)(AOUT + row * 512 + c) = o;
            }
        }
    }
    __syncthreads();
}
__device__ __forceinline__ void sgu_sample(const Params& p, unsigned char* lds, int b, int wave, int lane) {
    h16* PROJ = (h16*)(p.ws + WS_PROJ);
    float* vnS = (float*)lds;
    for (int tt = 0; tt < 2; ++tt) {
        const int t = wave * 2 + tt; const size_t row = (size_t)MP + b * 16 + t;
        const h16x8 vv = *(const h16x8*)(PROJ + row * NPJ + C_V + lane * 8);
        float g[8]; float s = 0.f;
#pragma unroll
        for (int j = 0; j < 8; ++j) { g[j] = geluf_((float)vv[j]); s += g[j]; }
        const float mean = wave_sum(s) * (1.f / 512.f); float q = 0.f;
#pragma unroll
        for (int j = 0; j < 8; ++j) { g[j] -= mean; q += g[j] * g[j]; }
        const float rstd = rsqrtf(wave_sum(q) * (1.f / 512.f) + 1e-5f);
#pragma unroll
        for (int j = 0; j < 8; ++j) { const int c = lane * 8 + j; const float v = g[j] * rstd * p.ln_g[c] + p.ln_b[c];
            vnS[t * 512 + c] = v; p.out[O_SSV + (size_t)(b * 16 + t) * 512 + c] = v; }
    }
    __syncthreads();
    {
        const int c = threadIdx.x, g = c >> 6;
        float vn[16];
#pragma unroll
        for (int j = 0; j < 16; ++j) vn[j] = vnS[j * 512 + c];
        for (int i = 0; i < 16; ++i) {
            float mixed = p.sgu_b[g * 128 + i];
#pragma unroll
            for (int j = 0; j < 16; ++j) mixed += p.sgu_w[((size_t)g * 128 + i) * 128 + j] * vn[j];
            const size_t row = (size_t)MP + b * 16 + i;
            const float u = (float)PROJ[row * NPJ + C_U + c], za = (float)PROJ[row * NPJ + C_ZA + c];
            ((h16*)(p.ws + WS_AOUT))[row * 512 + c] = (h16)(geluf_(u) * mixed * siluf_(za));
        }
    }
    __syncthreads();
}

constexpr int TK_C = 2048, TK_TRIG = TK_C - 512;
constexpr int L3_QA = 147456;
constexpr int L3_HIST = 131072, L3_CNT = L3_HIST + 8192, L3_THR = L3_CNT + 32, L3_SUM = L3_THR + 32;
__device__ __forceinline__ unsigned fkey(float f) { const unsigned u = __float_as_uint(f); return (u & 0x80000000u) ? ~u : (u | 0x80000000u); }
__device__ __forceinline__ float fkey_inv(unsigned k) { return __uint_as_float((k & 0x80000000u) ? (k ^ 0x80000000u) : ~k); }

template <bool ON_LO>
__device__ __forceinline__ unsigned radix_select(const u64* buf, unsigned* hist, int n, int lane, unsigned fhi, int k, int& ceq_out, int& krem_out) {
    unsigned prefix = 0, pmask = 0; int krem = k; int ceq = 0;
    for (int shift = 24; shift >= 0; shift -= 8) {
        *(u32x4*)(hist + 4 * lane) = (u32x4){0u, 0u, 0u, 0u};
        asm volatile("s_waitcnt lgkmcnt(0)" ::: "memory");
        for (int i = lane; i < n; i += 64) {
            const u64 e = buf[i]; const unsigned hi = (unsigned)(e >> 32), lo = (unsigned)e;
            const unsigned key = ON_LO ? lo : hi;
            const bool ok = (ON_LO ? (hi == fhi) : true) && ((key & pmask) == prefix);
            if (ok) atomicAdd(hist + ((key >> shift) & 255u), 1u);
        }
        asm volatile("s_waitcnt lgkmcnt(0)" ::: "memory");
        const u32x4 hv = *(const u32x4*)(hist + 4 * lane);
        const unsigned s = hv.x + hv.y + hv.z + hv.w;
        const unsigned S = wave_suffix_incl(s);
        const bool is = (S >= (unsigned)krem) && (S - s < (unsigned)krem);
        const u64 bm = __ballot(is);
        const int L = bm ? (__ffsll((long long)bm) - 1) : 0;
        unsigned d = 0, cab = S - s, ce = 0;
        { unsigned c = S - s;
          if (c + hv.w >= (unsigned)krem) { d = 3; cab = c; ce = hv.w; }
          else { c += hv.w; if (c + hv.z >= (unsigned)krem) { d = 2; cab = c; ce = hv.z; }
          else { c += hv.z; if (c + hv.y >= (unsigned)krem) { d = 1; cab = c; ce = hv.y; }
          else { c += hv.y; d = 0; cab = c; ce = hv.x; } } } }
        { const int Ls_ = __builtin_amdgcn_readfirstlane(L); d = __builtin_amdgcn_readlane(d, Ls_); cab = __builtin_amdgcn_readlane(cab, Ls_); ce = __builtin_amdgcn_readlane(ce, Ls_); }
        const unsigned digit = 4u * (unsigned)L + d;
        krem -= (int)cab; ceq = (int)ce; prefix |= digit << shift; pmask |= 255u << shift;
    }
    ceq_out = ceq; krem_out = krem;
    return prefix;
}
__device__ __forceinline__ int tk_compact(u64* buf, unsigned* hist, int n, int lane_in, float& thr) {
    int lane = lane_in; asm volatile("" : "+v"(lane));
    unsigned ehi[32];
    const unsigned* b32 = (const unsigned*)buf;
#pragma unroll
    for (int j = 0; j < 32; ++j) { ehi[j] = 0u; if (64 * j < n) { const int ic = min(lane + 64 * j, n - 1); ehi[j] = b32[2 * ic + 1]; } }
    unsigned mn = 0xFFFFFFFFu, mx = 0u;
#pragma unroll
    for (int j = 0; j < 32; ++j) { if (64 * j < n) { mn = min(mn, ehi[j]); mx = max(mx, ehi[j]); } }
    mn = wave_min_u(mn); mx = wave_max_u(mx);
    const unsigned range = mx - mn; const int sh = range ? __clz(range) : 0;
#pragma unroll
    for (int j = 0; j < 32; ++j) { const unsigned nk = (ehi[j] - mn) << sh; ehi[j] = ((lane + 64 * j) < n) ? nk : 0u; }
    const unsigned ninv = (unsigned)(((n + 63) & ~63) - n);
    unsigned prefix = 0, pmask = 0; int krem = 256; bool done = false;
    for (int shift = 24; shift >= 0 && !done; shift -= 8) {
        *(u32x4*)(hist + 4 * lane) = (u32x4){0u, 0u, 0u, 0u};
        asm volatile("s_waitcnt lgkmcnt(0)" ::: "memory");
#pragma unroll
        for (int j = 0; j < 32; ++j) { if (64 * j < n) { if ((ehi[j] & pmask) == prefix) atomicAdd(hist + ((ehi[j] >> shift) & 255u), 1u); } }
        asm volatile("s_waitcnt lgkmcnt(0)" ::: "memory");
        u32x4 hv = *(const u32x4*)(hist + 4 * lane);
        if (lane == 0 && prefix == 0u) hv.x -= ninv;
        const unsigned s = hv.x + hv.y + hv.z + hv.w;
        const unsigned S = wave_suffix_incl(s);
        const bool is = (S >= (unsigned)krem) && (S - s < (unsigned)krem);
        const u64 bm = __ballot(is);
        const int L = bm ? (__ffsll((long long)bm) - 1) : 0;
        unsigned d = 0, cab = S - s, ce = 0;
        { unsigned c = S - s;
          if (c + hv.w >= (unsigned)krem) { d = 3; cab = c; ce = hv.w; }
          else { c += hv.w; if (c + hv.z >= (unsigned)krem) { d = 2; cab = c; ce = hv.z; }
          else { c += hv.z; if (c + hv.y >= (unsigned)krem) { d = 1; cab = c; ce = hv.y; }
          else { c += hv.y; d = 0; cab = c; ce = hv.x; } } } }
        { const int Ls_ = __builtin_amdgcn_readfirstlane(L); d = __builtin_amdgcn_readlane(d, Ls_); cab = __builtin_amdgcn_readlane(cab, Ls_); ce = __builtin_amdgcn_readlane(ce, Ls_); }
        krem -= (int)cab; prefix |= (4u * (unsigned)L + d) << shift; pmask |= 255u << shift;
        if ((int)ce == krem) done = true;
    }
    unsigned tlo = 0u;
    const unsigned thi_abs = mn + ((prefix + ((1u << sh) - 1u)) >> sh);
    if (!done) { int c2, k2; tlo = radix_select<true>(buf, hist, n, lane, mn + (prefix >> sh), krem, c2, k2); }
    int outn = 0;
#pragma unroll
    for (int j = 0; j < 32; ++j) {
        if (64 * j < n) {
            const int i = lane + 64 * j; const int ic = min(i, n - 1);
            const unsigned elo_ = b32[2 * ic];
            const bool keep = (i < n) && ((ehi[j] > prefix) || ((ehi[j] & pmask) == prefix && (done || elo_ >= tlo)));
            const u64 bm = __ballot(keep);
            const int off = __builtin_amdgcn_mbcnt_hi((unsigned)(bm >> 32), __builtin_amdgcn_mbcnt_lo((unsigned)bm, 0u));
            if (keep) buf[outn + off] = ((u64)(mn + (ehi[j] >> sh)) << 32) | (u64)elo_;
            outn += __popcll(bm);
        }
    }
    asm volatile("s_waitcnt lgkmcnt(0)" ::: "memory");
    thr = fkey_inv(thi_abs - 1u);
    return outn;
}

struct AUnit { int qrow0, krow0, nk; const h16* kib; int kis; const unsigned char* kvb; int kvs; };

__device__ __forceinline__ void attn_unit(const Params& p, unsigned char* lds, const AUnit U, int wave, int lane, unsigned long long& tacc) {
    h16* PROJ = (h16*)(p.ws + WS_PROJ);
    u64* bufall = (u64*)lds;
    unsigned* hist = (unsigned*)(lds + L3_HIST) + wave * 256;
    unsigned* cnt = (unsigned*)(lds + L3_CNT);
    float* thrs = (float*)(lds + L3_THR);
    float* sums = (float*)(lds + L3_SUM) + wave * 8;
    int lane_r = lane; asm volatile("" : "+v"(lane_r));
    const int half = lane_r >> 5, l31 = lane_r & 31;
    f32x2 wq[2][2][4]; h16x8 qa[2][4];
    h16x8* qalds = (h16x8*)(lds + L3_QA);
#define LOADQA() do { _Pragma("unroll") for (int mt = 0; mt < 2; ++mt) _Pragma("unroll") for (int ks = 0; ks < 4; ++ks) qa[mt][ks] = qalds[(mt * 4 + ks) * 64 + lane_r]; } while (0)
#define LOADQ() do { _Pragma("unroll") for (int mt = 0; mt < 2; ++mt) _Pragma("unroll") for (int e = 0; e < 2; ++e) \
        { const h16x8 w8_ = *(const h16x8*)(PROJ + (size_t)(U.qrow0 + mt * 4 + 2 * half + e) * NPJ + C_WI); \
          _Pragma("unroll") for (int h = 0; h < 4; ++h) wq[mt][e][h] = (f32x2){(float)w8_[2 * h], (float)w8_[2 * h + 1]}; } } while (0)
    {
        int lane_s = lane; asm volatile("" : "+v"(lane_s)); const int l31 = lane_s & 31, half = lane_s >> 5;
        const int ql = 2 * ((l31 >> 2) & 1) + (l31 >> 4), hh = ((l31 >> 3) & 1) * 4 + (l31 & 3);
        const int mt_ = wave >> 2, ks_ = wave & 3;
        qalds[wave * 64 + lane_s] = *(const h16x8*)(PROJ + (size_t)(U.qrow0 + mt_ * 4 + ql) * NPJ + C_QI + hh * 64 + half * 8 + ks_ * 16);
    }
    __builtin_amdgcn_sched_barrier(0);
    LOADQ();
    __builtin_amdgcn_sched_barrier(0);
    for (int repi_ = 0; repi_ < REP_IDX; ++repi_) {
    __syncthreads();
    { const int t8 = lane_id(); if (wave == 0 && t8 < 8) { cnt[t8] = 0u; thrs[t8] = -__builtin_inff(); } }
    __syncthreads();
    const int nkt = (U.nk + 31) >> 5, rounds = (nkt + 15) >> 4;
    LOADQA();
    h16x8 bf[2][4], bn[2][4];
#define LOADB(dst, rdx) do { _Pragma("unroll") for (int rr = 0; rr < 2; ++rr) { const int kt_ = (rdx) * 16 + rr * 8 + wave; const int ktc_ = kt_ < nkt ? kt_ : nkt - 1; \
        const h16* kp_ = U.kib + (size_t)(U.krow0 + ktc_ * 32 + l31) * U.kis + half * 8; \
        _Pragma("unroll") for (int ks = 0; ks < 4; ++ks) dst[rr][ks] = *(const h16x8*)(kp_ + ks * 16); } } while (0)
    TBEG(1)
    LOADB(bf, 0);
#pragma unroll 1
    for (int rd = 0; rd < rounds; rd += 2) {
        LOADB(bn, rd + 1);
#pragma unroll
        for (int rr = 0; rr < 2; ++rr) {
            const int kt = (rd) * 16 + rr * 8 + wave;
            if (kt < nkt) {
                const int key = kt * 32 + l31; const bool kvalid = key < U.nk;
                f32x16 ccs[2];
#pragma unroll
                for (int r = 0; r < 16; ++r) { ccs[0][r] = 0.f; ccs[1][r] = 0.f; }
#pragma unroll
                for (int ks = 0; ks < 4; ++ks) { ccs[0] = __builtin_amdgcn_mfma_f32_32x32x16_f16(qa[0][ks], bf[rr][ks], ccs[0], 0, 0, 0); ccs[1] = __builtin_amdgcn_mfma_f32_32x32x16_f16(qa[1][ks], bf[rr][ks], ccs[1], 0, 0, 0); }
#pragma unroll
                for (int mt = 0; mt < 2; ++mt) {
                    const f32x16 cc = ccs[mt];
                    float sv[2]; bool ps[2];
                    const f32x2 thp = *(const f32x2*)(thrs + mt * 4 + 2 * half);
#pragma unroll
                    for (int e = 0; e < 2; ++e) {
                        f32x2 s2 = (f32x2){0.f, 0.f};
#pragma unroll
                        for (int h = 0; h < 4; ++h) {
                            const f32x2 r2 = (f32x2){__int_as_float(max(__float_as_int(cc[e * 8 + 2 * h]), 0)), __int_as_float(max(__float_as_int(cc[e * 8 + 2 * h + 1]), 0))};
                            s2 = __builtin_elementwise_fma(r2, wq[mt][e][h], s2);
                        }
                        const float s = s2.x + s2.y;
                        sv[e] = s; ps[e] = kvalid && (s > thp[e]);
                    }
                    const u64 bm0 = __ballot(ps[0]), bm1 = __ballot(ps[1]);
                    if (bm0 | bm1) {
                        const int ql = lane - mt * 4;
                        unsigned myc = 0u;
                        myc = (ql == 0) ? (unsigned)__popc((unsigned)bm0) : myc;
                        myc = (ql == 1) ? (unsigned)__popc((unsigned)bm1) : myc;
                        myc = (ql == 2) ? (unsigned)__popc((unsigned)(bm0 >> 32)) : myc;
                        myc = (ql == 3) ? (unsigned)__popc((unsigned)(bm1 >> 32)) : myc;
                        unsigned basev = 0u;
                        if ((unsigned)ql < 4u && myc) basev = atomicAdd(cnt + lane, myc);
                        const unsigned b00 = __builtin_amdgcn_readlane(basev, mt * 4), b01 = __builtin_amdgcn_readlane(basev, mt * 4 + 1);
                        const unsigned b10 = __builtin_amdgcn_readlane(basev, mt * 4 + 2), b11 = __builtin_amdgcn_readlane(basev, mt * 4 + 3);
                        const unsigned ltm = (1u << l31) - 1u;
                        if (ps[0]) { const unsigned hm = half ? (unsigned)(bm0 >> 32) : (unsigned)bm0; const unsigned pos = (half ? b10 : b00) + (unsigned)__popc(hm & ltm);
                            bufall[(size_t)(mt * 4 + 2 * half) * TK_C + pos] = ((u64)fkey(sv[0]) << 32) | (u64)(~(unsigned)key); }
                        if (ps[1]) { const unsigned hm = half ? (unsigned)(bm1 >> 32) : (unsigned)bm1; const unsigned pos = (half ? b11 : b01) + (unsigned)__popc(hm & ltm);
                            bufall[(size_t)(mt * 4 + 2 * half + 1) * TK_C + pos] = ((u64)fkey(sv[1]) << 32) | (u64)(~(unsigned)key); }
                    }
                }
            }
        }
        { TBEG(6)
        LDS_BARRIER();
        TEND(6) }
        bool need;
        { const u32x4 c0_ = *(const u32x4*)cnt, c1_ = *(const u32x4*)(cnt + 4); const unsigned m_ = max(max(max(c0_.x, c0_.y), max(c0_.z, c0_.w)), max(max(c1_.x, c1_.y), max(c1_.z, c1_.w))); need = m_ > (unsigned)TK_TRIG; }
        { TBEG(6)
        LDS_BARRIER();
        TEND(6) }
        if (need && (rd) + 1 < rounds) {
            TBEG(2)
            const int n = (int)cnt[wave];
            if (n > 256) { float t; const int nn = tk_compact(bufall + (size_t)wave * TK_C, hist, n, lane, t); if (lane == 0) { cnt[wave] = (unsigned)nn; thrs[wave] = t; } }
            __builtin_amdgcn_sched_barrier(0);
            LOADQ(); LOADQA(); LOADB(bn, rd + 1);
            LDS_BARRIER();
            TEND(2)
        }
        if (rd + 1 < rounds) {
        LOADB(bf, rd + 2);
#pragma unroll
        for (int rr = 0; rr < 2; ++rr) {
            const int kt = (rd + 1) * 16 + rr * 8 + wave;
            if (kt < nkt) {
                const int key = kt * 32 + l31; const bool kvalid = key < U.nk;
                f32x16 ccs[2];
#pragma unroll
                for (int r = 0; r < 16; ++r) { ccs[0][r] = 0.f; ccs[1][r] = 0.f; }
#pragma unroll
                for (int ks = 0; ks < 4; ++ks) { ccs[0] = __builtin_amdgcn_mfma_f32_32x32x16_f16(qa[0][ks], bn[rr][ks], ccs[0], 0, 0, 0); ccs[1] = __builtin_amdgcn_mfma_f32_32x32x16_f16(qa[1][ks], bn[rr][ks], ccs[1], 0, 0, 0); }
#pragma unroll
                for (int mt = 0; mt < 2; ++mt) {
                    const f32x16 cc = ccs[mt];
                    float sv[2]; bool ps[2];
                    const f32x2 thp = *(const f32x2*)(thrs + mt * 4 + 2 * half);
#pragma unroll
                    for (int e = 0; e < 2; ++e) {
                        f32x2 s2 = (f32x2){0.f, 0.f};
#pragma unroll
                        for (int h = 0; h < 4; ++h) {
                            const f32x2 r2 = (f32x2){__int_as_float(max(__float_as_int(cc[e * 8 + 2 * h]), 0)), __int_as_float(max(__float_as_int(cc[e * 8 + 2 * h + 1]), 0))};
                            s2 = __builtin_elementwise_fma(r2, wq[mt][e][h], s2);
                        }
                        const float s = s2.x + s2.y;
                        sv[e] = s; ps[e] = kvalid && (s > thp[e]);
                    }
                    const u64 bm0 = __ballot(ps[0]), bm1 = __ballot(ps[1]);
                    if (bm0 | bm1) {
                        const int ql = lane - mt * 4;
                        unsigned myc = 0u;
                        myc = (ql == 0) ? (unsigned)__popc((unsigned)bm0) : myc;
                        myc = (ql == 1) ? (unsigned)__popc((unsigned)bm1) : myc;
                        myc = (ql == 2) ? (unsigned)__popc((unsigned)(bm0 >> 32)) : myc;
                        myc = (ql == 3) ? (unsigned)__popc((unsigned)(bm1 >> 32)) : myc;
                        unsigned basev = 0u;
                        if ((unsigned)ql < 4u && myc) basev = atomicAdd(cnt + lane, myc);
                        const unsigned b00 = __builtin_amdgcn_readlane(basev, mt * 4), b01 = __builtin_amdgcn_readlane(basev, mt * 4 + 1);
                        const unsigned b10 = __builtin_amdgcn_readlane(basev, mt * 4 + 2), b11 = __builtin_amdgcn_readlane(basev, mt * 4 + 3);
                        const unsigned ltm = (1u << l31) - 1u;
                        if (ps[0]) { const unsigned hm = half ? (unsigned)(bm0 >> 32) : (unsigned)bm0; const unsigned pos = (half ? b10 : b00) + (unsigned)__popc(hm & ltm);
                            bufall[(size_t)(mt * 4 + 2 * half) * TK_C + pos] = ((u64)fkey(sv[0]) << 32) | (u64)(~(unsigned)key); }
                        if (ps[1]) { const unsigned hm = half ? (unsigned)(bm1 >> 32) : (unsigned)bm1; const unsigned pos = (half ? b11 : b01) + (unsigned)__popc(hm & ltm);
                            bufall[(size_t)(mt * 4 + 2 * half + 1) * TK_C + pos] = ((u64)fkey(sv[1]) << 32) | (u64)(~(unsigned)key); }
                    }
                }
            }
        }
        { TBEG(6)
        LDS_BARRIER();
        TEND(6) }
        bool need;
        { const u32x4 c0_ = *(const u32x4*)cnt, c1_ = *(const u32x4*)(cnt + 4); const unsigned m_ = max(max(max(c0_.x, c0_.y), max(c0_.z, c0_.w)), max(max(c1_.x, c1_.y), max(c1_.z, c1_.w))); need = m_ > (unsigned)TK_TRIG; }
        { TBEG(6)
        LDS_BARRIER();
        TEND(6) }
        if (need && (rd + 1) + 1 < rounds) {
            TBEG(2)
            const int n = (int)cnt[wave];
            if (n > 256) { float t; const int nn = tk_compact(bufall + (size_t)wave * TK_C, hist, n, lane, t); if (lane == 0) { cnt[wave] = (unsigned)nn; thrs[wave] = t; } }
            __builtin_amdgcn_sched_barrier(0);
            LOADQ(); LOADQA(); LOADB(bf, rd + 2);
            LDS_BARRIER();
            TEND(2)
        }
        }
    }
#undef LOADB
#undef LOADQ
#undef LOADQA
    TEND(1)
    }
    u64* buf = bufall + (size_t)wave * TK_C;
    TBEG(3)
    int n = (int)cnt[wave];
    if (n > 256) { float t; n = tk_compact(buf, hist, n, lane, t); }
    TEND(3)
    const int qrow = U.qrow0 + wave;
    int lane_o = lane; asm volatile("" : "+v"(lane_o));
    for (int repa_ = 0; repa_ < REP_ATT; ++repa_) {
    TBEG(4)
    float* P = (float*)((unsigned char*)buf + 4096);
    {
        const int fr = lane_o & 15, fq = lane_o >> 4;
        h16x8 qf[2];
#pragma unroll
        for (int ks = 0; ks < 2; ++ks) {
            if (fr < 8) qf[ks] = *(const h16x8*)(PROJ + (size_t)qrow * NPJ + C_Q + fr * 64 + ks * 32 + fq * 8);
            else {
#pragma unroll
                for (int j = 0; j < 8; ++j) qf[ks][j] = (h16)0.f; }
        }
        long q8[2];
#pragma unroll
        for (int ks = 0; ks < 2; ++ks) { f32x4 f0_, f1_;
#pragma unroll
            for (int j = 0; j < 4; ++j) { f0_[j] = (float)qf[ks][j]; f1_[j] = (float)qf[ks][4 + j]; }
            q8[ks] = (long)pack8_fp8(f0_, f1_); }
        h16x8 zero8;
#pragma unroll
        for (int j = 0; j < 8; ++j) zero8[j] = (h16)0.f;
        u32x4 ka[8], kb[8];
#define ISSUEK4(dst, g) do { _Pragma("unroll") for (int tt = 0; tt < 2; ++tt) { const int s_ = ((g) * 2 + tt) * 16 + fr; const unsigned idx_ = (s_ < n) ? ~(unsigned)buf[s_] : 0u; \
        const unsigned char* kr_ = U.kvb + (size_t)(U.krow0 + (int)idx_) * 512 + fq * 16; \
        _Pragma("unroll") for (int j = 0; j < 4; ++j) dst[tt * 4 + j] = *(const u32x4*)(kr_ + j * 64); } } while (0)
#define COMPK4(src, g) do { _Pragma("unroll") for (int tt = 0; tt < 2; ++tt) { f32x4 c_ = (f32x4){0.f, 0.f, 0.f, 0.f}; \
        _Pragma("unroll") for (int j = 0; j < 4; ++j) { const u32x4 w_ = src[tt * 4 + j]; \
            const long a0_ = ((fr >> 1) == j) ? q8[0] : 0l, a1_ = ((fr >> 1) == j) ? q8[1] : 0l; \
            c_ = __builtin_amdgcn_mfma_f32_16x16x32_fp8_fp8(a0_, (long)((u64)w_.x | ((u64)w_.y << 32)), c_, 0, 0, 0); \
            c_ = __builtin_amdgcn_mfma_f32_16x16x32_fp8_fp8(a1_, (long)((u64)w_.z | ((u64)w_.w << 32)), c_, 0, 0, 0); } \
        const int s_ = ((g) * 2 + tt) * 16 + fr; const bool v_ = s_ < n; \
        _Pragma("unroll") for (int r = 0; r < 4; ++r) c_[r] = v_ ? c_[r] * 0.125f : -1e30f; \
        if (fq < 2) *(f32x4*)(P + s_ * 8 + fq * 4) = c_; } } while (0)
        ISSUEK4(ka, 0);
#pragma unroll 1
        for (int g = 0; g < 8; g += 2) {
            ISSUEK4(kb, g + 1);
            COMPK4(ka, g);
            ISSUEK4(ka, g + 2);
            COMPK4(kb, g + 1);
        }
#undef ISSUEK4
#undef COMPK4
        asm volatile("s_waitcnt lgkmcnt(0)" ::: "memory");
        f32x4 acc[16];
#pragma unroll
        for (int t = 0; t < 16; ++t) acc[t] = *(const f32x4*)(P + (t * 16 + fr) * 8 + (fq & 1) * 4);
        float mx[4] = {-1e30f, -1e30f, -1e30f, -1e30f};
#pragma unroll
        for (int t = 0; t < 16; ++t) { const bool v = (t * 16 + fr) < n;
#pragma unroll
            for (int r = 0; r < 4; ++r) { mx[r] = fmaxf(mx[r], acc[t][r]); } }
#pragma unroll
        for (int r = 0; r < 4; ++r) mx[r] = row16_max(mx[r]);
        float sm[4] = {0.f, 0.f, 0.f, 0.f};
#pragma unroll
        for (int t = 0; t < 16; ++t) { const bool v = (t * 16 + fr) < n;
#pragma unroll
            for (int r = 0; r < 4; ++r) { const float e = v ? __expf(acc[t][r] - mx[r]) : 0.f; acc[t][r] = e; sm[r] += e; } }
#pragma unroll
        for (int r = 0; r < 4; ++r) sm[r] = row16_sum(sm[r]);
        asm volatile("s_waitcnt lgkmcnt(0)" ::: "memory");
        if (fq < 2) {
#pragma unroll
            for (int t = 0; t < 16; ++t) *(f32x4*)(P + (t * 16 + fr) * 8 + fq * 4) = acc[t];
            if (fr == 0) {
#pragma unroll
                for (int r = 0; r < 4; ++r) sums[fq * 4 + r] = sm[r]; }
        }
        asm volatile("s_waitcnt lgkmcnt(0)" ::: "memory");
    }
    TEND(4)
    TBEG(5)
    {
        const int sg = lane_o >> 4, part = lane_o & 15, kv = part >> 2, d0 = (part & 3) * 16;
        f32x2 o0[8], o1[8];
#pragma unroll
        for (int j = 0; j < 8; ++j) { o0[j] = (f32x2){0.f, 0.f}; o1[j] = (f32x2){0.f, 0.f}; }
        u32x4 va[8], vb[8];
        const unsigned char* vbase = U.kvb + 256 + kv * 64 + d0;
#define ISSUEV16(dst, gi) do { _Pragma("unroll") for (int ii = 0; ii < 8; ++ii) { const int s_ = 4 * ((gi) * 8 + ii) + sg; const unsigned idx_ = (s_ < n) ? ~(unsigned)buf[s_] : 0u; \
        dst[ii] = *(const u32x4*)(vbase + (size_t)(U.krow0 + (int)idx_) * 512); } } while (0)
#define COMPV16(src, gi) do { _Pragma("unroll") for (int ii = 0; ii < 8; ++ii) { const int s_ = 4 * ((gi) * 8 + ii) + sg; const f32x2 pp = *(const f32x2*)(P + (s_ & 255) * 8 + 2 * kv); const f32x2 px_ = (f32x2){pp.x, pp.x}, py_ = (f32x2){pp.y, pp.y}; const u32x4 w_ = src[ii]; \
        _Pragma("unroll") for (int q_ = 0; q_ < 4; ++q_) { const int ww_ = (int)w_[q_]; \
            const f32x2 xa_ = __builtin_amdgcn_cvt_pk_f32_fp8(ww_, false), xb_ = __builtin_amdgcn_cvt_pk_f32_fp8(ww_, true); \
            o0[q_ * 2] = __builtin_elementwise_fma(xa_, px_, o0[q_ * 2]); o0[q_ * 2 + 1] = __builtin_elementwise_fma(xb_, px_, o0[q_ * 2 + 1]); \
            o1[q_ * 2] = __builtin_elementwise_fma(xa_, py_, o1[q_ * 2]); o1[q_ * 2 + 1] = __builtin_elementwise_fma(xb_, py_, o1[q_ * 2 + 1]); } } } while (0)
        ISSUEV16(va, 0);
#pragma unroll 1
        for (int gi = 0; gi < 8; gi += 2) {
            ISSUEV16(vb, gi + 1);
            COMPV16(va, gi);
            ISSUEV16(va, gi + 2);
            COMPV16(vb, gi + 1);
        }
#undef ISSUEV16
#undef COMPV16
#pragma unroll
        for (int j = 0; j < 8; ++j) { o0[j].x = x32_sum(x16_sum(o0[j].x)); o0[j].y = x32_sum(x16_sum(o0[j].y)); o1[j].x = x32_sum(x16_sum(o1[j].x)); o1[j].y = x32_sum(x16_sum(o1[j].y)); }
        if (sg == 0) {
            const float i0 = __builtin_amdgcn_rcpf(sums[2 * kv]), i1 = __builtin_amdgcn_rcpf(sums[2 * kv + 1]);
            const h16* pz = PROJ + (size_t)qrow * NPJ + C_ZB + (2 * kv) * 64 + d0;
            h16* po = (h16*)(p.ws + WS_BOUT) + (size_t)qrow * 512 + (2 * kv) * 64 + d0;
#pragma unroll
            for (int hh = 0; hh < 2; ++hh) {
                const h16x8 za = *(const h16x8*)(pz + hh * 64), zb = *(const h16x8*)(pz + hh * 64 + 8);
                h16x8 ra, rb;
#pragma unroll
                for (int j = 0; j < 8; ++j) { const float oa = hh ? o1[j >> 1][j & 1] : o0[j >> 1][j & 1], ob = hh ? o1[4 + (j >> 1)][j & 1] : o0[4 + (j >> 1)][j & 1]; const float ii = hh ? i1 : i0;
                    ra[j] = (h16)(oa * ii * siluf_((float)za[j])); rb[j] = (h16)(ob * ii * siluf_((float)zb[j])); }
                *(h16x8*)(po + hh * 64) = ra; *(h16x8*)(po + hh * 64 + 8) = rb;
            }
        }
    }
    TEND(5)
    }
    __syncthreads();
}

__global__ void __launch_bounds__(512, 2) mk_fwd(Params p) {
    __builtin_assume(__builtin_amdgcn_workitem_id_y() == 0); __builtin_assume(__builtin_amdgcn_workitem_id_z() == 0);
    extern __shared__ __attribute__((aligned(16))) unsigned char lds[];
    cg::grid_group grid = cg::this_grid();
    const int wave = __builtin_amdgcn_readfirstlane((int)threadIdx.x >> 6);
    const int G = gridDim.x, bx = blockIdx.x;
    const int gw = bx * 8 + wave, NGW = G * 8;
    const int lo = p.ph_lo, hi = p.ph_hi;
    unsigned long long tacc = 0;
#define IN(k) (lo <= (k) && (k) < hi)
#define SEAM(k) do { if (IN(k) && IN((k) + 1)) grid.sync(); } while (0)
    h16* XH = (h16*)(p.ws + WS_XH); h16* PROJ = (h16*)(p.ws + WS_PROJ);
    h16* WIN = (h16*)(p.ws + WS_WIN); h16* WPA = (h16*)(p.ws + WS_WPA); h16* WPB = (h16*)(p.ws + WS_WPB); h16* WOUT = (h16*)(p.ws + WS_WOUT);
    h16* WSM = (h16*)(p.ws + WS_WSM); h16* KVS = (h16*)(p.ws + WS_KVS); h16* KIS = (h16*)(p.ws + WS_KIS);
    float* RSTD = (float*)(p.ws + WS_RSTD); float* ROWSS = (float*)(p.ws + WS_ROWSS);

    if (IN(0)) for (int rep_ = 0; rep_ < REP_P0; ++rep_) {
        const int lane = lane_id(), tid = wave * 64 + lane;
        float* scr = (float*)(lds + wave * 16384);
        constexpr int I_IN = 16 * (NPJ / 32), I_PA = 8 * 32, I_PB = 8 * 32, I_OUT = 16 * 32;
        for (int it = gw; it < I_IN + I_PA + I_PB + I_OUT; it += NGW) {
            int r = it;
            if (r < I_IN) { p0_tr_item(p.w_in, 1024, INW, WIN, p.norm_g, 1, scr, r, NPJ / 32, lane); continue; } r -= I_IN;
            if (r < I_PA) { p0_tr_item(p.w_pa, 512, 1024, WPA, nullptr, 0, scr, r, 32, lane); continue; } r -= I_PA;
            if (r < I_PB) { p0_tr_item(p.w_pb, 512, 1024, WPB, nullptr, 0, scr, r, 32, lane); continue; } r -= I_PB;
            p0_tr_item(p.w_out, 1024, 1024, WOUT, nullptr, 0, scr, r, 32, lane);
        }
        for (int m = gw; m < MT; m += NGW) {
            u64* o8 = (u64*)(XH + (size_t)m * DM) + lane;
            if (m < MROWS) {
                const float* xr = (m < MP) ? p.xp + (size_t)m * DM : p.xs + (size_t)(m - MP) * DM;
                const f32x4* x4 = (const f32x4*)xr + lane;
                f32x4 v[4]; float s = 0.f;
#pragma unroll
                for (int j = 0; j < 4; ++j) { v[j] = x4[64 * j]; s += (v[j].x * v[j].x + v[j].y * v[j].y) + (v[j].z * v[j].z + v[j].w * v[j].w); }
                s = wave_sum(s);
                if (lane == 0) RSTD[m] = rsqrtf(s * (1.f / 1024.f) + 1e-6f);
#pragma unroll
                for (int j = 0; j < 4; ++j) { h16x4 h; h[0] = (h16)v[j].x; h[1] = (h16)v[j].y; h[2] = (h16)v[j].z; h[3] = (h16)v[j].w; o8[64 * j] = __builtin_bit_cast(u64, h); }
            } else {
                if (lane == 0) RSTD[m] = 0.f;
#pragma unroll
                for (int j = 0; j < 4; ++j) o8[64 * j] = 0ull;
            }
        }
        const int gt = bx * 512 + tid, NGT = G * 512;
        for (int i = gt; i < NB * NKSP * 64; i += NGT) {
            const int c8 = (i & 63) * 8, r = (i >> 6) % NKSP, b = (i >> 6) / NKSP;
            if (r >= PAST && r < NKS) continue;
            f32x4 f0 = (f32x4){0.f, 0.f, 0.f, 0.f}, f1 = f0;
            if (r < PAST) { const float* src = (c8 < 256) ? p.ck + ((size_t)b * PAST + r) * 256 + c8 : p.cv + ((size_t)b * PAST + r) * 256 + (c8 - 256);
                f0 = *(const f32x4*)src; f1 = *(const f32x4*)(src + 4); }
            *(u64*)((unsigned char*)KVS + ((size_t)b * NKSP + r) * 512 + kvpos(c8)) = pack8_fp8(f0, f1);
        }
        for (int i = gt; i < NB * NKSP * 8; i += NGT) {
            const int c8 = (i & 7) * 8, r = (i >> 3) % NKSP, b = (i >> 3) / NKSP;
            if (r >= PAST && r < NKS) continue;
            h16x8 h;
            if (r < PAST) { const float* src = p.cki + ((size_t)b * PAST + r) * 64 + c8;
#pragma unroll
                for (int j = 0; j < 8; ++j) h[j] = (h16)src[j]; }
            else {
#pragma unroll
                for (int j = 0; j < 8; ++j) h[j] = (h16)0.f; }
            *(h16x8*)(KIS + ((size_t)b * NKSP + r) * 64 + c8) = h;
        }
        for (int i = gt; i < 8 * 128 * 128; i += NGT) { const int j = i & 127, ii = (i >> 7) & 127; WSM[i] = ((j >> 6) <= (ii >> 6)) ? (h16)p.sgu_w[i] : (h16)0.f; }
    }
    SEAM(0);
    if (IN(1)) for (int rep_ = 0; rep_ < REP_P1; ++rep_) {
        pg8::Gemm g{XH, WIN, MT, NPJ, 1024, 1024}; pg8::StaticOrder S; S.init(MT, NPJ, G, bx);
        EpiProj E{PROJ, RSTD, p.out, (unsigned char*)KVS, KIS, (unsigned char*)(p.ws + WS_KVC), (h16*)(p.ws + WS_KIC)};
        pg8::gemm_phase<EpiProj>((LAS unsigned char*)lds, g, S, E);
    }
    SEAM(1);
    if (IN(2)) for (int rep_ = 0; rep_ < REP_P2; ++rep_) {
        for (int u = bx; u < 512 + NB; u += G) { const int lane = lane_id(); if (u < 512) sgu_chunk(p, lds, u, wave, lane); else sgu_sample(p, lds, u - 512, wave, lane); }
    }
    if (IN(3)) for (int rep_ = 0; rep_ < REP_P3; ++rep_) {
        for (int u = bx; u < 8192 + 16; u += G) {
            AUnit U;
            if (u < 8192) { const int i = u >> 8, gp = u & 255, b = gp & 7, s = gp >> 3; const int jt = s + 32 * i;
                U.qrow0 = b * SEQ + jt * 8; U.krow0 = b * SEQ; U.nk = ((jt * 8) / 64 + 1) * 64; U.kib = (const h16*)(p.ws + WS_KIC); U.kis = 64; U.kvb = (const unsigned char*)(p.ws + WS_KVC); U.kvs = 512; }
            else { const int v = u - 8192, b = v >> 1, hf = v & 1;
                U.qrow0 = MP + b * 16 + hf * 8; U.krow0 = b * NKSP; U.nk = NKS; U.kib = KIS; U.kis = 64; U.kvb = (const unsigned char*)KVS; U.kvs = 512; }
            attn_unit(p, lds, U, wave, lane_id(), tacc);
        }
    }
    SEAM(3);
    if (IN(4)) for (int rep_ = 0; rep_ < REP_P4; ++rep_) {
        { pg8::Gemm g{(const h16*)(p.ws + WS_AOUT), WPA, MT, 1024, 512, 512}; pg8::StaticOrder S; S.init(MT, 1024, G, bx); EpiGate<1> E{PROJ}; pg8::gemm_phase<EpiGate<1>>((LAS unsigned char*)lds, g, S, E); }
        { pg8::Gemm g{(const h16*)(p.ws + WS_BOUT), WPB, MT, 1024, 512, 512}; pg8::StaticOrder S; S.init(MT, 1024, G, bx); EpiGate<0> E{PROJ}; pg8::gemm_phase<EpiGate<0>>((LAS unsigned char*)lds, g, S, E); }
    }
    SEAM(4);
    if (IN(5)) for (int rep_ = 0; rep_ < REP_P5; ++rep_) {
        pg8::Gemm g{PROJ + C_M, WOUT, MT, 1024, 1024, NPJ}; pg8::StaticOrder S; S.init(MT, 1024, G, bx);
        EpiOut E{p.xp, p.xs, p.out, ROWSS};
        pg8::gemm_phase<EpiOut>((LAS unsigned char*)lds, g, S, E);
    }
    SEAM(5);
    if (IN(6)) {
        const int lane = lane_id();
        for (int m = gw; m < MROWS; m += NGW) {
            float* yr = (m < MP) ? p.out + O_YP + (size_t)m * DM : p.out + O_YS + (size_t)(m - MP) * DM;
            float ssum = (lane < 16) ? ROWSS[(size_t)m * 16 + lane] : 0.f; ssum = wave_sum(ssum);
            const float r = rsqrtf(ssum * (1.f / 1024.f) + 1e-6f);
            const int lane6 = lane;
            f32x4* y4 = (f32x4*)yr + lane6; const f32x4* g4 = (const f32x4*)p.final_g + lane6;
#pragma unroll
            for (int j = 0; j < 4; ++j) { f32x4 v = y4[64 * j]; const f32x4 gg = g4[64 * j]; v = v * r * gg; y4[64 * j] = v; }
        }
    }
    if (TSEL != 0 && bx == 0 && threadIdx.x == 0) { const unsigned long long t0 = rt_(); while (rt_() - t0 < tacc) __builtin_amdgcn_s_sleep(8); }
#undef IN
#undef SEAM
}

extern "C" void kernel_launch(void* const* d_in, const int* in_sizes, int n_in, void* d_out, int out_size, void* d_ws, size_t ws_size, hipStream_t stream) {
    static int grid_blocks = 0;
    if (grid_blocks == 0) {
        if (ws_size < WS_END) { fprintf(stderr, "kernel_launch: workspace too small: %zu < %zu\n", ws_size, (size_t)WS_END); grid_blocks = -1; return; }
        int dev = 0, cus = 0, per_cu = 0;
        hipGetDevice(&dev);
        hipDeviceGetAttribute(&cus, hipDeviceAttributeMultiprocessorCount, dev);
        hipFuncSetAttribute((const void*)mk_fwd, hipFuncAttributeMaxDynamicSharedMemorySize, LDS_BYTES);
        hipOccupancyMaxActiveBlocksPerMultiprocessor(&per_cu, (const void*)mk_fwd, 512, LDS_BYTES);
        if (per_cu < 1) { fprintf(stderr, "kernel_launch: occupancy query says %d blocks per CU\n", per_cu); per_cu = 1; }
        grid_blocks = cus * per_cu;
        (void)hipGetLastError();
    }
    if (grid_blocks < 0) return;
    Params p{};
    p.xp = (const float*)d_in[0]; p.xs = (const float*)d_in[1]; p.ck = (const float*)d_in[2]; p.cv = (const float*)d_in[3]; p.cki = (const float*)d_in[4];
    p.norm_g = (const float*)d_in[5]; p.w_in = (const float*)d_in[6]; p.ln_g = (const float*)d_in[7]; p.ln_b = (const float*)d_in[8];
    p.sgu_w = (const float*)d_in[9]; p.sgu_b = (const float*)d_in[10]; p.w_pa = (const float*)d_in[11]; p.w_pb = (const float*)d_in[12];
    p.w_out = (const float*)d_in[13]; p.final_g = (const float*)d_in[14];
    p.out = (float*)d_out; p.ws = (unsigned char*)d_ws; p.ph_lo = 0; p.ph_hi = 7;
    void* args[] = {&p};
    hipError_t e = hipLaunchCooperativeKernel((const void*)mk_fwd, dim3(grid_blocks), dim3(512), args, LDS_BYTES, stream);
    if (e != hipSuccess) fprintf(stderr, "cooperative launch failed: %s (grid %d)\n", hipGetErrorString(e), grid_blocks);
}
```
